# Optimizing an MI355X kernel written in HIP

```python
import jax, jax.numpy as jnp
from jax import lax
import numpy as np

D_MODEL = 1024
BATCH = 4
SEQ = 4096
DEPTH = 1

HEAD_DIM = 64
ROPE_THETA = 10000.0
RMS_EPS = 1e-6
NEG_INF = -1e30
DIL_PAIRS = ((128, 1), (512, 4), (2048, 16))
DIL_HEADS = 4
DIL_TOTAL_HEADS = len(DIL_PAIRS) * DIL_HEADS
DIL_W = DIL_TOTAL_HEADS * HEAD_DIM
DIL_BLOCK = 64
SWA_Q_HEADS = 8
SWA_KV_HEADS = 2
SWA_WINDOW = 128
SWA_BLOCK = 128
SWA_QW = SWA_Q_HEADS * HEAD_DIM
SWA_KVW = SWA_KV_HEADS * HEAD_DIM
N_BRANCHES = 2
IN_SPLITS = tuple(int(v) for v in np.cumsum([DIL_W, DIL_W, DIL_W, SWA_QW, SWA_KVW, SWA_KVW, D_MODEL]))
IN_WIDTH = 3 * DIL_W + SWA_QW + 2 * SWA_KVW + N_BRANCHES * D_MODEL
MOE_GROUPS = 4
EXPERTS_PER_GROUP = 8
N_EXPERTS = MOE_GROUPS * EXPERTS_PER_GROUP
TOP_K = 2
D_EXPERT = 512
MOE_BLOCK = 128
N_MOD = 6

kernel_name = 'hybrid_dilated_swa_hmoe_adaln_encoder'


def rms_norm(x, g):
    x32 = x.astype(jnp.float32)
    y = x32 * lax.rsqrt(jnp.mean(x32 * x32, axis=-1, keepdims=True) + RMS_EPS)
    return y.astype(x.dtype) * g


def rope(t, positions):
    half = HEAD_DIM // 2
    inv_freq = ROPE_THETA ** (-jnp.arange(half, dtype=jnp.float32) * (2.0 / HEAD_DIM))
    ang = positions.astype(jnp.float32)[..., None] * inv_freq
    cos = jnp.cos(ang)[:, :, None, :]
    sin = jnp.sin(ang)[:, :, None, :]
    t32 = t.astype(jnp.float32)
    t1, t2 = t32[..., :half], t32[..., half:]
    return jnp.concatenate([t1 * cos - t2 * sin, t2 * cos + t1 * sin], axis=-1).astype(t.dtype)


def band_attention(q, k, v, window, block, sink=None):
    bt, length, hq, dh = q.shape
    hkv = k.shape[2]
    grp = hq // hkv
    nb = -(-length // block)
    lp = nb * block
    ks = block + 2 * window
    q = jnp.pad(q, ((0, 0), (0, lp - length), (0, 0), (0, 0)))
    kv_pad = ((0, 0), (window, lp - length + window), (0, 0), (0, 0))
    k = jnp.pad(k, kv_pad)
    v = jnp.pad(v, kv_pad)
    slab = jnp.arange(nb)[:, None] * block + jnp.arange(ks)[None, :]
    kb = k[:, slab]
    vb = v[:, slab]
    qb = q.reshape(bt, nb, block, hkv, grp, dh)
    s = jnp.einsum('bnqhgd,bnkhd->bnhgqk', qb, kb, preferred_element_type=jnp.float32) * (dh ** -0.5)
    rel = jnp.arange(ks)[None, :] - window - jnp.arange(block)[:, None]
    kpos = slab - window
    mask = (jnp.abs(rel) <= window)[None] & ((kpos >= 0) & (kpos < length))[:, None, :]
    s = jnp.where(mask[None, :, None, None], s, NEG_INF)
    m = jnp.max(s, axis=-1)
    if sink is not None:
        sk = sink.astype(jnp.float32).reshape(hkv, grp)[None, None, :, :, None]
        m = jnp.maximum(m, sk)
    e = jnp.exp(s - m[..., None])
    denom = jnp.sum(e, axis=-1)
    if sink is not None:
        denom = denom + jnp.exp(sk - m)
    o = jnp.einsum('bnhgqk,bnkhd->bnqhgd', e, vb.astype(jnp.float32))
    o = o / jnp.moveaxis(denom, -1, 2)[..., None]
    o = o.reshape(bt, lp, hq, dh)[:, :length]
    lse = jnp.moveaxis(m + jnp.log(denom), -1, 2).reshape(bt, lp, hq)[:, :length]
    return o.astype(q.dtype), lse


def to_strided(t, d):
    b, s = t.shape[0], t.shape[1]
    t = t.reshape((b, s // d, d) + t.shape[2:])
    t = jnp.swapaxes(t, 1, 2)
    return t.reshape((b * d, s // d) + t.shape[3:])


def from_strided(t, d, batch):
    length = t.shape[1]
    t = t.reshape((batch, d) + t.shape[1:])
    t = jnp.swapaxes(t, 1, 2)
    return t.reshape((batch, length * d) + t.shape[3:])


def dilated_attention(q, k, v):
    batch = q.shape[0]
    outs, lses = [], []
    for g, (w, d) in enumerate(DIL_PAIRS):
        sl = slice(g * DIL_HEADS, (g + 1) * DIL_HEADS)
        o, l = band_attention(to_strided(q[:, :, sl], d), to_strided(k[:, :, sl], d),
                              to_strided(v[:, :, sl], d), w // (2 * d), DIL_BLOCK)
        outs.append(from_strided(o, d, batch))
        lses.append(from_strided(l, d, batch))
    alpha = jax.nn.softmax(jnp.stack(lses), axis=0)
    o = jnp.stack(outs).astype(jnp.float32)
    return jnp.einsum('gbsh,gbshd->bshd', alpha, o).astype(q.dtype)


def token_mixer(h, positions, w_in, sink_logits, w_branch_a, w_branch_b, w_out):
    b, s, _ = h.shape
    p = h @ w_in
    qa, ka, va, qb, kb, vb, ga, gb = jnp.split(p, IN_SPLITS, axis=-1)
    heads = lambda t, n: t.reshape(b, s, n, HEAD_DIM)
    o_a = dilated_attention(rope(heads(qa, DIL_TOTAL_HEADS), positions),
                            rope(heads(ka, DIL_TOTAL_HEADS), positions),
                            heads(va, DIL_TOTAL_HEADS))
    o_b, _ = band_attention(rope(heads(qb, SWA_Q_HEADS), positions),
                            rope(heads(kb, SWA_KV_HEADS), positions),
                            heads(vb, SWA_KV_HEADS), SWA_WINDOW, SWA_BLOCK, sink_logits)
    y_a = o_a.reshape(b, s, -1) @ w_branch_a
    y_b = o_b.reshape(b, s, -1) @ w_branch_b
    merged = jax.nn.sigmoid(ga) * y_a + jax.nn.sigmoid(gb) * y_b
    return merged @ w_out


def hier_moe(h, w_group, b_group, w_route, b_route, w_gate, w_up, w_down):
    b, s, d = h.shape
    n = b * s
    t = h.reshape(n, d)
    glog = (t @ w_group).astype(jnp.float32) + b_group
    gprob = jax.nn.softmax(glog, axis=-1)
    gsel = jnp.argmax(glog, axis=-1)
    gw = jnp.take_along_axis(gprob, gsel[:, None], axis=1)[:, 0]
    elog = ((t @ w_route).astype(jnp.float32) + b_route).reshape(n, MOE_GROUPS, EXPERTS_PER_GROUP)
    elog = jnp.take_along_axis(elog, gsel[:, None, None], axis=1)[:, 0]
    topw, topi = lax.top_k(jax.nn.softmax(elog, axis=-1), TOP_K)
    topw = topw / jnp.sum(topw, axis=-1, keepdims=True) * gw[:, None]
    expert = gsel[:, None] * EXPERTS_PER_GROUP + topi
    a = n * TOP_K
    flat_e = expert.reshape(a).astype(jnp.int32)
    flat_tok = jnp.repeat(jnp.arange(n, dtype=jnp.int32), TOP_K)
    order = jnp.argsort(flat_e, stable=True)
    se = flat_e[order]
    counts = jnp.zeros((N_EXPERTS,), jnp.int32).at[flat_e].add(1)
    starts = jnp.cumsum(counts) - counts
    padded = (counts + MOE_BLOCK - 1) // MOE_BLOCK * MOE_BLOCK
    pend = jnp.cumsum(padded)
    pstarts = pend - padded
    dest_sorted = pstarts[se] + (jnp.arange(a, dtype=jnp.int32) - starts[se])
    dest = jnp.zeros((a,), jnp.int32).at[order].set(dest_sorted)
    rows = (-(-a // MOE_BLOCK) + N_EXPERTS) * MOE_BLOCK
    nblk = rows // MOE_BLOCK
    row_tok = jnp.full((rows,), n, jnp.int32).at[dest].set(flat_tok)
    t_pad = jnp.concatenate([t, jnp.zeros((1, d), t.dtype)], axis=0)
    x_rows = t_pad[row_tok].reshape(nblk, MOE_BLOCK, d)
    blk_e = jnp.clip(jnp.searchsorted(pend, jnp.arange(nblk) * MOE_BLOCK, side='right'), 0, N_EXPERTS - 1)

    def expert_block(args):
        xb, e = args
        return (jax.nn.silu(xb @ w_gate[e]) * (xb @ w_up[e])) @ w_down[e]

    y_rows = lax.map(expert_block, (x_rows, blk_e)).reshape(rows, d)
    picked = y_rows[dest].reshape(n, TOP_K, d)
    out = jnp.einsum('nk,nkd->nd', topw.astype(h.dtype), picked)
    return out.reshape(b, s, d)


def setup_inputs(seed: int = 0) -> dict:
    key = jax.random.key(seed)
    ks = jax.random.split(key, 20)
    f32 = jnp.float32
    nrm = lambda k, shape, fan: jax.random.normal(k, shape, f32) * (fan ** -0.5)
    L, D = DEPTH, D_MODEL
    return {
        'x': jax.random.normal(ks[0], (BATCH, SEQ, D), f32),
        'c': jax.random.normal(ks[1], (BATCH, D), f32),
        'positions': jnp.broadcast_to(jnp.arange(SEQ, dtype=jnp.int32), (BATCH, SEQ)),
        'w_ada': nrm(ks[2], (L, D, N_MOD * D), D),
        'b_ada': 0.02 * jax.random.normal(ks[3], (L, N_MOD * D), f32),
        'g_mix': 1.0 + 0.05 * jax.random.normal(ks[4], (L, D), f32),
        'w_in': nrm(ks[5], (L, D, IN_WIDTH), D),
        'sink_logits': jax.random.normal(ks[6], (L, SWA_Q_HEADS), f32),
        'w_branch_a': nrm(ks[7], (L, DIL_HEADS * HEAD_DIM, D), DIL_HEADS * HEAD_DIM),
        'w_branch_b': nrm(ks[8], (L, SWA_QW, D), SWA_QW),
        'w_out': nrm(ks[9], (L, D, D), D),
        'g_ffn': 1.0 + 0.05 * jax.random.normal(ks[10], (L, D), f32),
        'w_group': nrm(ks[11], (L, D, MOE_GROUPS), D),
        'b_group': 0.01 * jax.random.normal(ks[12], (L, MOE_GROUPS), f32),
        'w_route': nrm(ks[13], (L, D, N_EXPERTS), D),
        'b_route': 0.01 * jax.random.normal(ks[14], (L, N_EXPERTS), f32),
        'w_expert_gate': nrm(ks[15], (L, N_EXPERTS, D, D_EXPERT), D),
        'w_expert_up': nrm(ks[16], (L, N_EXPERTS, D, D_EXPERT), D),
        'w_expert_down': nrm(ks[17], (L, N_EXPERTS, D_EXPERT, D), D_EXPERT),
        'g_final': 1.0 + 0.05 * jax.random.normal(ks[18], (D,), f32),
    }


def reference(x, c, positions, w_ada, b_ada, g_mix, w_in, sink_logits, w_branch_a, w_branch_b,
              w_out, g_ffn, w_group, b_group, w_route, b_route, w_expert_gate, w_expert_up,
              w_expert_down, g_final):
    cs = jax.nn.silu(c)
    for l in range(DEPTH):
        mod = cs @ w_ada[l] + b_ada[l]
        sh1, sc1, gt1, sh2, sc2, gt2 = jnp.split(mod, N_MOD, axis=-1)
        h = rms_norm(x, g_mix[l]) * (1.0 + sc1[:, None]) + sh1[:, None]
        x = x + gt1[:, None] * token_mixer(h, positions, w_in[l], sink_logits[l],
                                           w_branch_a[l], w_branch_b[l], w_out[l])
        h = rms_norm(x, g_ffn[l]) * (1.0 + sc2[:, None]) + sh2[:, None]
        x = x + gt2[:, None] * hier_moe(h, w_group[l], b_group[l], w_route[l], b_route[l],
                                        w_expert_gate[l], w_expert_up[l], w_expert_down[l])
    return rms_norm(x, g_final)
```

```cpp
#include <hip/hip_runtime.h>
#include <cstdio>
#include <cstdint>

#ifndef MK_PER_PHASE
#define MK_PER_PHASE 0
#endif

#ifndef MK_REPEAT_MASK
#define MK_REPEAT_MASK 0
#endif
#define LAS __attribute__((address_space(3)))
#define GAS __attribute__((address_space(1)))
typedef unsigned short bf16;
typedef short bf16x8 __attribute__((ext_vector_type(8)));
typedef short s16x4 __attribute__((ext_vector_type(4)));
typedef float f32x4 __attribute__((ext_vector_type(4)));
typedef float f32x2 __attribute__((ext_vector_type(2)));
typedef float f32x16 __attribute__((ext_vector_type(16)));
typedef unsigned u32x4 __attribute__((ext_vector_type(4)));
typedef unsigned u32x2 __attribute__((ext_vector_type(2)));
typedef __bf16 bf16x2_t __attribute__((ext_vector_type(2)));

constexpr int NBATCH = 4, SEQ = 4096, DM = 1024, MT = NBATCH * SEQ;
constexpr int NIN = 5120, NMOD = 6 * DM;
constexpr int NEXP = 32, DEXP = 512;
constexpr float RMS_EPS = 1e-6f;
constexpr float LOG2E = 1.4426950408889634f;
constexpr float QSCALE = 0.125f * LOG2E;
constexpr int NPHASE = 8;

constexpr size_t MiB = 1u << 20;
constexpr size_t WS_CTL = 0, CTL_ZERO_BYTES = 1 * MiB;
constexpr size_t WS_MOD = 1 * MiB;
constexpr size_t WS_RCOS = 2 * MiB, WS_RSIN = 4 * MiB;
constexpr size_t WS_LIST = 288 * MiB;
constexpr size_t WS_WTS = 8 * MiB;
constexpr size_t WS_WRT = 8 * MiB + 512 * 1024;
constexpr size_t WS_WAT = 9 * MiB;
constexpr size_t WS_WBT = 9 * MiB + 512 * 1024;
constexpr size_t WS_WOT = 10 * MiB + 512 * 1024;
constexpr size_t WS_WINT = 13 * MiB;
constexpr size_t WS_GUT = 24 * MiB;
constexpr size_t WS_DT = 88 * MiB;
constexpr size_t WS_H = 120 * MiB;
constexpr size_t WS_OA = 120 * MiB;
constexpr size_t WS_OB = 128 * MiB;
constexpr size_t WS_QA = 152 * MiB, WS_KA = 176 * MiB, WS_VAT = 200 * MiB, WS_QB = 224 * MiB, WS_KB = 240 * MiB, WS_VBT = 244 * MiB;
constexpr size_t WS_MERGED = 152 * MiB;
constexpr size_t WS_ACT = 152 * MiB;
constexpr size_t WS_Y = 192 * MiB;
constexpr size_t WS_X1 = 256 * MiB;
constexpr size_t WS_END = 296 * MiB;
constexpr int CW_BAR = 4096;
constexpr int CW_CNT = 16384;
constexpr int CW_MODCNT = 49152;
constexpr int CW_ACT = 32768;

constexpr int RING_BYTES = 131072;
constexpr int TAB_OFF = RING_BYTES;
constexpr int TAB_GIDX = TAB_OFF, TAB_D = TAB_OFF + 3072, TAB_W = TAB_OFF + 6144, TAB_RB = TAB_OFF + 9216, TAB_CNT = TAB_RB + 768, TAB_NB = TAB_CNT + 128, TAB_PREF = TAB_NB + 16;
constexpr int MISC_OFF = TAB_OFF + 12288;
constexpr int LDS_BYTES = 147456;

#define LDS_WAIT() asm volatile("s_waitcnt lgkmcnt(0)" ::: "memory")
#define VM_WAIT() asm volatile("s_waitcnt vmcnt(0)" ::: "memory")
#define RLX_AGENT __ATOMIC_RELAXED, __HIP_MEMORY_SCOPE_AGENT
__device__ __forceinline__ unsigned cvtpk(float lo, float hi) { f32x2 v = {lo, hi}; bf16x2_t b = __builtin_convertvector(v, bf16x2_t); return __builtin_bit_cast(unsigned, b); }
__device__ __forceinline__ float bflo(unsigned u) { return __builtin_bit_cast(float, u << 16); }
__device__ __forceinline__ float bfhi(unsigned u) { return __builtin_bit_cast(float, u & 0xffff0000u); }
__device__ __forceinline__ float fexp2(float x) { return __builtin_amdgcn_exp2f(x); }
__device__ __forceinline__ float frcp(float x) { return __builtin_amdgcn_rcpf(x); }
__device__ __forceinline__ float fsigmoid(float x) { return frcp(1.0f + fexp2(-x * LOG2E)); }
__device__ __forceinline__ void st16_sc1(void* p, u32x4 v) { asm volatile("global_store_dwordx4 %0, %1, off sc1\n\ts_nop 1" :: "v"(p), "v"(v) : "memory"); }
__device__ __forceinline__ float wave_sum(float v) {
#pragma unroll
    for (int o = 1; o < 64; o <<= 1) v += __shfl_xor(v, o);
    return v;
}

namespace pg8 {
constexpr int BM = 256, BK = 64, HALF = 128, HTB = HALF * BK * 2, STAGE_BYTES = 8 * HTB;
__host__ __device__ __forceinline__ int lds_byte(int r, int c) { const int st = (r >> 4) * 2 + (c >> 5), rr = r & 15, cc = c & 31, ob = rr * 64 + cc * 2; return st * 1024 + (ob ^ (((ob >> 9) & 1) << 5)); }
__host__ __device__ __forceinline__ void stage_rc(int b, int& R, int& C) { const int st = b / 1024, sb = b % 1024, swz = sb ^ (((sb >> 9) & 1) << 5); R = (st >> 1) * 16 + swz / 64; C = (st & 1) * 32 + (swz % 64) / 2; }
__host__ __device__ __forceinline__ int perm32(int rho) { const int n = rho >> 4, i = rho & 15; return 8 * (i >> 2) + 4 * n + (i & 3); }

struct GU {
    const char* A;
    const char* B;
    int lda, ldb;
    int nt;
    int zero;
    int gslot;
    int pm, pn, aux;
    int eslot;
};

__device__ __forceinline__ bool static_tile(int i, int G, int c, int nM, int nN, int& pm, int& pn) {
    const int nwg = nM * nN; const long L = (long)i * G + c; if (L >= nwg) return false;
    int wgid = (int)L; { const int q = nwg / 8, r = nwg % 8, xcd = wgid % 8, off = wgid / 8; wgid = (xcd < r ? xcd * (q + 1) : r * (q + 1) + (xcd - r) * q) + off; }
    const int nig = 8 * nN, gid = wgid / nig, fm = gid * 8, gsz = (nM - fm) < 8 ? (nM - fm) : 8;
    pm = fm + ((wgid % nig) % gsz); pn = (wgid % nig) / gsz; return true;
}

template <class Epi, class Sched, bool GATHER, bool ALIGN_EPI>
__device__ __forceinline__ void gemm_run(LAS unsigned char* lds, const LAS int* gidx, const Sched& S, const Epi& E) {
    const int tid = threadIdx.x, wid = __builtin_amdgcn_readfirstlane(tid >> 6), lane = tid & 63, wr = wid >> 2, wc = wid & 3, fr = lane & 15, fq = lane >> 4;
    int R[2], C2[2], Rb[2];
#pragma unroll
    for (int i = 0; i < 2; ++i) { int C; stage_rc(tid * 16 + i * 8192, R[i], C); C2[i] = C * 2; Rb[i] = Epi::PERM ? ((R[i] & ~31) + perm32(R[i] & 31)) : R[i]; }
    const unsigned ldsw = (unsigned)wid * 1024u;
    const int aoff = lds_byte(wr * 64 + fr, fq * 8), boff = lds_byte(wc * 32 + fr, fq * 8);
#define PG8_SA(b, h) (((b) * 2 + (h)) * HTB)
#define PG8_SB(b, h) ((4 + (b) * 2 + (h)) * HTB)
#define PG8_STAGE(bufoff, gbase, voff) do { _Pragma("unroll") for (int _i = 0; _i < 2; ++_i) \
        __builtin_amdgcn_global_load_lds((const unsigned*)((const char*)(gbase) + (voff)[_i]), (LAS unsigned*)(lds + (bufoff) + ldsw + _i * 8192), 16, 0, 0); } while (0)
#define PG8_LDA(dst, b, h) do { _Pragma("unroll") for (int m = 0; m < 4; ++m) _Pragma("unroll") for (int k = 0; k < 2; ++k) dst[m][k] = *(const LAS bf16x8*)(lds + PG8_SA(b, h) + aoff + m * 2048 + k * 1024); } while (0)
#define PG8_LDB(dst, b, h) do { _Pragma("unroll") for (int n = 0; n < 2; ++n) _Pragma("unroll") for (int k = 0; k < 2; ++k) dst[n][k] = *(const LAS bf16x8*)(lds + PG8_SB(b, h) + boff + n * 2048 + k * 1024); } while (0)
#define PG8_MMA(ai, bj, At, Bt) do { __builtin_amdgcn_s_setprio(1); _Pragma("unroll") for (int m = 0; m < 4; ++m) _Pragma("unroll") for (int n = 0; n < 2; ++n) _Pragma("unroll") for (int k = 0; k < 2; ++k) \
        acc[ai][bj][m][n] = __builtin_amdgcn_mfma_f32_16x16x32_bf16(Bt[n][k], At[m][k], acc[ai][bj][m][n], 0, 0, 0); __builtin_amdgcn_s_setprio(0); } while (0)
#define PG8_WAIT_V(n) asm volatile("s_waitcnt vmcnt(" #n ")" ::: "memory")
#define PG8_WAIT_L(n) asm volatile("s_waitcnt lgkmcnt(" #n ")" ::: "memory")
#define PG8_BAR __builtin_amdgcn_s_barrier()
#define PG8_SCHED __builtin_amdgcn_sched_barrier(0)
#define PG8_SETV(u) do { _Pragma("unroll") for (int _i = 0; _i < 2; ++_i) { int r0, r1; \
        if (GATHER && (u).gslot >= 0) { r0 = gidx[(u).gslot * 256 + R[_i]]; r1 = gidx[(u).gslot * 256 + 128 + R[_i]]; } else { r0 = R[_i]; r1 = R[_i] + 128; } \
        vA[0][_i] = (unsigned)(r0 * (u).lda + C2[_i]); vA[1][_i] = (unsigned)(r1 * (u).lda + C2[_i]); vB[_i] = (unsigned)(Rb[_i] * (u).ldb + C2[_i]); } hB = (unsigned)(128 * (u).ldb); } while (0)
    GU cur, nxt; int ui = 0; int pend = -1;
    if (!S.next(0, cur)) return;
    f32x4 acc[2][2][4][2];
#pragma unroll
    for (int a = 0; a < 2; ++a)
#pragma unroll
        for (int b = 0; b < 2; ++b)
#pragma unroll
            for (int m = 0; m < 4; ++m)
#pragma unroll
                for (int n = 0; n < 2; ++n) acc[a][b][m][n] = (f32x4){0.f, 0.f, 0.f, 0.f};
    bf16x8 At[4][2], B0[2][2], B1[2][2];
    unsigned vA[2][2], vB[2], hB;
    S.a_ready(cur);
    PG8_SETV(cur);
    const char* sA = cur.A; const char* sB = cur.B;
    PG8_STAGE(PG8_SB(0, 0), sB, vB); PG8_STAGE(PG8_SB(0, 1), sB + hB, vB); PG8_STAGE(PG8_SA(0, 0), sA, vA[0]); PG8_STAGE(PG8_SA(0, 1), sA, vA[1]);
    if (wr == 1) PG8_BAR;
    PG8_WAIT_V(2); PG8_BAR;
    PG8_STAGE(PG8_SB(1, 0), sB + 128, vB); PG8_STAGE(PG8_SA(1, 0), sA + 128, vA[0]); PG8_STAGE(PG8_SB(1, 1), sB + hB + 128, vB);
    PG8_WAIT_V(6); PG8_BAR;
    sA += 256; sB += 256;
    for (;;) {
        bool has_next = false;
        const int nt = cur.nt;
        for (int t = 0; t < nt; t += 2) {
            const bool last = (t == nt - 2);
            PG8_LDB(B0, 0, 0); PG8_LDB(B1, 0, 1); PG8_SCHED; PG8_LDA(At, 0, 0); PG8_STAGE(PG8_SA(1, 1), sA - 128, vA[1]);
            PG8_WAIT_V(8); PG8_WAIT_L(0); PG8_BAR; PG8_MMA(0, 0, At, B0); PG8_MMA(0, 1, At, B1); PG8_BAR; PG8_SCHED;
            if (last) {
                has_next = S.next(ui + 1, nxt);
                if (has_next) { S.a_ready(nxt); PG8_SETV(nxt); sA = nxt.A; sB = nxt.B; } else { sA = cur.A; sB = cur.B; }
            }
            PG8_LDA(At, 0, 1); PG8_STAGE(PG8_SB(0, 0), sB, vB); PG8_STAGE(PG8_SB(0, 1), sB + hB, vB); PG8_STAGE(PG8_SA(0, 0), sA, vA[0]);
            PG8_WAIT_V(8);
            if constexpr (Epi::DEFER_PUBLISH) { if (pend >= 0) { E.publish(pend, lane); pend = -1; } }
            PG8_WAIT_L(0); PG8_BAR; PG8_MMA(1, 0, At, B0); PG8_MMA(1, 1, At, B1); PG8_BAR; PG8_SCHED;
            PG8_LDB(B0, 1, 0); PG8_LDB(B1, 1, 1); PG8_SCHED; PG8_LDA(At, 1, 0); PG8_STAGE(PG8_SA(0, 1), sA, vA[1]);
            PG8_WAIT_V(8); PG8_WAIT_L(0); PG8_BAR; PG8_MMA(0, 0, At, B0); PG8_MMA(0, 1, At, B1); PG8_BAR; PG8_SCHED;
            PG8_LDA(At, 1, 1); PG8_STAGE(PG8_SB(1, 0), sB + 128, vB); PG8_STAGE(PG8_SB(1, 1), sB + hB + 128, vB); PG8_STAGE(PG8_SA(1, 0), sA + 128, vA[0]);
            PG8_WAIT_V(8); PG8_WAIT_L(0); PG8_BAR; PG8_MMA(1, 0, At, B0); PG8_MMA(1, 1, At, B1); PG8_BAR; PG8_SCHED;
            sA += 256; sB += 256;
        }
        if constexpr (ALIGN_EPI) { if (wr == 0) PG8_BAR; }
        if constexpr (!Epi::AFTER_DRAIN) { E(acc, cur, wr, wc, fr, fq); }
        if constexpr (Epi::DEFER_PUBLISH) { if (E.wants_publish(cur)) pend = cur.pm; }
        if (!has_next) break;
        if (nxt.zero) {
#pragma unroll
            for (int a = 0; a < 2; ++a)
#pragma unroll
                for (int b = 0; b < 2; ++b)
#pragma unroll
                    for (int m = 0; m < 4; ++m)
#pragma unroll
                        for (int n = 0; n < 2; ++n) acc[a][b][m][n] = (f32x4){0.f, 0.f, 0.f, 0.f};
        }
        cur = nxt; ++ui;
        if constexpr (ALIGN_EPI) { if (wr == 1) PG8_BAR; }
    }
    PG8_WAIT_V(0);
    if constexpr (Epi::DEFER_PUBLISH) { if (pend >= 0) { E.publish(pend, lane); pend = -1; } }
    if constexpr (!ALIGN_EPI) { if (wr == 0) PG8_BAR; }
    PG8_BAR;
    if constexpr (Epi::AFTER_DRAIN) { E.fused(acc, cur, wr, wc, fr, fq, lds, wid, lane); }
#undef PG8_SA
#undef PG8_SB
#undef PG8_STAGE
#undef PG8_LDA
#undef PG8_LDB
#undef PG8_MMA
#undef PG8_WAIT_V
#undef PG8_WAIT_L
#undef PG8_BAR
#undef PG8_SCHED
#undef PG8_SETV
}
}

#define XB_TMO      128
#define XB_XCNT(j)  (256  + 64 * (j))
#define XB_XSUB(j)  (1280 + 64 * (j))
#define XB_XGEN(j)  (2304 + 64 * (j))
#define XB_TOP      3328
#define XB_TOPGEN   3392
#define XCD_BAR_WORDS 3456
#define XB_SPIN_CAP (1u << 18)
__device__ __forceinline__ unsigned xb_ld(unsigned* p)              { return __hip_atomic_load(p, __ATOMIC_RELAXED, __HIP_MEMORY_SCOPE_AGENT); }
__device__ __forceinline__ unsigned xb_add(unsigned* p, unsigned v) { return __hip_atomic_fetch_add(p, v, __ATOMIC_RELAXED, __HIP_MEMORY_SCOPE_AGENT); }
__device__ __forceinline__ unsigned xb_xcc_id() { return (unsigned)__builtin_amdgcn_s_getreg((3 << 11) | 20) & 0xFu; }
#define XB_SPIN(cond, bar) do { unsigned _sp = 0; while (cond) { __builtin_amdgcn_s_sleep(1); \
    if ((++_sp & 255u) == 0u) { if (xb_ld(&(bar)[XB_TMO])) break; if (_sp > XB_SPIN_CAP) { atomicAdd(&(bar)[XB_TMO], 1u); break; } } } } while (0)
struct XcdBarrier { unsigned* bar; unsigned x; volatile LAS unsigned* st; };
__device__ __forceinline__ XcdBarrier xcd_barrier_post(unsigned* bar, volatile LAS unsigned* st) {
    XcdBarrier b; b.bar = bar; b.x = xb_xcc_id(); b.st = st;
    if (threadIdx.x == 0) (void)xb_add(&bar[XB_XCNT(b.x)], 1u);
    return b;
}
__device__ __forceinline__ void xcd_barrier_complete(unsigned* bar, unsigned x, unsigned& nloc, unsigned& nx) {
    const unsigned G = gridDim.x * gridDim.y * gridDim.z;
    unsigned sum, cnt, mine, sp = 0u;
    for (;;) {
        sum = 0u; cnt = 0u; mine = 0u;
#pragma unroll
        for (unsigned j = 0; j < 16; ++j) { const unsigned c = xb_ld(&bar[XB_XCNT(j)]); sum += c; cnt += (c > 0u) ? 1u : 0u; mine = (j == x) ? c : mine; }
        if (sum == G) break;
        __builtin_amdgcn_s_sleep(1);
        if ((++sp & 255u) == 0u) { if (xb_ld(&bar[XB_TMO])) break; if (sp > XB_SPIN_CAP) { atomicAdd(&bar[XB_TMO], 1u); break; } }
    }
    nloc = mine > 0u ? mine : 1u; nx = cnt > 0u ? cnt : 1u;
}
__device__ __forceinline__ void xcd_barrier(const XcdBarrier& b) {
    asm volatile("s_waitcnt vmcnt(0)" ::: "memory");
    __syncthreads();
    if (threadIdx.x == 0) {
        unsigned* bar = b.bar;
        __builtin_amdgcn_s_waitcnt(0);
        unsigned nloc = b.st[0], nx = b.st[1];
        if (nloc == 0u) { xcd_barrier_complete(bar, b.x, nloc, nx); b.st[0] = nloc; b.st[1] = nx; }
        const unsigned old = xb_add(&bar[XB_XSUB(b.x)], 1u);
        const unsigned gen = old / nloc;
        if (old + 1u == (gen + 1u) * nloc) {
            __builtin_amdgcn_fence(__ATOMIC_RELEASE, "agent");
            asm volatile("s_waitcnt vmcnt(0)" ::: "memory");
            const unsigned og = xb_add(&bar[XB_TOP], 1u);
            const unsigned tg = og / nx;
            if (og + 1u == (tg + 1u) * nx) xb_add(&bar[XB_TOPGEN], 1u);
            else XB_SPIN(xb_ld(&bar[XB_TOPGEN]) == tg, bar);
            __builtin_amdgcn_fence(__ATOMIC_ACQUIRE, "agent");
            xb_add(&bar[XB_XGEN(b.x)], 1u);
            asm volatile("s_waitcnt vmcnt(0)" ::: "memory");
        } else {
            XB_SPIN(xb_ld(&bar[XB_XGEN(b.x)]) == gen, bar);
            __builtin_amdgcn_fence(__ATOMIC_ACQUIRE, "agent");
            asm volatile("s_waitcnt vmcnt(0)" ::: "memory");
        }
    }
    __syncthreads();
}

struct Frame {
    LAS unsigned char* lds;
    unsigned* ctl;
    int tid, lane, wave, vcu, G, bx;
    const float *x, *c, *w_ada, *b_ada, *g_mix, *w_in, *sink, *w_a, *w_b, *w_out, *g_ffn, *w_group, *b_group, *w_route, *b_route, *w_gate, *w_up, *w_down, *g_final;
    const int* positions;
    float* out;
    float *mod, *rcos, *rsin, *wts;
    int* list;
    bf16 *WrT, *WaT, *WbT, *WoT, *WinT, *GUT, *DT, *H, *OA, *OB, *QA, *KA, *VAT, *QB, *KB, *VBT, *MERGED, *ACT, *Y, *X1;
    unsigned char *SGA, *SGB;
};

__device__ const double INVF[32] = {1, 0.74989420933245587, 0.56234132519034907, 0.42169650342858223, 0.31622776601683794, 0.23713737056616552, 0.17782794100389229, 0.1333521432163324,
    0.10000000000000001, 0.074989420933245579, 0.056234132519034911, 0.042169650342858224, 0.031622776601683791, 0.023713737056616554, 0.017782794100389229, 0.013335214321633241,
    0.01, 0.0074989420933245579, 0.005623413251903491, 0.0042169650342858229, 0.0031622776601683794, 0.0023713737056616554, 0.0017782794100389228, 0.0013335214321633241,
    0.001, 0.00074989420933245586, 0.0005623413251903491, 0.00042169650342858224, 0.00031622776601683794, 0.00023713737056616554, 0.00017782794100389227, 0.0001333521432163324};

template <int KIND> __device__ __forceinline__ int rowmap(int n) {
    if (KIND == 0) return n;
    if (KIND == 1) { const bool rp = (n < 1536) || (n >= 2304 && n < 2944); if (!rp) return n; const int j = n & 63; return (n & ~63) + (((j & 31) >> 2) << 3) + ((j >> 5) << 2) + (j & 3); }
    if (KIND == 2) return ((n >> 7) << 8) + (n & 127);
    return ((n >> 7) << 8) + 128 + (n & 127);
}
template <int KIND> __device__ __forceinline__ void transpose_item(const float* W, int K, int N, bf16* WT, int item, int lane) {
    const int nblk = N >> 5, kb = item / nblk, nb = item - kb * nblk, k0 = 64 * kb + 8 * (lane >> 3), n0 = 32 * nb + 4 * (lane & 7);
    f32x4 v[8];
#pragma unroll
    for (int j = 0; j < 8; ++j) v[j] = __builtin_nontemporal_load((const f32x4*)(W + (size_t)(k0 + j) * N + n0));
#pragma unroll
    for (int i = 0; i < 4; ++i) { u32x4 o; o.x = cvtpk(v[0][i], v[1][i]); o.y = cvtpk(v[2][i], v[3][i]); o.z = cvtpk(v[4][i], v[5][i]); o.w = cvtpk(v[6][i], v[7][i]);
        __builtin_nontemporal_store(o, (u32x4*)(WT + (size_t)rowmap<KIND>(n0 + i) * K + k0)); }
}

__device__ __forceinline__ void p0_prologue(Frame& F) {
    {
        LAS float* cs = (LAS float*)(F.lds);
        LAS float* red = (LAS float*)(F.lds + 16384);
        for (int item = F.vcu; item < NMOD / 32; item += F.G) {
            for (int i = F.tid; i < 4096; i += 512) { const float v = F.c[i]; cs[i] = v / (1.0f + __expf(-v)); }
            __syncthreads();
            const int kq = F.tid >> 3, cq = F.tid & 7, n0 = 32 * item + 4 * cq;
            f32x4 a[4];
#pragma unroll
            for (int b = 0; b < 4; ++b) a[b] = (f32x4){0.f, 0.f, 0.f, 0.f};
#pragma unroll 4
            for (int it = 0; it < 16; ++it) { const int k = kq + 64 * it; const f32x4 w = __builtin_nontemporal_load((const f32x4*)(F.w_ada + (size_t)k * NMOD + n0));
#pragma unroll
                for (int b = 0; b < 4; ++b) a[b] += cs[b * 1024 + k] * w; }
#pragma unroll
            for (int b = 0; b < 4; ++b) *(LAS f32x4*)(red + kq * 132 + b * 32 + cq * 4) = a[b];
            __syncthreads();
            if (F.tid < 128) { float s = 0.f; for (int q = 0; q < 64; ++q) s += red[q * 132 + F.tid];
                const int b = F.tid >> 5, col = 32 * item + (F.tid & 31); __hip_atomic_store(F.mod + b * NMOD + col, s + F.b_ada[col], RLX_AGENT); }
            VM_WAIT(); __syncthreads();
            if (F.tid == 0) __hip_atomic_fetch_add(F.ctl + CW_MODCNT, 1u, RLX_AGENT);
        }
    }
    {
        const int gw = F.vcu * 8 + F.wave, NGW = F.G * 8;
        constexpr int I_IN = 16 * 160, I_A = 4 * 32, I_B = 8 * 32, I_O = 16 * 32, I_E = 256;
        constexpr int NITEMS = I_IN + I_A + I_B + I_O + NEXP * 3 * I_E;
        for (int it = gw; it < NITEMS; it += NGW) {
            int r = it;
            if (r < I_IN) { transpose_item<1>(F.w_in, DM, NIN, F.WinT, r, F.lane); continue; } r -= I_IN;
            if (r < I_A) { transpose_item<0>(F.w_a, 256, DM, F.WaT, r, F.lane); continue; } r -= I_A;
            if (r < I_B) { transpose_item<0>(F.w_b, 512, DM, F.WbT, r, F.lane); continue; } r -= I_B;
            if (r < I_O) { transpose_item<0>(F.w_out, DM, DM, F.WoT, r, F.lane); continue; } r -= I_O;
            const int e = r / (3 * I_E), q = r - e * 3 * I_E;
            if (q < I_E) transpose_item<2>(F.w_gate + (size_t)e * DM * DEXP, DM, DEXP, F.GUT + (size_t)e * 1024 * 1024, q, F.lane);
            else if (q < 2 * I_E) transpose_item<3>(F.w_up + (size_t)e * DM * DEXP, DM, DEXP, F.GUT + (size_t)e * 1024 * 1024, q - I_E, F.lane);
            else transpose_item<0>(F.w_down + (size_t)e * DEXP * DM, DEXP, DM, F.DT + (size_t)e * 1024 * 512, q - 2 * I_E, F.lane);
        }
    }
    {
        const int gt = F.vcu * 512 + F.tid, NT = F.G * 512;
        for (int idx = gt; idx < MT * 32; idx += NT) { const int tok = idx >> 5, i = idx & 31;
            double rev = (double)F.positions[tok] * INVF[i] * 0.15915494309189535; rev -= __builtin_rint(rev);
            const float fr = (float)rev; F.rcos[idx] = __builtin_amdgcn_cosf(fr); F.rsin[idx] = __builtin_amdgcn_sinf(fr); }
        for (int idx = gt; idx < 256 * 1024; idx += NT) { const int n = idx >> 10, k = idx & 1023;
            const float v = n < 4 ? F.w_group[k * 4 + n] : (n < 36 ? F.w_route[k * 32 + (n - 4)] : 0.f);
            F.WrT[idx] = (bf16)(cvtpk(v, 0.f) & 0xffffu); }
    }
    if (F.tid == 0) {
        unsigned sp = 0; while (__hip_atomic_load(F.ctl + CW_MODCNT, RLX_AGENT) < (unsigned)(NMOD / 32)) { __builtin_amdgcn_s_sleep(2); if (++sp > (1u << 22)) break; }
        __builtin_amdgcn_fence(__ATOMIC_ACQUIRE, "agent"); VM_WAIT();
    }
    __syncthreads();
}

__device__ __forceinline__ void norm_rows(Frame& F, const float* src, const float* g, int sh_off, int sc_off, bf16* dst) {
    const int gw = F.vcu * 8 + F.wave, NGW = F.G * 8;
    for (int m0 = gw; m0 < MT; m0 += 4 * NGW) {
        f32x4 v[4][4]; float s[4];
#pragma unroll
        for (int q = 0; q < 4; ++q) { const int m = m0 + q * NGW; s[q] = 0.f;
            if (m < MT) { const f32x4* xr = (const f32x4*)(src + (size_t)m * DM) + F.lane;
#pragma unroll
                for (int j = 0; j < 4; ++j) v[q][j] = xr[64 * j]; } }
#pragma unroll
        for (int q = 0; q < 4; ++q) { const int m = m0 + q * NGW; if (m >= MT) continue;
#pragma unroll
            for (int j = 0; j < 4; ++j) s[q] += (v[q][j].x * v[q][j].x + v[q][j].y * v[q][j].y) + (v[q][j].z * v[q][j].z + v[q][j].w * v[q][j].w);
            const float rinv = 1.0f / sqrtf(wave_sum(s[q]) * (1.0f / DM) + RMS_EPS);
            const float* md = F.mod + (m >> 12) * NMOD;
#pragma unroll
            for (int j = 0; j < 4; ++j) { const int col = 4 * (F.lane + 64 * j);
                const f32x4 g4 = *(const f32x4*)(g + col), sc = *(const f32x4*)(md + sc_off + col), sh = *(const f32x4*)(md + sh_off + col);
                const f32x4 h = v[q][j] * rinv * g4 * (1.0f + sc) + sh;
                u32x2 o; o.x = cvtpk(h.x, h.y); o.y = cvtpk(h.z, h.w);
                *(u32x2*)(dst + (size_t)m * DM + col) = o; } }
    }
}

using pg8::GU;
struct SchedTiles {
    const char* A; const char* B; int lda, ldb, nt, nM, nN, G, c;
    __device__ __forceinline__ bool next(int i, GU& u) const {
        int pm, pn; if (!pg8::static_tile(i, G, c, nM, nN, pm, pn)) return false;
        u.A = A + (size_t)pm * 256 * lda; u.B = B + (size_t)pn * 256 * ldb; u.lda = lda; u.ldb = ldb; u.nt = nt; u.zero = 1; u.gslot = 0; u.pm = pm; u.pn = pn; u.aux = 0; u.eslot = 0; return true;
    }
    __device__ __forceinline__ void a_ready(const GU&) const {}
};
struct SchedBranch {
    const char* OA; const char* OB; const char* WaT; const char* WbT; int G, c;
    __device__ __forceinline__ bool next(int i, GU& u) const {
        int pm, pn; if (!pg8::static_tile(i >> 1, G, c, 64, 4, pm, pn)) return false;
        if ((i & 1) == 0) { u.A = OB + (size_t)pm * 256 * 1024; u.B = WbT + (size_t)pn * 256 * 1024; u.lda = 1024; u.ldb = 1024; u.nt = 8; u.zero = 1; u.aux = 0; }
        else { u.A = OA + (size_t)pm * 256 * 512; u.B = WaT + (size_t)pn * 256 * 512; u.lda = 512; u.ldb = 512; u.nt = 4; u.zero = 0; u.aux = 1; }
        u.gslot = 0; u.pm = pm; u.pn = pn; u.eslot = 0; return true;
    }
    __device__ __forceinline__ void a_ready(const GU&) const {}
};
__device__ __forceinline__ int moe_deal(int i, int c, int G, int n4) {
    const int q = n4 / G, r = n4 - q * G, n7 = q + (c < r ? 1 : 0);
    if (i < n7) return i * G + c;
    const int k = i - n7, Lc = G - r; int j;
    if (c >= r) j = k == 0 ? (c - r) : (k == 1 ? Lc + (c - r) : 2 * Lc + (k - 2) * G + c);
    else j = 2 * Lc + k * G + c;
    return j < n4 ? n4 + j : -1;
}
struct SchedMoe {
    const char* H; const char* ACT; const char* GUT; const char* DT; const LAS int* rbtab; unsigned* cnt; int n4, n7, G, c;
    __device__ __forceinline__ bool next(int i, GU& u) const {
        const int t = moe_deal(i, c, G, n4); if (t < 0) return false;
        if (t < n4) { const int rb = t >> 2, pn = t & 3, e = rbtab[rb] >> 8;
            u.A = H; u.B = GUT + (size_t)e * (1024 * 2048) + (size_t)pn * 256 * 2048; u.lda = 2048; u.ldb = 2048; u.nt = 16; u.gslot = i; u.eslot = 0; u.pm = rb; u.pn = pn; u.aux = 0; }
        else { const int j = t - n4, rb = j >> 2, pn = j & 3, e = rbtab[rb] >> 8;
            u.A = ACT + (size_t)rb * 256 * 1024; u.B = DT + (size_t)e * (1024 * 1024) + (size_t)pn * 256 * 1024; u.lda = 1024; u.ldb = 1024; u.nt = 8; u.gslot = -1; u.eslot = i - n7; u.pm = rb; u.pn = pn; u.aux = 1; }
        u.zero = 1; return true;
    }
    __device__ __forceinline__ void a_ready(const GU& u) const {
        if (u.aux != 1) return;
        if (threadIdx.x < 64) {
            unsigned sp = 0;
            while ((unsigned)__builtin_amdgcn_readfirstlane(__hip_atomic_load(cnt + 64 * u.pm, RLX_AGENT)) < 32u) { __builtin_amdgcn_s_sleep(2); if (++sp > (1u << 20)) break; }
            __builtin_amdgcn_fence(__ATOMIC_ACQUIRE, "agent");
            asm volatile("s_waitcnt vmcnt(0)" ::: "memory");
        }
        asm volatile("" ::: "memory"); __builtin_amdgcn_s_barrier(); asm volatile("" ::: "memory");
    }
};

__device__ __forceinline__ int strided_row(int s, int sh) { return ((s & ((1 << sh) - 1)) << (12 - sh)) | (s >> sh); }

struct EpiIn {
    static constexpr bool PERM = true, AFTER_DRAIN = false, DEFER_PUBLISH = false;
    bf16 *QA, *KA, *VAT, *QB, *KB, *VBT; unsigned char *SGA, *SGB; const float *rcos, *rsin;
    __device__ __forceinline__ void operator()(f32x4 (&acc)[2][2][4][2], const GU& u, int wr, int wc, int fr, int fq) const {
        const int row0 = u.pm * 256 + wr * 64 + fr;
        if (u.pn >= 12) {
            unsigned char* base = (u.pn < 16 ? SGA : SGB) + (size_t)(u.pm * 4 + ((u.pn - 12) & 3)) * 65536 + (size_t)(((wr * 4 + wc) * 64 + fq * 16 + fr) * 16);
#pragma unroll
            for (int ai = 0; ai < 2; ++ai)
#pragma unroll
                for (int m = 0; m < 4; ++m) { u32x4 w;
#pragma unroll
                    for (int bj = 0; bj < 2; ++bj)
#pragma unroll
                        for (int n = 0; n < 2; ++n) { unsigned p = 0;
#pragma unroll
                            for (int j = 0; j < 4; ++j) p = __builtin_amdgcn_cvt_pk_u8_f32(fmaxf(fsigmoid(acc[ai][bj][m][n][j]) * 255.0f, 1.0f), j, p);
                            w[bj * 2 + n] = p; }
                    *(u32x4*)(base + (size_t)(ai * 4 + m) * 8192) = w; }
            return;
        }
#pragma unroll
        for (int bj = 0; bj < 2; ++bj) {
            const int blk = 2 * u.pn + bj;
            const int pc = 32 * (wc & 1) + 8 * fq;
            if (blk < 12 || (blk >= 18 && blk < 23)) {
                const bool isq = (blk < 6) || (blk >= 18 && blk < 22);
                const float sc = isq ? QSCALE : 1.0f;
                const int g4 = 4 * (pc >> 3);
                bf16* base; int hd, nh, sh;
                if (blk < 6) { base = QA; hd = 2 * blk + (wc >> 1); nh = 12; sh = 2 * (hd >> 2); }
                else if (blk < 12) { base = KA; hd = 2 * (blk - 6) + (wc >> 1); nh = 12; sh = 2 * (hd >> 2); }
                else if (blk < 22) { base = QB; hd = 2 * (blk - 18) + (wc >> 1); nh = 8; sh = 0; }
                else { base = KB; hd = (wc >> 1); nh = 2; sh = 0; }
                f32x4 cs[2][4], sn[2][4];
#pragma unroll
                for (int ai = 0; ai < 2; ++ai)
#pragma unroll
                    for (int m = 0; m < 4; ++m) { const size_t ro = (size_t)(row0 + ai * 128 + m * 16) * 32 + g4; cs[ai][m] = *(const f32x4*)(rcos + ro); sn[ai][m] = *(const f32x4*)(rsin + ro); }
#pragma unroll
                for (int ai = 0; ai < 2; ++ai)
#pragma unroll
                    for (int m = 0; m < 4; ++m) {
                        const int row = row0 + ai * 128 + m * 16, b = row >> 12, s = row & 4095;
                        const f32x4 x1 = acc[ai][bj][m][0], x2 = acc[ai][bj][m][1];
                        const f32x4 o1 = (x1 * cs[ai][m] - x2 * sn[ai][m]) * sc, o2 = (x2 * cs[ai][m] + x1 * sn[ai][m]) * sc;
                        u32x4 w; w.x = cvtpk(o1[0], o1[1]); w.y = cvtpk(o1[2], o1[3]); w.z = cvtpk(o2[0], o2[1]); w.w = cvtpk(o2[2], o2[3]);
                        const int srow = strided_row(s, sh), q8 = pc >> 3;
                        *(u32x4*)(base + ((size_t)(b * nh + hd) * 4096 + (srow & ~31)) * 64 + (q8 >> 1) * 512 + (32 * (q8 & 1) + (srow & 31)) * 8) = w;
                    }
            } else if (blk < 24) {
                bf16* base; int hd, nh, sh;
                if (blk < 18) { base = VAT; hd = 2 * (blk - 12) + (wc >> 1); nh = 12; sh = 2 * (hd >> 2); }
                else { base = VBT; hd = (wc >> 1); nh = 2; sh = 0; }
                if (sh == 4) {
#pragma unroll
                    for (int ai = 0; ai < 2; ++ai) {
                        const int row = row0 + ai * 128, b = row >> 12, s = row & 4095;
                        const int srow = strided_row(s, 4), kap = srow & 31;
                        bf16* p = base + ((size_t)(b * nh + hd) * 4096 + (srow & ~31)) * 64 + ((pc >> 5) * 2 + (kap >> 4)) * 512 + (32 * ((kap >> 2) & 1) + (pc & 31)) * 8 + 4 * ((kap >> 3) & 1);
#pragma unroll
                        for (int n = 0; n < 2; ++n)
#pragma unroll
                            for (int j = 0; j < 4; ++j) { u32x2 w; w.x = cvtpk(acc[ai][bj][0][n][j], acc[ai][bj][1][n][j]); w.y = cvtpk(acc[ai][bj][2][n][j], acc[ai][bj][3][n][j]);
                                *(u32x2*)(p + (4 * n + j) * 8) = w; }
                    }
                } else {
#pragma unroll
                for (int ai = 0; ai < 2; ++ai)
#pragma unroll
                    for (int m = 0; m < 4; ++m) {
                        const int row = row0 + ai * 128 + m * 16, b = row >> 12, s = row & 4095;
                        const int srow = strided_row(s, sh), kap = srow & 31;
                        bf16* p = base + ((size_t)(b * nh + hd) * 4096 + (srow & ~31)) * 64 + ((pc >> 5) * 2 + (kap >> 4)) * 512 + (32 * ((kap >> 2) & 1) + (pc & 31)) * 8 + 4 * ((kap >> 3) & 1) + (kap & 3);
                        const f32x4 v0 = acc[ai][bj][m][0], v1 = acc[ai][bj][m][1];
                        const unsigned a = cvtpk(v0[0], v0[1]), bb = cvtpk(v0[2], v0[3]), c = cvtpk(v1[0], v1[1]), d = cvtpk(v1[2], v1[3]);
                        p[0 * 8] = (bf16)(a & 0xffffu); p[1 * 8] = (bf16)(a >> 16); p[2 * 8] = (bf16)(bb & 0xffffu); p[3 * 8] = (bf16)(bb >> 16);
                        p[4 * 8] = (bf16)(c & 0xffffu); p[5 * 8] = (bf16)(c >> 16); p[6 * 8] = (bf16)(d & 0xffffu); p[7 * 8] = (bf16)(d >> 16);
                    }
                }
            }
        }
    }
};

struct EpiMerge {
    static constexpr bool PERM = true, AFTER_DRAIN = false, DEFER_PUBLISH = false;
    const unsigned char *SGA, *SGB; bf16* MERGED;
    __device__ __forceinline__ void operator()(f32x4 (&acc)[2][2][4][2], const GU& u, int wr, int wc, int fr, int fq) const {
        const int row0 = u.pm * 256 + wr * 64 + fr, col0 = u.pn * 256 + wc * 32 + 8 * fq;
        const size_t gbase = (size_t)(u.pm * 4 + u.pn) * 65536 + (size_t)(((wr * 4 + wc) * 64 + fq * 16 + fr) * 16);
#pragma unroll
        for (int ai = 0; ai < 2; ++ai)
#pragma unroll
            for (int m = 0; m < 4; ++m) {
                const u32x4 ga = *(const u32x4*)(SGA + gbase + (size_t)(ai * 4 + m) * 8192);
                if (u.aux == 0) {
                    const u32x4 gb = *(const u32x4*)(SGB + gbase + (size_t)(ai * 4 + m) * 8192);
#pragma unroll
                    for (int bj = 0; bj < 2; ++bj)
#pragma unroll
                        for (int n = 0; n < 2; ++n)
#pragma unroll
                            for (int j = 0; j < 4; ++j) acc[ai][bj][m][n][j] *= (float)((gb[bj * 2 + n] >> (8 * j)) & 255u) * frcp((float)((ga[bj * 2 + n] >> (8 * j)) & 255u));
                } else {
#pragma unroll
                    for (int bj = 0; bj < 2; ++bj) { f32x4 v0, v1;
#pragma unroll
                        for (int j = 0; j < 4; ++j) { v0[j] = acc[ai][bj][m][0][j] * ((float)((ga[bj * 2] >> (8 * j)) & 255u) * (1.0f / 255.0f)); v1[j] = acc[ai][bj][m][1][j] * ((float)((ga[bj * 2 + 1] >> (8 * j)) & 255u) * (1.0f / 255.0f)); }
                        u32x4 w; w.x = cvtpk(v0[0], v0[1]); w.y = cvtpk(v0[2], v0[3]); w.z = cvtpk(v1[0], v1[1]); w.w = cvtpk(v1[2], v1[3]);
                        *(u32x4*)(MERGED + (size_t)(row0 + ai * 128 + m * 16) * DM + col0 + bj * 128) = w; }
                }
            }
    }
};

struct EpiX1 {
    static constexpr bool PERM = true, AFTER_DRAIN = false, DEFER_PUBLISH = false;
    const float* x; const float* mod; bf16* X1;
    __device__ __forceinline__ void operator()(f32x4 (&acc)[2][2][4][2], const GU& u, int wr, int wc, int fr, int fq) const {
        const int row0 = u.pm * 256 + wr * 64 + fr, col0 = u.pn * 256 + wc * 32 + 8 * fq, b = (u.pm * 256) >> 12;
        const float* gt = mod + b * NMOD + 2 * DM;
#pragma unroll
        for (int bj = 0; bj < 2; ++bj) { const int col = col0 + bj * 128; const f32x4 g0 = *(const f32x4*)(gt + col), g1 = *(const f32x4*)(gt + col + 4);
#pragma unroll
            for (int ai = 0; ai < 2; ++ai)
#pragma unroll
                for (int m = 0; m < 4; ++m) { const size_t off = (size_t)(row0 + ai * 128 + m * 16) * DM + col;
                    const f32x4 v0 = __builtin_nontemporal_load((const f32x4*)(x + off)) + g0 * acc[ai][bj][m][0], v1 = __builtin_nontemporal_load((const f32x4*)(x + off + 4)) + g1 * acc[ai][bj][m][1];
                    u32x4 w; w.x = cvtpk(v0[0], v0[1]); w.y = cvtpk(v0[2], v0[3]); w.z = cvtpk(v1[0], v1[1]); w.w = cvtpk(v1[2], v1[3]);
                    *(u32x4*)(X1 + off) = w; } }
    }
};

struct EpiMoe {
    static constexpr bool PERM = true, AFTER_DRAIN = false, DEFER_PUBLISH = true;
    bf16* ACT; bf16* Y; const LAS int* dtab; const LAS float* wtab; unsigned* cnt;
    __device__ __forceinline__ bool wants_publish(const GU& u) const { return u.aux == 0; }
    __device__ __forceinline__ void publish(int rb, int lane) const { if (lane == 0) __hip_atomic_fetch_add(cnt + 64 * rb, 1u, RLX_AGENT); }
    __device__ __forceinline__ void operator()(f32x4 (&acc)[2][2][4][2], const GU& u, int wr, int wc, int fr, int fq) const {
        if (u.aux == 0) {
            const int row0 = u.pm * 256 + wr * 64 + fr, col0 = u.pn * 128 + wc * 32 + 8 * fq;
#pragma unroll
            for (int ai = 0; ai < 2; ++ai)
#pragma unroll
                for (int m = 0; m < 4; ++m) { f32x4 a0, a1;
#pragma unroll
                    for (int j = 0; j < 4; ++j) { const float g0 = acc[ai][0][m][0][j], g1 = acc[ai][0][m][1][j]; a0[j] = g0 * fsigmoid(g0) * acc[ai][1][m][0][j]; a1[j] = g1 * fsigmoid(g1) * acc[ai][1][m][1][j]; }
                    u32x4 w; w.x = cvtpk(a0[0], a0[1]); w.y = cvtpk(a0[2], a0[3]); w.z = cvtpk(a1[0], a1[1]); w.w = cvtpk(a1[2], a1[3]);
                    st16_sc1(ACT + (size_t)(row0 + ai * 128 + m * 16) * DEXP + col0, w); }
        } else {
            const int r0 = wr * 64 + fr, col0 = u.pn * 256 + wc * 32 + 8 * fq;
#pragma unroll
            for (int ai = 0; ai < 2; ++ai)
#pragma unroll
                for (int m = 0; m < 4; ++m) { const int r = r0 + ai * 128 + m * 16; const int dest = dtab[u.eslot * 256 + r]; const float w = wtab[u.eslot * 256 + r];
                    if (dest >= 0) {
#pragma unroll
                        for (int bj = 0; bj < 2; ++bj) { const f32x4 v0 = acc[ai][bj][m][0] * w, v1 = acc[ai][bj][m][1] * w;
                            u32x4 o; o.x = cvtpk(v0[0], v0[1]); o.y = cvtpk(v0[2], v0[3]); o.z = cvtpk(v1[0], v1[1]); o.w = cvtpk(v1[2], v1[3]);
                            *(u32x4*)(Y + (size_t)dest * DM + col0 + bj * 128) = o; } } }
        }
    }
};

#define MFMA32(a, b, c) __builtin_amdgcn_mfma_f32_32x32x16_bf16((a), (b), (c), 0, 0, 0)
__device__ __forceinline__ int crow(int reg, int h) { return (reg & 3) + 8 * (reg >> 2) + 4 * h; }
struct KVFrag { bf16x8 k[4], v[4]; };
#define GLD16(dst, ptr, OFF) asm volatile("global_load_dwordx4 %0, %1, off offset:" #OFF : "=v"(dst) : "v"(ptr) : "memory")
__device__ __forceinline__ void kv_load(KVFrag& f, const bf16* kp, const bf16* vp) {
    GLD16(f.k[0], kp, 0); GLD16(f.k[1], kp, 1024); GLD16(f.k[2], kp, 2048); GLD16(f.k[3], kp, 3072);
    GLD16(f.v[0], vp, 0); GLD16(f.v[1], vp, 1024); GLD16(f.v[2], vp, 2048); GLD16(f.v[3], vp, 3072);
}
#define KV_WAIT(f, N) asm volatile("s_waitcnt vmcnt(" #N ")" : "+v"(f.k[0]), "+v"(f.k[1]), "+v"(f.k[2]), "+v"(f.k[3]), "+v"(f.v[0]), "+v"(f.v[1]), "+v"(f.v[2]), "+v"(f.v[3]) :: "memory")
__device__ __forceinline__ void attn_tile(const KVFrag& f, const bf16x8 (&qf)[4], bool first, bool lastt, int r, int h, float& m, float& l, f32x16& o0, f32x16& o1) {
    f32x16 st;
#pragma unroll
    for (int e = 0; e < 16; ++e) st[e] = 0.f;
#pragma unroll
    for (int c = 0; c < 4; ++c) st = MFMA32(f.k[c], qf[c], st);
    if (first || lastt) {
        int rq = r - 4 * h; asm volatile("" : "+v"(rq));
        if (first) {
#pragma unroll
            for (int e = 0; e < 16; ++e) st[e] = ((e & 3) + 8 * (e >> 2) < rq) ? -1.0e30f : st[e];
        } else {
#pragma unroll
            for (int e = 0; e < 16; ++e) st[e] = ((e & 3) + 8 * (e >> 2) > rq) ? -1.0e30f : st[e];
        }
    }
    float tm = st[0];
#pragma unroll
    for (int e = 1; e < 16; ++e) tm = fmaxf(tm, st[e]);
    tm = fmaxf(tm, __shfl_xor(tm, 32));
    const float mn = fmaxf(m, tm), alpha = fexp2(m - mn); m = mn;
    float ps = 0.f;
#pragma unroll
    for (int e = 0; e < 16; ++e) { st[e] = fexp2(st[e] - mn); ps += st[e]; }
    l = l * alpha + ps;
#pragma unroll
    for (int e = 0; e < 16; ++e) { o0[e] *= alpha; o1[e] *= alpha; }
    u32x4 pa, pb;
    pa.x = cvtpk(st[0], st[1]); pa.y = cvtpk(st[2], st[3]); pa.z = cvtpk(st[4], st[5]); pa.w = cvtpk(st[6], st[7]);
    pb.x = cvtpk(st[8], st[9]); pb.y = cvtpk(st[10], st[11]); pb.z = cvtpk(st[12], st[13]); pb.w = cvtpk(st[14], st[15]);
    const bf16x8 p0 = __builtin_bit_cast(bf16x8, pa), p1 = __builtin_bit_cast(bf16x8, pb);
    o0 = MFMA32(f.v[0], p0, o0); o0 = MFMA32(f.v[1], p1, o0);
    o1 = MFMA32(f.v[2], p0, o1); o1 = MFMA32(f.v[3], p1, o1);
}
template <int W>
__device__ __forceinline__ void attn_job(const bf16* __restrict__ Qp, const bf16* __restrict__ Kp, const bf16* __restrict__ Vp, int L, int t0, float m0, float l0,
                                         f32x16& o0, f32x16& o1, float& m_out, float& l_out, int lane) {
    constexpr int NT = 2 * W / 32 + 1;
    const int r = lane & 31, h = lane >> 5;
    bf16x8 qf[4];
    { const bf16* qp = Qp + (size_t)(t0 >> 5) * 2048 + lane * 8; GLD16(qf[0], qp, 0); GLD16(qf[1], qp, 1024); GLD16(qf[2], qp, 2048); GLD16(qf[3], qp, 3072); }
    float m = m0, l = (h == 0) ? l0 : 0.f;
#pragma unroll
    for (int i = 0; i < 16; ++i) { o0[i] = 0.f; o1[i] = 0.f; }
    const int i_lo = (W - t0) > 0 ? ((W - t0) >> 5) : 0, i_hi = ((L - t0 + W) >> 5) < NT ? ((L - t0 + W) >> 5) : NT;
    const bf16* kq = Kp + lane * 8; const bf16* vq = Vp + lane * 8;
#define TILE_OFF(ii) ((size_t)((t0 - W + 32 * ((ii) < i_hi ? (ii) : i_hi - 1)) >> 5) * 2048)
    KVFrag fa, fb;
    int i = i_lo;
    kv_load(fa, kq + TILE_OFF(i), vq + TILE_OFF(i));
#pragma unroll 1
    for (;;) {
        kv_load(fb, kq + TILE_OFF(i + 1), vq + TILE_OFF(i + 1));
        KV_WAIT(fa, 8); asm volatile("" : "+v"(qf[0]), "+v"(qf[1]), "+v"(qf[2]), "+v"(qf[3]));
        attn_tile(fa, qf, i == 0, i == NT - 1, r, h, m, l, o0, o1);
        if (++i >= i_hi) break;
        kv_load(fa, kq + TILE_OFF(i + 1), vq + TILE_OFF(i + 1));
        KV_WAIT(fb, 8);
        attn_tile(fb, qf, i == 0, i == NT - 1, r, h, m, l, o0, o1);
        if (++i >= i_hi) break;
    }
    KV_WAIT(fa, 0); KV_WAIT(fb, 0);
#undef TILE_OFF
    l += __shfl_xor(l, 32);
    m_out = m; l_out = l;
}

constexpr int PSTRIDE = 136;
__device__ __forceinline__ void attn_phase(Frame& F) {
    LAS unsigned char* P = F.lds;
    LAS f32x2* ML = (LAS f32x2*)(F.lds + 3 * 256 * PSTRIDE);
    const int lane = F.lane, r = lane & 31, h = lane >> 5;
    for (int uidx = F.vcu; uidx < 512; uidx += F.G) {
        if (uidx < 256) {
            const int b = uidx >> 6, hs = (uidx >> 4) & 3, c = uidx & 15;
#pragma unroll 1
            for (int jj = 0; jj < 4; ++jj) {
                const int j = F.wave + 8 * jj;
                int g, head, res, t0, L, slot; bool valid = true;
                if (j < 8) { g = 0; head = hs; res = 0; t0 = 256 * c + 32 * j; L = 4096; slot = 32 * j + r; }
                else if (j < 16) { const int q = j - 8; g = 1; head = 4 + hs; res = q >> 1; t0 = 64 * c + 32 * (q & 1); L = 1024; slot = res * 64 + 32 * (q & 1) + r; }
                else { const int q = j - 16; g = 2; head = 8 + hs; res = q; t0 = 32 * (c >> 1); L = 256; valid = (r >> 4) == (c & 1); slot = res * 16 + (r & 15); }
                const size_t hb = (size_t)(b * 12 + head);
                const bf16* Qp = F.QA + (hb * 4096 + (size_t)res * L) * 64;
                const bf16* Kp = F.KA + (hb * 4096 + (size_t)res * L) * 64;
                const bf16* Vt = F.VAT + (hb * 4096 + (size_t)res * L) * 64;
                f32x16 o0, o1; float m, l;
                attn_job<64>(Qp, Kp, Vt, L, t0, -1.0e30f, 0.f, o0, o1, m, l, lane);
                if (valid) {
                    LAS unsigned char* row = P + (g * 256 + slot) * PSTRIDE;
#pragma unroll
                    for (int q4 = 0; q4 < 4; ++q4) {
                        u32x2 w0, w1; w0.x = cvtpk(o0[4 * q4], o0[4 * q4 + 1]); w0.y = cvtpk(o0[4 * q4 + 2], o0[4 * q4 + 3]); w1.x = cvtpk(o1[4 * q4], o1[4 * q4 + 1]); w1.y = cvtpk(o1[4 * q4 + 2], o1[4 * q4 + 3]);
                        *(LAS u32x2*)(row + (8 * q4 + 4 * h) * 2) = w0; *(LAS u32x2*)(row + (32 + 8 * q4 + 4 * h) * 2) = w1; }
                    if (h == 0) ML[g * 256 + slot] = (f32x2){m, l};
                }
            }
            __syncthreads();
            {
                const int tau = F.tid >> 1, half = F.tid & 1;
                const int s0 = tau, s1 = 256 + (tau & 3) * 64 + (tau >> 2), s2 = 512 + (tau & 15) * 16 + (tau >> 4);
                const f32x2 a0 = ML[s0], a1 = ML[s1], a2 = ML[s2];
                const float M = fmaxf(a0.x, fmaxf(a1.x, a2.x));
                float w0 = fexp2(a0.x - M), w1 = fexp2(a1.x - M), w2 = fexp2(a2.x - M);
                const float inv = 1.0f / (w0 * a0.y + w1 * a1.y + w2 * a2.y); w0 *= inv; w1 *= inv; w2 *= inv;
                bf16* dst = F.OA + (size_t)(b * 4096 + 256 * c + tau) * 256 + hs * 64 + 32 * half;
#pragma unroll
                for (int q = 0; q < 4; ++q) {
                    const u32x4 x0 = *(const LAS u32x4*)(P + s0 * PSTRIDE + (32 * half + 8 * q) * 2), x1 = *(const LAS u32x4*)(P + s1 * PSTRIDE + (32 * half + 8 * q) * 2), x2 = *(const LAS u32x4*)(P + s2 * PSTRIDE + (32 * half + 8 * q) * 2);
                    u32x4 o;
#pragma unroll
                    for (int k = 0; k < 4; ++k) { const float lo = w0 * bflo(x0[k]) + w1 * bflo(x1[k]) + w2 * bflo(x2[k]), hi = w0 * bfhi(x0[k]) + w1 * bfhi(x1[k]) + w2 * bfhi(x2[k]); o[k] = cvtpk(lo, hi); }
                    *(u32x4*)(dst + 8 * q) = o; }
            }
            __syncthreads();
        } else {
            const int uu = uidx - 256, b = uu >> 6, kvh = (uu >> 5) & 1, qb = uu & 31, T0 = 4 * qb - 4;
            const bf16* Kb_ = F.KB + (size_t)(b * 2 + kvh) * 4096 * 64; const bf16* Vb_ = F.VBT + (size_t)(b * 2 + kvh) * 4096 * 64;
            for (int x = F.wave; x < 24; x += 8) { const int j = x >> 1, kv = x & 1, T = T0 + j; if (T < 0 || T > 127) continue;
                const bf16* src = (kv ? Vb_ : Kb_) + (size_t)T * 2048 + lane * 8;
#pragma unroll
                for (int c = 0; c < 4; ++c) __builtin_amdgcn_global_load_lds((const unsigned*)(src + c * 512), (LAS unsigned*)(F.lds + j * 8192 + kv * 4096 + c * 1024), 16, 0, 0); }
            VM_WAIT(); __syncthreads();
#pragma unroll 1
            for (int jj = 0; jj < 2; ++jj) {
                const int j = F.wave + 8 * jj, head = kvh * 4 + (j >> 2), qt = j & 3, t0 = 128 * qb + 32 * qt;
                const bf16* Qp = F.QB + (size_t)(b * 8 + head) * 4096 * 64 + (size_t)(t0 >> 5) * 2048 + lane * 8;
                bf16x8 qf[4];
#pragma unroll
                for (int c = 0; c < 4; ++c) qf[c] = *(const bf16x8*)(Qp + c * 512);
                float m = F.sink[head] * LOG2E, l = (h == 0) ? 1.0f : 0.f;
                f32x16 o0, o1;
#pragma unroll
                for (int e = 0; e < 16; ++e) { o0[e] = 0.f; o1[e] = 0.f; }
#pragma unroll 1
                for (int i = 0; i < 9; ++i) { const int T = T0 + qt + i; if (T < 0 || T > 127) continue;
                    const LAS unsigned char* tp = F.lds + (qt + i) * 8192 + lane * 16;
                    KVFrag f;
#pragma unroll
                    for (int c = 0; c < 4; ++c) { f.k[c] = *(const LAS bf16x8*)(tp + c * 1024); f.v[c] = *(const LAS bf16x8*)(tp + 4096 + c * 1024); }
                    attn_tile(f, qf, i == 0, i == 8, r, h, m, l, o0, o1); }
                l += __shfl_xor(l, 32);
                const float inv = 1.0f / l;
                bf16* dst = F.OB + (size_t)(b * 4096 + t0 + r) * 512 + head * 64;
#pragma unroll
                for (int q4 = 0; q4 < 4; ++q4) {
                    u32x2 w0, w1; w0.x = cvtpk(o0[4 * q4] * inv, o0[4 * q4 + 1] * inv); w0.y = cvtpk(o0[4 * q4 + 2] * inv, o0[4 * q4 + 3] * inv);
                    w1.x = cvtpk(o1[4 * q4] * inv, o1[4 * q4 + 1] * inv); w1.y = cvtpk(o1[4 * q4 + 2] * inv, o1[4 * q4 + 3] * inv);
                    *(u32x2*)(dst + 8 * q4 + 4 * h) = w0; *(u32x2*)(dst + 32 + 8 * q4 + 4 * h) = w1; }
            }
            __syncthreads();
        }
    }
}

__device__ __forceinline__ void norm_route_phase(Frame& F, int bank) {
    LAS unsigned char* A = F.lds;
    const int lane = F.lane, w = F.wave;
    for (int u = F.vcu; u < MT / 64; u += F.G) {
        {
            u32x4 xv[8][2];
#pragma unroll
            for (int q = 0; q < 8; ++q) { const u32x4* xr = (const u32x4*)(F.X1 + (size_t)(64 * u + 8 * w + q) * DM) + lane; xv[q][0] = xr[0]; xv[q][1] = xr[64]; }
            f32x4 gg[2][2], sc[2][2], sh[2][2];
            const float* md = F.mod + ((64 * u) >> 12) * NMOD;
#pragma unroll
            for (int j = 0; j < 2; ++j)
#pragma unroll
                for (int hh = 0; hh < 2; ++hh) { const int col = 8 * (lane + 64 * j) + 4 * hh; gg[j][hh] = *(const f32x4*)(F.g_ffn + col); sc[j][hh] = *(const f32x4*)(md + 4 * DM + col) + 1.0f; sh[j][hh] = *(const f32x4*)(md + 3 * DM + col); }
#pragma unroll
            for (int q = 0; q < 8; ++q) {
                const int rl = 8 * w + q, m = 64 * u + rl; float ss = 0.f; f32x4 f[2][2];
#pragma unroll
                for (int j = 0; j < 2; ++j) { f[j][0] = (f32x4){bflo(xv[q][j].x), bfhi(xv[q][j].x), bflo(xv[q][j].y), bfhi(xv[q][j].y)}; f[j][1] = (f32x4){bflo(xv[q][j].z), bfhi(xv[q][j].z), bflo(xv[q][j].w), bfhi(xv[q][j].w)};
#pragma unroll
                    for (int hh = 0; hh < 2; ++hh) ss += (f[j][hh].x * f[j][hh].x + f[j][hh].y * f[j][hh].y) + (f[j][hh].z * f[j][hh].z + f[j][hh].w * f[j][hh].w); }
                const float rinv = 1.0f / sqrtf(wave_sum(ss) * (1.0f / DM) + RMS_EPS);
#pragma unroll
                for (int j = 0; j < 2; ++j) { const int col = 8 * (lane + 64 * j);
                    const f32x4 h0 = f[j][0] * rinv * gg[j][0] * sc[j][0] + sh[j][0], h1 = f[j][1] * rinv * gg[j][1] * sc[j][1] + sh[j][1];
                    u32x4 o; o.x = cvtpk(h0.x, h0.y); o.y = cvtpk(h0.z, h0.w); o.z = cvtpk(h1.x, h1.y); o.w = cvtpk(h1.z, h1.w);
                    *(u32x4*)(F.H + (size_t)m * DM + col) = o;
                    *(LAS u32x4*)(A + rl * 2048 + ((((col >> 3) ^ (rl & 15))) << 4)) = o; }
            }
        }
        __syncthreads();
        const int rt = w & 1, ct = (w >> 1) & 1, kq = w >> 2, r = lane & 31, h = lane >> 5;
        f32x16 acc;
#pragma unroll
        for (int e = 0; e < 16; ++e) acc[e] = 0.f;
        {
            const bf16* bp = F.WrT + (size_t)(32 * ct + r) * DM + 512 * kq + 8 * h;
            const int arow = 32 * rt + r;
            const LAS unsigned char* ap = A + arow * 2048;
#pragma unroll 8
            for (int ks = 0; ks < 32; ++ks) {
                const bf16x8 bf = *(const bf16x8*)(bp + 16 * ks);
                const int chunk = 64 * kq + 2 * ks + h;
                const bf16x8 af = *(const LAS bf16x8*)(ap + ((chunk ^ (arow & 15)) << 4));
                acc = MFMA32(af, bf, acc);
            }
        }
        __syncthreads();
        LAS float* P = (LAS float*)F.lds;
        LAS int* lcnt = (LAS int*)(F.lds + 2 * 64 * 68 * 4);
#pragma unroll
        for (int e = 0; e < 16; ++e) P[(kq * 64 + 32 * rt + crow(e, h)) * 68 + 32 * ct + r] = acc[e];
        if (F.tid < 64) lcnt[F.tid] = 0;
        __syncthreads();
        int e1 = 0, e2 = 0, p1 = 0, p2 = 0; float w1 = 0.f, w2 = 0.f;
        if (F.tid < 64) {
            const LAS float* q0 = P + F.tid * 68; const LAS float* q1 = P + (64 + F.tid) * 68;
            float gl[4]; float gmax = -3.0e38f; int gs = 0;
#pragma unroll
            for (int j = 0; j < 4; ++j) { gl[j] = q0[j] + q1[j] + F.b_group[j]; if (gl[j] > gmax) { gmax = gl[j]; gs = j; } }
            float gz = 0.f;
#pragma unroll
            for (int j = 0; j < 4; ++j) gz += __expf(gl[j] - gmax);
            const float gw = 1.0f / gz;
            float el[8]; float m1 = -3.0e38f; int i1 = 0;
#pragma unroll
            for (int j = 0; j < 8; ++j) { el[j] = q0[4 + 8 * gs + j] + q1[4 + 8 * gs + j] + F.b_route[8 * gs + j]; if (el[j] > m1) { m1 = el[j]; i1 = j; } }
            float m2 = -3.0e38f; int i2 = 0;
#pragma unroll
            for (int j = 0; j < 8; ++j) { if (j != i1 && el[j] > m2) { m2 = el[j]; i2 = j; } }
            const float q2 = __expf(m2 - m1), inv = 1.0f / (1.0f + q2);
            w1 = inv * gw; w2 = q2 * inv * gw; e1 = 8 * gs + i1; e2 = 8 * gs + i2;
            p1 = atomicAdd((int*)(lcnt + e1), 1); p2 = atomicAdd((int*)(lcnt + e2), 1);
        }
        __syncthreads();
        const int shard = F.bx & 7;
        if (F.tid < 32) { const int c = lcnt[F.tid]; lcnt[32 + F.tid] = c ? (int)__hip_atomic_fetch_add(F.ctl + CW_CNT + bank * 49152 + 64 * (32 * shard + F.tid), (unsigned)c, RLX_AGENT) : 0; }
        __syncthreads();
        if (F.tid < 64) {
            const int tok = 64 * u + F.tid;
            F.list[(bank << 20) + ((32 * shard + e1) << 12) + lcnt[32 + e1] + p1] = 2 * tok; F.wts[2 * tok] = w1;
            F.list[(bank << 20) + ((32 * shard + e2) << 12) + lcnt[32 + e2] + p2] = 2 * tok + 1; F.wts[2 * tok + 1] = w2;
        }
        __syncthreads();
    }
}

__device__ __forceinline__ void moe_setup(Frame& F, int& n4_out, int& n7_out) {
    LAS int* rbtab = (LAS int*)(F.lds + TAB_RB); LAS int* cnttab = (LAS int*)(F.lds + TAB_CNT); LAS int* nbw = (LAS int*)(F.lds + TAB_NB);
    LAS int* gidx = (LAS int*)(F.lds + TAB_GIDX); LAS int* dtab = (LAS int*)(F.lds + TAB_D); LAS float* wtab = (LAS float*)(F.lds + TAB_W);
    LAS int* pref = (LAS int*)(F.lds + TAB_PREF);
    if (F.tid < 256) pref[(F.tid & 31) * 8 + (F.tid >> 5)] = (int)__hip_atomic_load(F.ctl + CW_CNT + 64 * F.tid, RLX_AGENT);
    __syncthreads();
    if (F.tid < 64) {
        int cnt = 0;
        if (F.tid < 32) { for (int sh = 0; sh < 8; ++sh) { const int c = pref[F.tid * 8 + sh]; pref[F.tid * 8 + sh] = cnt; cnt += c; } }
        const int nb = (cnt + 255) >> 8; int incl = nb;
#pragma unroll
        for (int o = 1; o < 32; o <<= 1) { const int t = __shfl_up(incl, o); if (F.lane >= o) incl += t; }
        if (F.tid < 32) { cnttab[F.tid] = cnt; const int st = incl - nb; for (int j = 0; j < nb; ++j) rbtab[st + j] = (F.tid << 8) | j; }
        if (F.tid == 31) nbw[0] = incl;
    }
    __syncthreads();
    const int n4 = 4 * nbw[0];
    const int n7 = n4 / F.G + (F.bx < n4 % F.G ? 1 : 0);
    for (int i = 0; i < 7; ++i) { const int t = moe_deal(i, F.bx, F.G, n4); if (t < 0) break;
        const bool down = t >= n4; const int rb = (down ? t - n4 : t) >> 2, slot = down ? i - n7 : i;
        if (slot < 3 && F.tid < 256) { const int v = rbtab[rb], e = v >> 8, j = v & 255; const int nvalid = cnttab[e] - 256 * j;
            int val = -1;
            if (F.tid < nvalid) { const int q = 256 * j + F.tid; int sh = 0;
#pragma unroll
                for (int k = 1; k < 8; ++k) sh += (pref[e * 8 + k] <= q) ? 1 : 0;
                val = F.list[((32 * sh + e) << 12) + q - pref[e * 8 + sh]]; }
            if (!down) gidx[slot * 256 + F.tid] = val >= 0 ? (val >> 1) : 0;
            else { dtab[slot * 256 + F.tid] = val; wtab[slot * 256 + F.tid] = val >= 0 ? F.wts[val] : 0.f; } } }
    __syncthreads();
    n4_out = n4; n7_out = n7;
}

__device__ __forceinline__ void final_rows(Frame& F) {
    const int gw = F.vcu * 8 + F.wave, NGW = F.G * 8;
    for (int m0 = gw; m0 < MT; m0 += 2 * NGW) {
        u32x4 xa[2][2], ya[2][2], yb[2][2];
#pragma unroll
        for (int q = 0; q < 2; ++q) { const int m = m0 + q * NGW; if (m < MT) {
            const u32x4* xr = (const u32x4*)(F.X1 + (size_t)m * DM) + F.lane; const u32x4* y0 = (const u32x4*)(F.Y + (size_t)(2 * m) * DM) + F.lane; const u32x4* y1 = (const u32x4*)(F.Y + (size_t)(2 * m + 1) * DM) + F.lane;
#pragma unroll
            for (int j = 0; j < 2; ++j) { xa[q][j] = xr[64 * j]; ya[q][j] = y0[64 * j]; yb[q][j] = y1[64 * j]; } } }
#pragma unroll
        for (int q = 0; q < 2; ++q) { const int m = m0 + q * NGW; if (m >= MT) continue;
            const float* gt = F.mod + (m >> 12) * NMOD + 5 * DM; float s = 0.f; f32x4 v[2][2];
#pragma unroll
            for (int j = 0; j < 2; ++j)
#pragma unroll
                for (int hh = 0; hh < 2; ++hh) { const int col = 8 * (F.lane + 64 * j) + 4 * hh; const f32x4 g = *(const f32x4*)(gt + col);
                    const unsigned x0 = hh ? xa[q][j].z : xa[q][j].x, x1 = hh ? xa[q][j].w : xa[q][j].y, a0 = hh ? ya[q][j].z : ya[q][j].x, a1 = hh ? ya[q][j].w : ya[q][j].y, b0 = hh ? yb[q][j].z : yb[q][j].x, b1 = hh ? yb[q][j].w : yb[q][j].y;
                    const f32x4 xs = {bflo(x0), bfhi(x0), bflo(x1), bfhi(x1)}, ys = {bflo(a0) + bflo(b0), bfhi(a0) + bfhi(b0), bflo(a1) + bflo(b1), bfhi(a1) + bfhi(b1)};
                    v[j][hh] = xs + g * ys; s += (v[j][hh].x * v[j][hh].x + v[j][hh].y * v[j][hh].y) + (v[j][hh].z * v[j][hh].z + v[j][hh].w * v[j][hh].w); }
            const float rinv = 1.0f / sqrtf(wave_sum(s) * (1.0f / DM) + RMS_EPS);
#pragma unroll
            for (int j = 0; j < 2; ++j)
#pragma unroll
                for (int hh = 0; hh < 2; ++hh) { const int col = 8 * (F.lane + 64 * j) + 4 * hh; *(f32x4*)(F.out + (size_t)m * DM + col) = v[j][hh] * rinv * *(const f32x4*)(F.g_final + col); }
        }
    }
}

struct Args { const void* in[20]; float* out; unsigned char* ws; int ph_lo, ph_hi, li, pad; };
__global__ void __launch_bounds__(512, 2) fwd_kernel(Args args) {
    extern __shared__ __attribute__((aligned(16))) unsigned char lds[];
    Frame F;
    F.lds = (LAS unsigned char*)lds;
    F.tid = threadIdx.x; F.lane = F.tid & 63; F.wave = __builtin_amdgcn_readfirstlane(F.tid >> 6);
    F.G = gridDim.x; F.bx = blockIdx.x; F.vcu = (F.G % 8 == 0) ? (F.bx % 8) * (F.G / 8) + F.bx / 8 : F.bx;
    unsigned char* ws = args.ws;
    F.ctl = (unsigned*)(ws + WS_CTL);
    F.x = (const float*)args.in[0]; F.c = (const float*)args.in[1]; F.positions = (const int*)args.in[2]; F.w_ada = (const float*)args.in[3]; F.b_ada = (const float*)args.in[4];
    F.g_mix = (const float*)args.in[5]; F.w_in = (const float*)args.in[6]; F.sink = (const float*)args.in[7]; F.w_a = (const float*)args.in[8]; F.w_b = (const float*)args.in[9];
    F.w_out = (const float*)args.in[10]; F.g_ffn = (const float*)args.in[11]; F.w_group = (const float*)args.in[12]; F.b_group = (const float*)args.in[13]; F.w_route = (const float*)args.in[14];
    F.b_route = (const float*)args.in[15]; F.w_gate = (const float*)args.in[16]; F.w_up = (const float*)args.in[17]; F.w_down = (const float*)args.in[18]; F.g_final = (const float*)args.in[19];
    F.out = args.out;
    F.mod = (float*)(ws + WS_MOD); F.rcos = (float*)(ws + WS_RCOS); F.rsin = (float*)(ws + WS_RSIN); F.wts = (float*)(ws + WS_WTS); F.list = (int*)(ws + WS_LIST);
    F.WrT = (bf16*)(ws + WS_WRT); F.WaT = (bf16*)(ws + WS_WAT); F.WbT = (bf16*)(ws + WS_WBT); F.WoT = (bf16*)(ws + WS_WOT); F.WinT = (bf16*)(ws + WS_WINT); F.GUT = (bf16*)(ws + WS_GUT); F.DT = (bf16*)(ws + WS_DT);
    F.H = (bf16*)(ws + WS_H); F.OA = (bf16*)(ws + WS_OA); F.OB = (bf16*)(ws + WS_OB); F.QA = (bf16*)(ws + WS_QA); F.KA = (bf16*)(ws + WS_KA); F.VAT = (bf16*)(ws + WS_VAT);
    F.QB = (bf16*)(ws + WS_QB); F.KB = (bf16*)(ws + WS_KB); F.VBT = (bf16*)(ws + WS_VBT); F.MERGED = (bf16*)(ws + WS_MERGED); F.ACT = (bf16*)(ws + WS_ACT); F.Y = (bf16*)(ws + WS_Y);
    F.X1 = (bf16*)(ws + WS_X1);
    F.SGA = (unsigned char*)args.out; F.SGB = (unsigned char*)args.out + (size_t)MT * DM;
    for (int u = F.tid; u < (LDS_BYTES - MISC_OFF) / 4; u += 512) ((LAS unsigned*)(F.lds + MISC_OFF))[u] = 0u;
    __syncthreads();
#if MK_PER_PHASE
#define GRID_BAR() do {} while (0)
#else
    XcdBarrier bar = xcd_barrier_post(F.ctl + CW_BAR + args.li * XCD_BAR_WORDS, (volatile LAS unsigned*)(F.lds + MISC_OFF));
#define GRID_BAR() xcd_barrier(bar)
#endif
    const int lo = args.ph_lo, hi = args.ph_hi;
#define IN(k) (lo <= (k) && (k) < hi)
#define SEAM(k) do { if (IN(k) && IN((k) + 1)) GRID_BAR(); } while (0)

#define PHASE_BEGIN(k) if (IN(k)) {
#define PHASE_END(k) SEAM(k); }
    PHASE_BEGIN(0) p0_prologue(F); norm_rows(F, F.x, F.g_mix, 0, DM, F.H); PHASE_END(0)
    PHASE_BEGIN(1)
        SchedTiles S{(const char*)F.H, (const char*)F.WinT, 2048, 2048, 16, 64, 20, F.G, F.bx};
        EpiIn E{F.QA, F.KA, F.VAT, F.QB, F.KB, F.VBT, F.SGA, F.SGB, F.rcos, F.rsin};
        pg8::gemm_run<EpiIn, SchedTiles, false, true>(F.lds, nullptr, S, E);
    PHASE_END(1)
    PHASE_BEGIN(2) attn_phase(F); PHASE_END(2)
    PHASE_BEGIN(3)
        SchedBranch S{(const char*)F.OA, (const char*)F.OB, (const char*)F.WaT, (const char*)F.WbT, F.G, F.bx};
        EpiMerge E{F.SGA, F.SGB, F.MERGED};
        pg8::gemm_run<EpiMerge, SchedBranch, false, false>(F.lds, nullptr, S, E);
    PHASE_END(3)
    PHASE_BEGIN(4)
        SchedTiles S{(const char*)F.MERGED, (const char*)F.WoT, 2048, 2048, 16, 64, 4, F.G, F.bx};
        EpiX1 E{F.x, F.mod, F.X1};
        pg8::gemm_run<EpiX1, SchedTiles, false, false>(F.lds, nullptr, S, E);
    PHASE_END(4)
    PHASE_BEGIN(5) norm_route_phase(F, (MK_REPEAT_MASK != 0 && args.li == 1) ? 1 : 0); PHASE_END(5)
    PHASE_BEGIN(6)
        int n4, n7; moe_setup(F, n4, n7);
        SchedMoe S{(const char*)F.H, (const char*)F.ACT, (const char*)F.GUT, (const char*)F.DT, (const LAS int*)(F.lds + TAB_RB), F.ctl + CW_ACT, n4, n7, F.G, F.bx};
        EpiMoe E{F.ACT, F.Y, (const LAS int*)(F.lds + TAB_D), (const LAS float*)(F.lds + TAB_W), F.ctl + CW_ACT};
        pg8::gemm_run<EpiMoe, SchedMoe, true, true>(F.lds, (const LAS int*)(F.lds + TAB_GIDX), S, E);
    PHASE_END(6)
    PHASE_BEGIN(7) final_rows(F); PHASE_END(7)
#undef IN
#undef SEAM
}

extern "C" void kernel_launch(void* const* d_in, const int* in_sizes, int n_in, void* d_out, int out_size, void* d_ws, size_t ws_size, hipStream_t stream) {
    static int grid = 0;
    if (grid == 0) {
        if (n_in != 20 || out_size != MT * DM || ws_size < WS_END) { fprintf(stderr, "kernel_launch: unexpected shapes (n_in %d out %d ws %zu)\n", n_in, out_size, ws_size); grid = -1; return; }
        int dev = 0, cus = 0, per_cu = 0;
        if (hipGetDevice(&dev) != hipSuccess || hipDeviceGetAttribute(&cus, hipDeviceAttributeMultiprocessorCount, dev) != hipSuccess) { grid = -1; return; }
        if (hipFuncSetAttribute((const void*)fwd_kernel, hipFuncAttributeMaxDynamicSharedMemorySize, LDS_BYTES) != hipSuccess) { fprintf(stderr, "kernel_launch: hipFuncSetAttribute failed\n"); grid = -1; return; }
        if (hipOccupancyMaxActiveBlocksPerMultiprocessor(&per_cu, (const void*)fwd_kernel, 512, LDS_BYTES) != hipSuccess || per_cu < 1) { fprintf(stderr, "kernel_launch: occupancy query says %d\n", per_cu); }
        (void)hipGetLastError();
        grid = cus;
    }
    if (grid < 0) return;
    (void)hipMemsetAsync((char*)d_ws + WS_CTL, 0, CTL_ZERO_BYTES, stream);
    Args a{};
    for (int i = 0; i < 20; ++i) a.in[i] = d_in[i];
    a.out = (float*)d_out; a.ws = (unsigned char*)d_ws;
#if MK_PER_PHASE
    for (int p = 0; p < NPHASE; ++p) { a.ph_lo = p; a.ph_hi = p + 1; hipLaunchKernelGGL(fwd_kernel, dim3(grid), dim3(512), LDS_BYTES, stream, a); }
#else
    if (MK_REPEAT_MASK == 0) { a.ph_lo = 0; a.ph_hi = NPHASE; a.li = 0; hipLaunchKernelGGL(fwd_kernel, dim3(grid), dim3(512), LDS_BYTES, stream, a); }
    else {
        int k0 = 0, k1 = 0; for (int k = 0; k < NPHASE; ++k) if ((MK_REPEAT_MASK >> k) & 1) { k0 = k; break; }
        for (int k = 0; k < NPHASE; ++k) if ((MK_REPEAT_MASK >> k) & 1) k1 = k;
        a.ph_lo = 0; a.ph_hi = k1 + 1; a.li = 0; hipLaunchKernelGGL(fwd_kernel, dim3(grid), dim3(512), LDS_BYTES, stream, a);
        a.ph_lo = k0; a.ph_hi = k1 + 1; a.li = 1; hipLaunchKernelGGL(fwd_kernel, dim3(grid), dim3(512), LDS_BYTES, stream, a);
        if (k1 + 1 < NPHASE) { a.ph_lo = k1 + 1; a.ph_hi = NPHASE; a.li = 2; hipLaunchKernelGGL(fwd_kernel, dim3(grid), dim3(512), LDS_BYTES, stream, a); }
    }
#endif
}
```

```cpp
#include <hip/hip_runtime.h>
#include <cstdio>
#include <cstdint>

#ifndef MK_PER_PHASE
#define MK_PER_PHASE 0
#endif

#ifndef MK_REPEAT_MASK
#define MK_REPEAT_MASK 0
#endif
#define LAS __attribute__((address_space(3)))
#define GAS __attribute__((address_space(1)))
typedef unsigned short bf16;
typedef short bf16x8 __attribute__((ext_vector_type(8)));
typedef short s16x4 __attribute__((ext_vector_type(4)));
typedef float f32x4 __attribute__((ext_vector_type(4)));
typedef float f32x2 __attribute__((ext_vector_type(2)));
typedef float f32x16 __attribute__((ext_vector_type(16)));
typedef unsigned u32x4 __attribute__((ext_vector_type(4)));
typedef unsigned u32x2 __attribute__((ext_vector_type(2)));
typedef __bf16 bf16x2_t __attribute__((ext_vector_type(2)));

constexpr int NBATCH = 4, SEQ = 4096, DM = 1024, MT = NBATCH * SEQ;
constexpr int NIN = 5120, NMOD = 6 * DM;
constexpr int NEXP = 32, DEXP = 512;
constexpr float RMS_EPS = 1e-6f;
constexpr float LOG2E = 1.4426950408889634f;
constexpr float QSCALE = 0.125f * LOG2E;
constexpr int NPHASE = 8;

constexpr size_t MiB = 1u << 20;
constexpr size_t WS_CTL = 0, CTL_ZERO_BYTES = 1 * MiB;
constexpr size_t WS_MOD = 1 * MiB;
constexpr size_t WS_RCOS = 2 * MiB, WS_RSIN = 4 * MiB;
constexpr size_t WS_LIST = 288 * MiB;
constexpr size_t WS_WTS = 8 * MiB;
constexpr size_t WS_WRT = 8 * MiB + 512 * 1024;
constexpr size_t WS_WAT = 9 * MiB;
constexpr size_t WS_WBT = 9 * MiB + 512 * 1024;
constexpr size_t WS_WOT = 10 * MiB + 512 * 1024;
constexpr size_t WS_WINT = 13 * MiB;
constexpr size_t WS_GUT = 24 * MiB;
constexpr size_t WS_DT = 88 * MiB;
constexpr size_t WS_H = 120 * MiB;
constexpr size_t WS_OA = 120 * MiB;
constexpr size_t WS_OB = 128 * MiB;
constexpr size_t WS_QA = 152 * MiB, WS_KA = 176 * MiB, WS_VAT = 200 * MiB, WS_QB = 224 * MiB, WS_KB = 240 * MiB, WS_VBT = 244 * MiB;
constexpr size_t WS_MERGED = 152 * MiB;
constexpr size_t WS_ACT = 152 * MiB;
constexpr size_t WS_Y = 192 * MiB;
constexpr size_t WS_X1 = 256 * MiB;
constexpr size_t WS_END = 296 * MiB;
constexpr int CW_BAR = 4096;
constexpr int CW_CNT = 16384;
constexpr int CW_MODCNT = 49152;
constexpr int CW_ACT = 32768;

constexpr int RING_BYTES = 131072;
constexpr int TAB_OFF = RING_BYTES;
constexpr int TAB_GIDX = TAB_OFF, TAB_D = TAB_OFF + 3072, TAB_W = TAB_OFF + 6144, TAB_RB = TAB_OFF + 9216, TAB_CNT = TAB_RB + 768, TAB_NB = TAB_CNT + 128, TAB_PREF = TAB_NB + 16;
constexpr int MISC_OFF = TAB_OFF + 12288;
constexpr int LDS_BYTES = 147456;

#define LDS_WAIT() asm volatile("s_waitcnt lgkmcnt(0)" ::: "memory")
#define VM_WAIT() asm volatile("s_waitcnt vmcnt(0)" ::: "memory")
#define RLX_AGENT __ATOMIC_RELAXED, __HIP_MEMORY_SCOPE_AGENT
__device__ __forceinline__ unsigned cvtpk(float lo, float hi) { f32x2 v = {lo, hi}; bf16x2_t b = __builtin_convertvector(v, bf16x2_t); return __builtin_bit_cast(unsigned, b); }
__device__ __forceinline__ float bflo(unsigned u) { return __builtin_bit_cast(float, u << 16); }
__device__ __forceinline__ float bfhi(unsigned u) { return __builtin_bit_cast(float, u & 0xffff0000u); }
__device__ __forceinline__ float fexp2(float x) { return __builtin_amdgcn_exp2f(x); }
__device__ __forceinline__ float frcp(float x) { return __builtin_amdgcn_rcpf(x); }
__device__ __forceinline__ float fsigmoid(float x) { return frcp(1.0f + fexp2(-x * LOG2E)); }
__device__ __forceinline__ void st16_sc1(void* p, u32x4 v) { asm volatile("global_store_dwordx4 %0, %1, off sc1\n\ts_nop 1" :: "v"(p), "v"(v) : "memory"); }
__device__ __forceinline__ float wave_sum(float v) {
#pragma unroll
    for (int o = 1; o < 64; o <<= 1) v += __shfl_xor(v, o);
    return v;
}

namespace pg8 {
constexpr int BM = 256, BK = 64, HALF = 128, HTB = HALF * BK * 2, STAGE_BYTES = 8 * HTB;
__host__ __device__ __forceinline__ int lds_byte(int r, int c) { const int st = (r >> 4) * 2 + (c >> 5), rr = r & 15, cc = c & 31, ob = rr * 64 + cc * 2; return st * 1024 + (ob ^ (((ob >> 9) & 1) << 5)); }
__host__ __device__ __forceinline__ void stage_rc(int b, int& R, int& C) { const int st = b / 1024, sb = b % 1024, swz = sb ^ (((sb >> 9) & 1) << 5); R = (st >> 1) * 16 + swz / 64; C = (st & 1) * 32 + (swz % 64) / 2; }
__host__ __device__ __forceinline__ int perm32(int rho) { const int n = rho >> 4, i = rho & 15; return 8 * (i >> 2) + 4 * n + (i & 3); }

struct GU {
    const char* A;
    const char* B;
    int lda, ldb;
    int nt;
    int zero;
    int gslot;
    int pm, pn, aux;
    int eslot;
};

__device__ __forceinline__ bool static_tile(int i, int G, int c, int nM, int nN, int& pm, int& pn) {
    const int nwg = nM * nN; const long L = (long)i * G + c; if (L >= nwg) return false;
    int wgid = (int)L; { const int q = nwg / 8, r = nwg % 8, xcd = wgid % 8, off = wgid / 8; wgid = (xcd < r ? xcd * (q + 1) : r * (q + 1) + (xcd - r) * q) + off; }
    const int nig = 8 * nN, gid = wgid / nig, fm = gid * 8, gsz = (nM - fm) < 8 ? (nM - fm) : 8;
    pm = fm + ((wgid % nig) % gsz); pn = (wgid % nig) / gsz; return true;
}

template <class Epi, class Sched, bool GATHER, bool ALIGN_EPI>
__device__ __forceinline__ void gemm_run(LAS unsigned char* lds, const LAS int* gidx, const Sched& S, const Epi& E) {
    const int tid = threadIdx.x, wid = __builtin_amdgcn_readfirstlane(tid >> 6), lane = tid & 63, wr = wid >> 2, wc = wid & 3, fr = lane & 15, fq = lane >> 4;
    int R[2], C2[2], Rb[2];
#pragma unroll
    for (int i = 0; i < 2; ++i) { int C; stage_rc(tid * 16 + i * 8192, R[i], C); C2[i] = C * 2; Rb[i] = Epi::PERM ? ((R[i] & ~31) + perm32(R[i] & 31)) : R[i]; }
    const unsigned ldsw = (unsigned)wid * 1024u;
    const int aoff = lds_byte(wr * 64 + fr, fq * 8), boff = lds_byte(wc * 32 + fr, fq * 8);
#define PG8_SA(b, h) (((b) * 2 + (h)) * HTB)
#define PG8_SB(b, h) ((4 + (b) * 2 + (h)) * HTB)
#define PG8_STAGE(bufoff, gbase, voff) do { _Pragma("unroll") for (int _i = 0; _i < 2; ++_i) \
        __builtin_amdgcn_global_load_lds((const unsigned*)((const char*)(gbase) + (voff)[_i]), (LAS unsigned*)(lds + (bufoff) + ldsw + _i * 8192), 16, 0, 0); } while (0)
#define PG8_LDA(dst, b, h) do { _Pragma("unroll") for (int m = 0; m < 4; ++m) _Pragma("unroll") for (int k = 0; k < 2; ++k) dst[m][k] = *(const LAS bf16x8*)(lds + PG8_SA(b, h) + aoff + m * 2048 + k * 1024); } while (0)
#define PG8_LDB(dst, b, h) do { _Pragma("unroll") for (int n = 0; n < 2; ++n) _Pragma("unroll") for (int k = 0; k < 2; ++k) dst[n][k] = *(const LAS bf16x8*)(lds + PG8_SB(b, h) + boff + n * 2048 + k * 1024); } while (0)
#define PG8_MMA(ai, bj, At, Bt) do { __builtin_amdgcn_s_setprio(1); _Pragma("unroll") for (int m = 0; m < 4; ++m) _Pragma("unroll") for (int n = 0; n < 2; ++n) _Pragma("unroll") for (int k = 0; k < 2; ++k) \
        acc[ai][bj][m][n] = __builtin_amdgcn_mfma_f32_16x16x32_bf16(Bt[n][k], At[m][k], acc[ai][bj][m][n], 0, 0, 0); __builtin_amdgcn_s_setprio(0); } while (0)
#define PG8_WAIT_V(n) asm volatile("s_waitcnt vmcnt(" #n ")" ::: "memory")
#define PG8_WAIT_L(n) asm volatile("s_waitcnt lgkmcnt(" #n ")" ::: "memory")
#define PG8_BAR __builtin_amdgcn_s_barrier()
#define PG8_SCHED __builtin_amdgcn_sched_barrier(0)
#define PG8_SETV(u) do { _Pragma("unroll") for (int _i = 0; _i < 2; ++_i) { int r0, r1; \
        if (GATHER && (u).gslot >= 0) { r0 = gidx[(u).gslot * 256 + R[_i]]; r1 = gidx[(u).gslot * 256 + 128 + R[_i]]; } else { r0 = R[_i]; r1 = R[_i] + 128; } \
        vA[0][_i] = (unsigned)(r0 * (u).lda + C2[_i]); vA[1][_i] = (unsigned)(r1 * (u).lda + C2[_i]); vB[_i] = (unsigned)(Rb[_i] * (u).ldb + C2[_i]); } hB = (unsigned)(128 * (u).ldb); } while (0)
    GU cur, nxt; int ui = 0; int pend = -1;
    if (!S.next(0, cur)) return;
    f32x4 acc[2][2][4][2];
#pragma unroll
    for (int a = 0; a < 2; ++a)
#pragma unroll
        for (int b = 0; b < 2; ++b)
#pragma unroll
            for (int m = 0; m < 4; ++m)
#pragma unroll
                for (int n = 0; n < 2; ++n) acc[a][b][m][n] = (f32x4){0.f, 0.f, 0.f, 0.f};
    bf16x8 At[4][2], B0[2][2], B1[2][2];
    unsigned vA[2][2], vB[2], hB;
    S.a_ready(cur);
    PG8_SETV(cur);
    const char* sA = cur.A; const char* sB = cur.B;
    PG8_STAGE(PG8_SB(0, 0), sB, vB); PG8_STAGE(PG8_SB(0, 1), sB + hB, vB); PG8_STAGE(PG8_SA(0, 0), sA, vA[0]); PG8_STAGE(PG8_SA(0, 1), sA, vA[1]);
    if (wr == 1) PG8_BAR;
    PG8_WAIT_V(2); PG8_BAR;
    PG8_STAGE(PG8_SB(1, 0), sB + 128, vB); PG8_STAGE(PG8_SA(1, 0), sA + 128, vA[0]); PG8_STAGE(PG8_SB(1, 1), sB + hB + 128, vB);
    PG8_WAIT_V(6); PG8_BAR;
    sA += 256; sB += 256;
    for (;;) {
        bool has_next = false;
        const int nt = cur.nt;
        for (int t = 0; t < nt; t += 2) {
            const bool last = (t == nt - 2);
            PG8_LDB(B0, 0, 0); PG8_LDB(B1, 0, 1); PG8_SCHED; PG8_LDA(At, 0, 0); PG8_STAGE(PG8_SA(1, 1), sA - 128, vA[1]);
            PG8_WAIT_V(8); PG8_WAIT_L(0); PG8_BAR; PG8_MMA(0, 0, At, B0); PG8_MMA(0, 1, At, B1); PG8_BAR; PG8_SCHED;
            if (last) {
                has_next = S.next(ui + 1, nxt);
                if (has_next) { S.a_ready(nxt); PG8_SETV(nxt); sA = nxt.A; sB = nxt.B; } else { sA = cur.A; sB = cur.B; }
            }
            PG8_LDA(At, 0, 1); PG8_STAGE(PG8_SB(0, 0), sB, vB); PG8_STAGE(PG8_SB(0, 1), sB + hB, vB); PG8_STAGE(PG8_SA(0, 0), sA, vA[0]);
            PG8_WAIT_V(8);
            if constexpr (Epi::DEFER_PUBLISH) { if (pend >= 0) { E.publish(pend, lane); pend = -1; } }
            PG8_WAIT_L(0); PG8_BAR; PG8_MMA(1, 0, At, B0); PG8_MMA(1, 1, At, B1); PG8_BAR; PG8_SCHED;
            PG8_LDB(B0, 1, 0); PG8_LDB(B1, 1, 1); PG8_SCHED; PG8_LDA(At, 1, 0); PG8_STAGE(PG8_SA(0, 1), sA, vA[1]);
            PG8_WAIT_V(8); PG8_WAIT_L(0); PG8_BAR; PG8_MMA(0, 0, At, B0); PG8_MMA(0, 1, At, B1); PG8_BAR; PG8_SCHED;
            PG8_LDA(At, 1, 1); PG8_STAGE(PG8_SB(1, 0), sB + 128, vB); PG8_STAGE(PG8_SB(1, 1), sB + hB + 128, vB); PG8_STAGE(PG8_SA(1, 0), sA + 128, vA[0]);
            PG8_WAIT_V(8); PG8_WAIT_L(0); PG8_BAR; PG8_MMA(1, 0, At, B0); PG8_MMA(1, 1, At, B1); PG8_BAR; PG8_SCHED;
            sA += 256; sB += 256;
        }
        if constexpr (ALIGN_EPI) { if (wr == 0) PG8_BAR; }
        if constexpr (!Epi::AFTER_DRAIN) { E(acc, cur, wr, wc, fr, fq); }
        if constexpr (Epi::DEFER_PUBLISH) { if (E.wants_publish(cur)) pend = cur.pm; }
        if (!has_next) break;
        if (nxt.zero) {
#pragma unroll
            for (int a = 0; a < 2; ++a)
#pragma unroll
                for (int b = 0; b < 2; ++b)
#pragma unroll
                    for (int m = 0; m < 4; ++m)
#pragma unroll
                        for (int n = 0; n < 2; ++n) acc[a][b][m][n] = (f32x4){0.f, 0.f, 0.f, 0.f};
        }
        cur = nxt; ++ui;
        if constexpr (ALIGN_EPI) { if (wr == 1) PG8_BAR; }
    }
    PG8_WAIT_V(0);
    if constexpr (Epi::DEFER_PUBLISH) { if (pend >= 0) { E.publish(pend, lane); pend = -1; } }
    if constexpr (!ALIGN_EPI) { if (wr == 0) PG8_BAR; }
    PG8_BAR;
    if constexpr (Epi::AFTER_DRAIN) { E.fused(acc, cur, wr, wc, fr, fq, lds, wid, lane); }
#undef PG8_SA
#undef PG8_SB
#undef PG8_STAGE
#undef PG8_LDA
#undef PG8_LDB
#undef PG8_MMA
#undef PG8_WAIT_V
#undef PG8_WAIT_L
#undef PG8_BAR
#undef PG8_SCHED
#undef PG8_SETV
}
}

#define XB_TMO      128
#define XB_XCNT(j)  (256  + 64 * (j))
#define XB_XSUB(j)  (1280 + 64 * (j))
#define XB_XGEN(j)  (2304 + 64 * (j))
#define XB_TOP      3328
#define XB_TOPGEN   3392
#define XCD_BAR_WORDS 3456
#define XB_SPIN_CAP (1u << 18)
__device__ __forceinline__ unsigned xb_ld(unsigned* p)              { return __hip_atomic_load(p, __ATOMIC_RELAXED, __HIP_MEMORY_SCOPE_AGENT); }
__device__ __forceinline__ unsigned xb_add(unsigned* p, unsigned v) { return __hip_atomic_fetch_add(p, v, __ATOMIC_RELAXED, __HIP_MEMORY_SCOPE_AGENT); }
__device__ __forceinline__ unsigned xb_xcc_id() { return (unsigned)__builtin_amdgcn_s_getreg((3 << 11) | 20) & 0xFu; }
#define XB_SPIN(cond, bar) do { unsigned _sp = 0; while (cond) { __builtin_amdgcn_s_sleep(1); \
    if ((++_sp & 255u) == 0u) { if (xb_ld(&(bar)[XB_TMO])) break; if (_sp > XB_SPIN_CAP) { atomicAdd(&(bar)[XB_TMO], 1u); break; } } } } while (0)
struct XcdBarrier { unsigned* bar; unsigned x; volatile LAS unsigned* st; };
__device__ __forceinline__ XcdBarrier xcd_barrier_post(unsigned* bar, volatile LAS unsigned* st) {
    XcdBarrier b; b.bar = bar; b.x = xb_xcc_id(); b.st = st;
    if (threadIdx.x == 0) (void)xb_add(&bar[XB_XCNT(b.x)], 1u);
    return b;
}
__device__ __forceinline__ void xcd_barrier_complete(unsigned* bar, unsigned x, unsigned& nloc, unsigned& nx) {
    const unsigned G = gridDim.x * gridDim.y * gridDim.z;
    unsigned sum, cnt, mine, sp = 0u;
    for (;;) {
        sum = 0u; cnt = 0u; mine = 0u;
#pragma unroll
        for (unsigned j = 0; j < 16; ++j) { const unsigned c = xb_ld(&bar[XB_XCNT(j)]); sum += c; cnt += (c > 0u) ? 1u : 0u; mine = (j == x) ? c : mine; }
        if (sum == G) break;
        __builtin_amdgcn_s_sleep(1);
        if ((++sp & 255u) == 0u) { if (xb_ld(&bar[XB_TMO])) break; if (sp > XB_SPIN_CAP) { atomicAdd(&bar[XB_TMO], 1u); break; } }
    }
    nloc = mine > 0u ? mine : 1u; nx = cnt > 0u ? cnt : 1u;
}
__device__ __forceinline__ void xcd_barrier(const XcdBarrier& b) {
    asm volatile("s_waitcnt vmcnt(0)" ::: "memory");
    __syncthreads();
    if (threadIdx.x == 0) {
        unsigned* bar = b.bar;
        __builtin_amdgcn_s_waitcnt(0);
        unsigned nloc = b.st[0], nx = b.st[1];
        if (nloc == 0u) { xcd_barrier_complete(bar, b.x, nloc, nx); b.st[0] = nloc; b.st[1] = nx; }
        const unsigned old = xb_add(&bar[XB_XSUB(b.x)], 1u);
        const unsigned gen = old / nloc;
        if (old + 1u == (gen + 1u) * nloc) {
            __builtin_amdgcn_fence(__ATOMIC_RELEASE, "agent");
            asm volatile("s_waitcnt vmcnt(0)" ::: "memory");
            const unsigned og = xb_add(&bar[XB_TOP], 1u);
            const unsigned tg = og / nx;
            if (og + 1u == (tg + 1u) * nx) xb_add(&bar[XB_TOPGEN], 1u);
            else XB_SPIN(xb_ld(&bar[XB_TOPGEN]) == tg, bar);
            __builtin_amdgcn_fence(__ATOMIC_ACQUIRE, "agent");
            xb_add(&bar[XB_XGEN(b.x)], 1u);
            asm volatile("s_waitcnt vmcnt(0)" ::: "memory");
        } else {
            XB_SPIN(xb_ld(&bar[XB_XGEN(b.x)]) == gen, bar);
            __builtin_amdgcn_fence(__ATOMIC_ACQUIRE, "agent");
            asm volatile("s_waitcnt vmcnt(0)" ::: "memory");
        }
    }
    __syncthreads();
}

struct Frame {
    LAS unsigned char* lds;
    unsigned* ctl;
    int tid, lane, wave, vcu, G, bx;
    int bg_done;
    const float *x, *c, *w_ada, *b_ada, *g_mix, *w_in, *sink, *w_a, *w_b, *w_out, *g_ffn, *w_group, *b_group, *w_route, *b_route, *w_gate, *w_up, *w_down, *g_final;
    const int* positions;
    float* out;
    float *mod, *rcos, *rsin, *wts;
    int* list;
    bf16 *WrT, *WaT, *WbT, *WoT, *WinT, *GUT, *DT, *H, *OA, *OB, *QA, *KA, *VAT, *QB, *KB, *VBT, *MERGED, *ACT, *Y, *X1;
    unsigned char *SGA, *SGB;
};

__device__ const double INVF[32] = {1, 0.74989420933245587, 0.56234132519034907, 0.42169650342858223, 0.31622776601683794, 0.23713737056616552, 0.17782794100389229, 0.1333521432163324,
    0.10000000000000001, 0.074989420933245579, 0.056234132519034911, 0.042169650342858224, 0.031622776601683791, 0.023713737056616554, 0.017782794100389229, 0.013335214321633241,
    0.01, 0.0074989420933245579, 0.005623413251903491, 0.0042169650342858229, 0.0031622776601683794, 0.0023713737056616554, 0.0017782794100389228, 0.0013335214321633241,
    0.001, 0.00074989420933245586, 0.0005623413251903491, 0.00042169650342858224, 0.00031622776601683794, 0.00023713737056616554, 0.00017782794100389227, 0.0001333521432163324};

template <int KIND> __device__ __forceinline__ int rowmap(int n) {
    if (KIND == 0) return n;
    if (KIND == 1) { const bool rp = (n < 1536) || (n >= 2304 && n < 2944); if (!rp) return n; const int j = n & 63; return (n & ~63) + (((j & 31) >> 2) << 3) + ((j >> 5) << 2) + (j & 3); }
    if (KIND == 2) return ((n >> 7) << 8) + (n & 127);
    return ((n >> 7) << 8) + 128 + (n & 127);
}
template <int KIND> __device__ __forceinline__ void transpose_item(const float* W, int K, int N, bf16* WT, int item, int lane) {
    const int nblk = N >> 5, kb = item / nblk, nb = item - kb * nblk, k0 = 64 * kb + 8 * (lane >> 3), n0 = 32 * nb + 4 * (lane & 7);
    f32x4 v[8];
#pragma unroll
    for (int j = 0; j < 8; ++j) v[j] = __builtin_nontemporal_load((const f32x4*)(W + (size_t)(k0 + j) * N + n0));
#pragma unroll
    for (int i = 0; i < 4; ++i) { u32x4 o; o.x = cvtpk(v[0][i], v[1][i]); o.y = cvtpk(v[2][i], v[3][i]); o.z = cvtpk(v[4][i], v[5][i]); o.w = cvtpk(v[6][i], v[7][i]);
        __builtin_nontemporal_store(o, (u32x4*)(WT + (size_t)rowmap<KIND>(n0 + i) * K + k0)); }
}


constexpr int EXP_ITEMS = NEXP * 3 * 256;
#ifndef BGW
#define BGW 3
#endif
#ifndef EXP_DEFER
#define EXP_DEFER 3072
#endif
struct FillRegs { f32x4 a, b, c, d, e, f, g, h; };
__device__ __forceinline__ void expert_item(const float* wg, const float* wu, const float* wd, bf16* gut, bf16* dt, int r, int lane) {
    const int e = r / 768, q = r - e * 768, kind = q >> 8, item = q & 255;
    const float* W = (kind == 0 ? wg : (kind == 1 ? wu : wd)) + (size_t)e * DM * DEXP;
    const int N = kind == 2 ? DM : DEXP, K = kind == 2 ? DEXP : DM, nblk = N >> 5, kb = item / nblk, nb = item - kb * nblk, k0 = 64 * kb + 8 * (lane >> 3), n0 = 32 * nb + 4 * (lane & 7);
    const f32x4* p = (const f32x4*)(W + (size_t)k0 * N + n0); const size_t st = (size_t)(N >> 2);
    FillRegs v;
    v.a = __builtin_nontemporal_load(p); v.b = __builtin_nontemporal_load(p + st); v.c = __builtin_nontemporal_load(p + 2 * st); v.d = __builtin_nontemporal_load(p + 3 * st);
    v.e = __builtin_nontemporal_load(p + 4 * st); v.f = __builtin_nontemporal_load(p + 5 * st); v.g = __builtin_nontemporal_load(p + 6 * st); v.h = __builtin_nontemporal_load(p + 7 * st);
    bf16* WT = kind == 2 ? dt + (size_t)e * 1024 * 512 : gut + (size_t)e * 1024 * 1024;
#pragma unroll
    for (int i = 0; i < 4; ++i) { u32x4 o; o.x = cvtpk(v.a[i], v.b[i]); o.y = cvtpk(v.c[i], v.d[i]); o.z = cvtpk(v.e[i], v.f[i]); o.w = cvtpk(v.g[i], v.h[i]);
        const int n = n0 + i, row = kind == 2 ? n : (((n >> 7) << 8) + 128 * kind + (n & 127));
        __builtin_nontemporal_store(o, (u32x4*)(WT + (size_t)row * K + k0)); }
}

__device__ __forceinline__ bool bg_step(Frame& F) {
    if (F.bg_done) return false;
    volatile LAS unsigned* bgk = (volatile LAS unsigned*)(F.lds + MISC_OFF + 128);
    int k = 0; if (F.lane == 0) k = (int)__hip_atomic_fetch_add((LAS unsigned*)bgk, 1u, __ATOMIC_RELAXED, __HIP_MEMORY_SCOPE_WORKGROUP);
    k = __builtin_amdgcn_readfirstlane(k);
    const int r = EXP_DEFER + F.vcu + k * F.G;
    if (r >= EXP_ITEMS) { F.bg_done = 1; return false; }
    expert_item(F.w_gate, F.w_up, F.w_down, F.GUT, F.DT, r, F.lane); return true;
}
__device__ __forceinline__ void xcd_barrier_bg(const XcdBarrier& b, Frame& F, volatile LAS unsigned* relw, unsigned epoch) {
    asm volatile("s_waitcnt vmcnt(0)" ::: "memory");
    __syncthreads();
    if (threadIdx.x < 64) {
        if (threadIdx.x == 0) {
            unsigned* bar = b.bar;
            __builtin_amdgcn_s_waitcnt(0);
            unsigned nloc = b.st[0], nx = b.st[1];
            if (nloc == 0u) { xcd_barrier_complete(bar, b.x, nloc, nx); b.st[0] = nloc; b.st[1] = nx; }
            const unsigned old = xb_add(&bar[XB_XSUB(b.x)], 1u);
            const unsigned gen = old / nloc;
            if (old + 1u == (gen + 1u) * nloc) {
                __builtin_amdgcn_fence(__ATOMIC_RELEASE, "agent");
                asm volatile("s_waitcnt vmcnt(0)" ::: "memory");
                const unsigned og = xb_add(&bar[XB_TOP], 1u);
                const unsigned tg = og / nx;
                if (og + 1u == (tg + 1u) * nx) xb_add(&bar[XB_TOPGEN], 1u);
                else XB_SPIN(xb_ld(&bar[XB_TOPGEN]) == tg, bar);
                __builtin_amdgcn_fence(__ATOMIC_ACQUIRE, "agent");
                xb_add(&bar[XB_XGEN(b.x)], 1u);
                asm volatile("s_waitcnt vmcnt(0)" ::: "memory");
            } else {
                XB_SPIN(xb_ld(&bar[XB_XGEN(b.x)]) == gen, bar);
                __builtin_amdgcn_fence(__ATOMIC_ACQUIRE, "agent");
                asm volatile("s_waitcnt vmcnt(0)" ::: "memory");
            }
            relw[0] = epoch;
        }
    } else {
        while (relw[0] != epoch) { if (F.wave > BGW || !bg_step(F)) __builtin_amdgcn_s_sleep(4); }
    }
    asm volatile("s_waitcnt lgkmcnt(0)" ::: "memory"); __builtin_amdgcn_s_barrier(); asm volatile("" ::: "memory");
}

__device__ __forceinline__ void p0_prologue(Frame& F) {
    {
        LAS float* cs = (LAS float*)(F.lds);
        LAS float* red = (LAS float*)(F.lds + 16384);
        for (int item = F.vcu; item < NMOD / 32; item += F.G) {
            for (int i = F.tid; i < 4096; i += 512) { const float v = F.c[i]; cs[i] = v / (1.0f + __expf(-v)); }
            __syncthreads();
            const int kq = F.tid >> 3, cq = F.tid & 7, n0 = 32 * item + 4 * cq;
            f32x4 a[4];
#pragma unroll
            for (int b = 0; b < 4; ++b) a[b] = (f32x4){0.f, 0.f, 0.f, 0.f};
#pragma unroll 4
            for (int it = 0; it < 16; ++it) { const int k = kq + 64 * it; const f32x4 w = __builtin_nontemporal_load((const f32x4*)(F.w_ada + (size_t)k * NMOD + n0));
#pragma unroll
                for (int b = 0; b < 4; ++b) a[b] += cs[b * 1024 + k] * w; }
#pragma unroll
            for (int b = 0; b < 4; ++b) *(LAS f32x4*)(red + kq * 132 + b * 32 + cq * 4) = a[b];
            __syncthreads();
            if (F.tid < 128) { float s = 0.f; for (int q = 0; q < 64; ++q) s += red[q * 132 + F.tid];
                const int b = F.tid >> 5, col = 32 * item + (F.tid & 31); __hip_atomic_store(F.mod + b * NMOD + col, s + F.b_ada[col], RLX_AGENT); }
            VM_WAIT(); __syncthreads();
            if (F.tid == 0) __hip_atomic_fetch_add(F.ctl + CW_MODCNT, 1u, RLX_AGENT);
        }
    }
    {
        const int gw = F.vcu * 8 + F.wave, NGW = F.G * 8;
        constexpr int I_IN = 16 * 160, I_A = 4 * 32, I_B = 8 * 32, I_O = 16 * 32, I_E = 256;
        constexpr int NITEMS = I_IN + I_A + I_B + I_O + EXP_DEFER;
        for (int it = gw; it < NITEMS; it += NGW) {
            int r = it;
            if (r < I_IN) { transpose_item<1>(F.w_in, DM, NIN, F.WinT, r, F.lane); continue; } r -= I_IN;
            if (r < I_A) { transpose_item<0>(F.w_a, 256, DM, F.WaT, r, F.lane); continue; } r -= I_A;
            if (r < I_B) { transpose_item<0>(F.w_b, 512, DM, F.WbT, r, F.lane); continue; } r -= I_B;
            if (r < I_O) { transpose_item<0>(F.w_out, DM, DM, F.WoT, r, F.lane); continue; } r -= I_O;
            const int e = r / (3 * I_E), q = r - e * 3 * I_E;
            if (q < I_E) transpose_item<2>(F.w_gate + (size_t)e * DM * DEXP, DM, DEXP, F.GUT + (size_t)e * 1024 * 1024, q, F.lane);
            else if (q < 2 * I_E) transpose_item<3>(F.w_up + (size_t)e * DM * DEXP, DM, DEXP, F.GUT + (size_t)e * 1024 * 1024, q - I_E, F.lane);
            else transpose_item<0>(F.w_down + (size_t)e * DEXP * DM, DEXP, DM, F.DT + (size_t)e * 1024 * 512, q - 2 * I_E, F.lane);
        }
    }
    {
        const int gt = F.vcu * 512 + F.tid, NT = F.G * 512;
        for (int idx = gt; idx < MT * 32; idx += NT) { const int tok = idx >> 5, i = idx & 31;
            double rev = (double)F.positions[tok] * INVF[i] * 0.15915494309189535; rev -= __builtin_rint(rev);
            const float fr = (float)rev; F.rcos[idx] = __builtin_amdgcn_cosf(fr); F.rsin[idx] = __builtin_amdgcn_sinf(fr); }
        for (int idx = gt; idx < 256 * 1024; idx += NT) { const int n = idx >> 10, k = idx & 1023;
            const float v = n < 4 ? F.w_group[k * 4 + n] : (n < 36 ? F.w_route[k * 32 + (n - 4)] : 0.f);
            F.WrT[idx] = (bf16)(cvtpk(v, 0.f) & 0xffffu); }
    }
    if (F.tid == 0) {
        unsigned sp = 0; while (__hip_atomic_load(F.ctl + CW_MODCNT, RLX_AGENT) < (unsigned)(NMOD / 32)) { __builtin_amdgcn_s_sleep(2); if (++sp > (1u << 22)) break; }
        __builtin_amdgcn_fence(__ATOMIC_ACQUIRE, "agent"); VM_WAIT();
    }
    __syncthreads();
}

__device__ __forceinline__ void norm_rows(Frame& F, const float* src, const float* g, int sh_off, int sc_off, bf16* dst) {
    const int gw = F.vcu * 8 + F.wave, NGW = F.G * 8;
    for (int m0 = gw; m0 < MT; m0 += 4 * NGW) {
        f32x4 v[4][4]; float s[4];
#pragma unroll
        for (int q = 0; q < 4; ++q) { const int m = m0 + q * NGW; s[q] = 0.f;
            if (m < MT) { const f32x4* xr = (const f32x4*)(src + (size_t)m * DM) + F.lane;
#pragma unroll
                for (int j = 0; j < 4; ++j) v[q][j] = xr[64 * j]; } }
#pragma unroll
        for (int q = 0; q < 4; ++q) { const int m = m0 + q * NGW; if (m >= MT) continue;
#pragma unroll
            for (int j = 0; j < 4; ++j) s[q] += (v[q][j].x * v[q][j].x + v[q][j].y * v[q][j].y) + (v[q][j].z * v[q][j].z + v[q][j].w * v[q][j].w);
            const float rinv = 1.0f / sqrtf(wave_sum(s[q]) * (1.0f / DM) + RMS_EPS);
            const float* md = F.mod + (m >> 12) * NMOD;
#pragma unroll
            for (int j = 0; j < 4; ++j) { const int col = 4 * (F.lane + 64 * j);
                const f32x4 g4 = *(const f32x4*)(g + col), sc = *(const f32x4*)(md + sc_off + col), sh = *(const f32x4*)(md + sh_off + col);
                const f32x4 h = v[q][j] * rinv * g4 * (1.0f + sc) + sh;
                u32x2 o; o.x = cvtpk(h.x, h.y); o.y = cvtpk(h.z, h.w);
                *(u32x2*)(dst + (size_t)m * DM + col) = o; } }
    }
}

using pg8::GU;
struct SchedTiles {
    const char* A; const char* B; int lda, ldb, nt, nM, nN, G, c;
    __device__ __forceinline__ bool next(int i, GU& u) const {
        int pm, pn; if (!pg8::static_tile(i, G, c, nM, nN, pm, pn)) return false;
        u.A = A + (size_t)pm * 256 * lda; u.B = B + (size_t)pn * 256 * ldb; u.lda = lda; u.ldb = ldb; u.nt = nt; u.zero = 1; u.gslot = 0; u.pm = pm; u.pn = pn; u.aux = 0; u.eslot = 0; return true;
    }
    __device__ __forceinline__ void a_ready(const GU&) const {}
};
struct SchedBranch {
    const char* OA; const char* OB; const char* WaT; const char* WbT; int G, c;
    __device__ __forceinline__ bool next(int i, GU& u) const {
        int pm, pn; if (!pg8::static_tile(i >> 1, G, c, 64, 4, pm, pn)) return false;
        if ((i & 1) == 0) { u.A = OB + (size_t)pm * 256 * 1024; u.B = WbT + (size_t)pn * 256 * 1024; u.lda = 1024; u.ldb = 1024; u.nt = 8; u.zero = 1; u.aux = 0; }
        else { u.A = OA + (size_t)pm * 256 * 512; u.B = WaT + (size_t)pn * 256 * 512; u.lda = 512; u.ldb = 512; u.nt = 4; u.zero = 0; u.aux = 1; }
        u.gslot = 0; u.pm = pm; u.pn = pn; u.eslot = 0; return true;
    }
    __device__ __forceinline__ void a_ready(const GU&) const {}
};
__device__ __forceinline__ int moe_deal(int i, int c, int G, int n4) {
    const int q = n4 / G, r = n4 - q * G, n7 = q + (c < r ? 1 : 0);
    if (i < n7) return i * G + c;
    const int k = i - n7, Lc = G - r; int j;
    if (c >= r) j = k == 0 ? (c - r) : (k == 1 ? Lc + (c - r) : 2 * Lc + (k - 2) * G + c);
    else j = 2 * Lc + k * G + c;
    return j < n4 ? n4 + j : -1;
}
struct SchedMoe {
    const char* H; const char* ACT; const char* GUT; const char* DT; const LAS int* rbtab; unsigned* cnt; int n4, n7, G, c;
    __device__ __forceinline__ bool next(int i, GU& u) const {
        const int t = moe_deal(i, c, G, n4); if (t < 0) return false;
        if (t < n4) { const int rb = t >> 2, pn = t & 3, e = rbtab[rb] >> 8;
            u.A = H; u.B = GUT + (size_t)e * (1024 * 2048) + (size_t)pn * 256 * 2048; u.lda = 2048; u.ldb = 2048; u.nt = 16; u.gslot = i; u.eslot = 0; u.pm = rb; u.pn = pn; u.aux = 0; }
        else { const int j = t - n4, rb = j >> 2, pn = j & 3, e = rbtab[rb] >> 8;
            u.A = ACT + (size_t)rb * 256 * 1024; u.B = DT + (size_t)e * (1024 * 1024) + (size_t)pn * 256 * 1024; u.lda = 1024; u.ldb = 1024; u.nt = 8; u.gslot = -1; u.eslot = i - n7; u.pm = rb; u.pn = pn; u.aux = 1; }
        u.zero = 1; return true;
    }
    __device__ __forceinline__ void a_ready(const GU& u) const {
        if (u.aux != 1) return;
        if (threadIdx.x < 64) {
            unsigned sp = 0;
            while ((unsigned)__builtin_amdgcn_readfirstlane(__hip_atomic_load(cnt + 64 * u.pm, RLX_AGENT)) < 32u) { __builtin_amdgcn_s_sleep(2); if (++sp > (1u << 20)) break; }
            __builtin_amdgcn_fence(__ATOMIC_ACQUIRE, "agent");
            asm volatile("s_waitcnt vmcnt(0)" ::: "memory");
        }
        asm volatile("" ::: "memory"); __builtin_amdgcn_s_barrier(); asm volatile("" ::: "memory");
    }
};

__device__ __forceinline__ int strided_row(int s, int sh) { return ((s & ((1 << sh) - 1)) << (12 - sh)) | (s >> sh); }

struct EpiIn {
    static constexpr bool PERM = true, AFTER_DRAIN = false, DEFER_PUBLISH = false;
    bf16 *QA, *KA, *VAT, *QB, *KB, *VBT; unsigned char *SGA, *SGB; const float *rcos, *rsin;
    __device__ __forceinline__ void operator()(f32x4 (&acc)[2][2][4][2], const GU& u, int wr, int wc, int fr, int fq) const {
        const int row0 = u.pm * 256 + wr * 64 + fr;
        if (u.pn >= 12) {
            unsigned char* base = (u.pn < 16 ? SGA : SGB) + (size_t)(u.pm * 4 + ((u.pn - 12) & 3)) * 65536 + (size_t)(((wr * 4 + wc) * 64 + fq * 16 + fr) * 16);
#pragma unroll
            for (int ai = 0; ai < 2; ++ai)
#pragma unroll
                for (int m = 0; m < 4; ++m) { u32x4 w;
#pragma unroll
                    for (int bj = 0; bj < 2; ++bj)
#pragma unroll
                        for (int n = 0; n < 2; ++n) { unsigned p = 0;
#pragma unroll
                            for (int j = 0; j < 4; ++j) p = __builtin_amdgcn_cvt_pk_u8_f32(fmaxf(fsigmoid(acc[ai][bj][m][n][j]) * 255.0f, 1.0f), j, p);
                            w[bj * 2 + n] = p; }
                    *(u32x4*)(base + (size_t)(ai * 4 + m) * 8192) = w; }
            return;
        }
#pragma unroll
        for (int bj = 0; bj < 2; ++bj) {
            const int blk = 2 * u.pn + bj;
            const int pc = 32 * (wc & 1) + 8 * fq;
            if (blk < 12 || (blk >= 18 && blk < 23)) {
                const bool isq = (blk < 6) || (blk >= 18 && blk < 22);
                const float sc = isq ? QSCALE : 1.0f;
                const int g4 = 4 * (pc >> 3);
                bf16* base; int hd, nh, sh;
                if (blk < 6) { base = QA; hd = 2 * blk + (wc >> 1); nh = 12; sh = 2 * (hd >> 2); }
                else if (blk < 12) { base = KA; hd = 2 * (blk - 6) + (wc >> 1); nh = 12; sh = 2 * (hd >> 2); }
                else if (blk < 22) { base = QB; hd = 2 * (blk - 18) + (wc >> 1); nh = 8; sh = 0; }
                else { base = KB; hd = (wc >> 1); nh = 2; sh = 0; }
                f32x4 cs[2][4], sn[2][4];
#pragma unroll
                for (int ai = 0; ai < 2; ++ai)
#pragma unroll
                    for (int m = 0; m < 4; ++m) { const size_t ro = (size_t)(row0 + ai * 128 + m * 16) * 32 + g4; cs[ai][m] = *(const f32x4*)(rcos + ro); sn[ai][m] = *(const f32x4*)(rsin + ro); }
#pragma unroll
                for (int ai = 0; ai < 2; ++ai)
#pragma unroll
                    for (int m = 0; m < 4; ++m) {
                        const int row = row0 + ai * 128 + m * 16, b = row >> 12, s = row & 4095;
                        const f32x4 x1 = acc[ai][bj][m][0], x2 = acc[ai][bj][m][1];
                        const f32x4 o1 = (x1 * cs[ai][m] - x2 * sn[ai][m]) * sc, o2 = (x2 * cs[ai][m] + x1 * sn[ai][m]) * sc;
                        u32x4 w; w.x = cvtpk(o1[0], o1[1]); w.y = cvtpk(o1[2], o1[3]); w.z = cvtpk(o2[0], o2[1]); w.w = cvtpk(o2[2], o2[3]);
                        const int srow = strided_row(s, sh), q8 = pc >> 3;
                        *(u32x4*)(base + ((size_t)(b * nh + hd) * 4096 + (srow & ~31)) * 64 + (q8 >> 1) * 512 + (32 * (q8 & 1) + (srow & 31)) * 8) = w;
                    }
            } else if (blk < 24) {
                bf16* base; int hd, nh, sh;
                if (blk < 18) { base = VAT; hd = 2 * (blk - 12) + (wc >> 1); nh = 12; sh = 2 * (hd >> 2); }
                else { base = VBT; hd = (wc >> 1); nh = 2; sh = 0; }
                if (sh == 4) {
#pragma unroll
                    for (int ai = 0; ai < 2; ++ai) {
                        const int row = row0 + ai * 128, b = row >> 12, s = row & 4095;
                        const int srow = strided_row(s, 4), kap = srow & 31;
                        bf16* p = base + ((size_t)(b * nh + hd) * 4096 + (srow & ~31)) * 64 + ((pc >> 5) * 2 + (kap >> 4)) * 512 + (32 * ((kap >> 2) & 1) + (pc & 31)) * 8 + 4 * ((kap >> 3) & 1);
#pragma unroll
                        for (int n = 0; n < 2; ++n)
#pragma unroll
                            for (int j = 0; j < 4; ++j) { u32x2 w; w.x = cvtpk(acc[ai][bj][0][n][j], acc[ai][bj][1][n][j]); w.y = cvtpk(acc[ai][bj][2][n][j], acc[ai][bj][3][n][j]);
                                *(u32x2*)(p + (4 * n + j) * 8) = w; }
                    }
                } else {
#pragma unroll
                for (int ai = 0; ai < 2; ++ai)
#pragma unroll
                    for (int m = 0; m < 4; ++m) {
                        const int row = row0 + ai * 128 + m * 16, b = row >> 12, s = row & 4095;
                        const int srow = strided_row(s, sh), kap = srow & 31;
                        bf16* p = base + ((size_t)(b * nh + hd) * 4096 + (srow & ~31)) * 64 + ((pc >> 5) * 2 + (kap >> 4)) * 512 + (32 * ((kap >> 2) & 1) + (pc & 31)) * 8 + 4 * ((kap >> 3) & 1) + (kap & 3);
                        const f32x4 v0 = acc[ai][bj][m][0], v1 = acc[ai][bj][m][1];
                        const unsigned a = cvtpk(v0[0], v0[1]), bb = cvtpk(v0[2], v0[3]), c = cvtpk(v1[0], v1[1]), d = cvtpk(v1[2], v1[3]);
                        p[0 * 8] = (bf16)(a & 0xffffu); p[1 * 8] = (bf16)(a >> 16); p[2 * 8] = (bf16)(bb & 0xffffu); p[3 * 8] = (bf16)(bb >> 16);
                        p[4 * 8] = (bf16)(c & 0xffffu); p[5 * 8] = (bf16)(c >> 16); p[6 * 8] = (bf16)(d & 0xffffu); p[7 * 8] = (bf16)(d >> 16);
                    }
                }
            }
        }
    }
};

struct EpiMerge {
    static constexpr bool PERM = true, AFTER_DRAIN = false, DEFER_PUBLISH = false;
    const unsigned char *SGA, *SGB; bf16* MERGED;
    __device__ __forceinline__ void operator()(f32x4 (&acc)[2][2][4][2], const GU& u, int wr, int wc, int fr, int fq) const {
        const int row0 = u.pm * 256 + wr * 64 + fr, col0 = u.pn * 256 + wc * 32 + 8 * fq;
        const size_t gbase = (size_t)(u.pm * 4 + u.pn) * 65536 + (size_t)(((wr * 4 + wc) * 64 + fq * 16 + fr) * 16);
#pragma unroll
        for (int ai = 0; ai < 2; ++ai)
#pragma unroll
            for (int m = 0; m < 4; ++m) {
                const u32x4 ga = *(const u32x4*)(SGA + gbase + (size_t)(ai * 4 + m) * 8192);
                if (u.aux == 0) {
                    const u32x4 gb = *(const u32x4*)(SGB + gbase + (size_t)(ai * 4 + m) * 8192);
#pragma unroll
                    for (int bj = 0; bj < 2; ++bj)
#pragma unroll
                        for (int n = 0; n < 2; ++n)
#pragma unroll
                            for (int j = 0; j < 4; ++j) acc[ai][bj][m][n][j] *= (float)((gb[bj * 2 + n] >> (8 * j)) & 255u) * frcp((float)((ga[bj * 2 + n] >> (8 * j)) & 255u));
                } else {
#pragma unroll
                    for (int bj = 0; bj < 2; ++bj) { f32x4 v0, v1;
#pragma unroll
                        for (int j = 0; j < 4; ++j) { v0[j] = acc[ai][bj][m][0][j] * ((float)((ga[bj * 2] >> (8 * j)) & 255u) * (1.0f / 255.0f)); v1[j] = acc[ai][bj][m][1][j] * ((float)((ga[bj * 2 + 1] >> (8 * j)) & 255u) * (1.0f / 255.0f)); }
                        u32x4 w; w.x = cvtpk(v0[0], v0[1]); w.y = cvtpk(v0[2], v0[3]); w.z = cvtpk(v1[0], v1[1]); w.w = cvtpk(v1[2], v1[3]);
                        *(u32x4*)(MERGED + (size_t)(row0 + ai * 128 + m * 16) * DM + col0 + bj * 128) = w; }
                }
            }
    }
};

struct EpiX1 {
    static constexpr bool PERM = true, AFTER_DRAIN = false, DEFER_PUBLISH = false;
    const float* x; const float* mod; bf16* X1;
    __device__ __forceinline__ void operator()(f32x4 (&acc)[2][2][4][2], const GU& u, int wr, int wc, int fr, int fq) const {
        const int row0 = u.pm * 256 + wr * 64 + fr, col0 = u.pn * 256 + wc * 32 + 8 * fq, b = (u.pm * 256) >> 12;
        const float* gt = mod + b * NMOD + 2 * DM;
#pragma unroll
        for (int bj = 0; bj < 2; ++bj) { const int col = col0 + bj * 128; const f32x4 g0 = *(const f32x4*)(gt + col), g1 = *(const f32x4*)(gt + col + 4);
#pragma unroll
            for (int ai = 0; ai < 2; ++ai)
#pragma unroll
                for (int m = 0; m < 4; ++m) { const size_t off = (size_t)(row0 + ai * 128 + m * 16) * DM + col;
                    const f32x4 v0 = __builtin_nontemporal_load((const f32x4*)(x + off)) + g0 * acc[ai][bj][m][0], v1 = __builtin_nontemporal_load((const f32x4*)(x + off + 4)) + g1 * acc[ai][bj][m][1];
                    u32x4 w; w.x = cvtpk(v0[0], v0[1]); w.y = cvtpk(v0[2], v0[3]); w.z = cvtpk(v1[0], v1[1]); w.w = cvtpk(v1[2], v1[3]);
                    *(u32x4*)(X1 + off) = w; } }
    }
};

struct EpiMoe {
    static constexpr bool PERM = true, AFTER_DRAIN = false, DEFER_PUBLISH = true;
    bf16* ACT; bf16* Y; const LAS int* dtab; const LAS float* wtab; unsigned* cnt;
    __device__ __forceinline__ bool wants_publish(const GU& u) const { return u.aux == 0; }
    __device__ __forceinline__ void publish(int rb, int lane) const { if (lane == 0) __hip_atomic_fetch_add(cnt + 64 * rb, 1u, RLX_AGENT); }
    __device__ __forceinline__ void operator()(f32x4 (&acc)[2][2][4][2], const GU& u, int wr, int wc, int fr, int fq) const {
        if (u.aux == 0) {
            const int row0 = u.pm * 256 + wr * 64 + fr, col0 = u.pn * 128 + wc * 32 + 8 * fq;
#pragma unroll
            for (int ai = 0; ai < 2; ++ai)
#pragma unroll
                for (int m = 0; m < 4; ++m) { f32x4 a0, a1;
#pragma unroll
                    for (int j = 0; j < 4; ++j) { const float g0 = acc[ai][0][m][0][j], g1 = acc[ai][0][m][1][j]; a0[j] = g0 * fsigmoid(g0) * acc[ai][1][m][0][j]; a1[j] = g1 * fsigmoid(g1) * acc[ai][1][m][1][j]; }
                    u32x4 w; w.x = cvtpk(a0[0], a0[1]); w.y = cvtpk(a0[2], a0[3]); w.z = cvtpk(a1[0], a1[1]); w.w = cvtpk(a1[2], a1[3]);
                    st16_sc1(ACT + (size_t)(row0 + ai * 128 + m * 16) * DEXP + col0, w); }
        } else {
            const int r0 = wr * 64 + fr, col0 = u.pn * 256 + wc * 32 + 8 * fq;
#pragma unroll
            for (int ai = 0; ai < 2; ++ai)
#pragma unroll
                for (int m = 0; m < 4; ++m) { const int r = r0 + ai * 128 + m * 16; const int dest = dtab[u.eslot * 256 + r]; const float w = wtab[u.eslot * 256 + r];
                    if (dest >= 0) {
#pragma unroll
                        for (int bj = 0; bj < 2; ++bj) { const f32x4 v0 = acc[ai][bj][m][0] * w, v1 = acc[ai][bj][m][1] * w;
                            u32x4 o; o.x = cvtpk(v0[0], v0[1]); o.y = cvtpk(v0[2], v0[3]); o.z = cvtpk(v1[0], v1[1]); o.w = cvtpk(v1[2], v1[3]);
                            *(u32x4*)(Y + (size_t)dest * DM + col0 + bj * 128) = o; } } }
        }
    }
};

#define MFMA32(a, b, c) __builtin_amdgcn_mfma_f32_32x32x16_bf16((a), (b), (c), 0, 0, 0)
__device__ __forceinline__ int crow(int reg, int h) { return (reg & 3) + 8 * (reg >> 2) + 4 * h; }
struct KVFrag { bf16x8 k[4], v[4]; };
#define GLD16(dst, ptr, OFF) asm volatile("global_load_dwordx4 %0, %1, off offset:" #OFF : "=v"(dst) : "v"(ptr) : "memory")
__device__ __forceinline__ void kv_load(KVFrag& f, const bf16* kp, const bf16* vp) {
    GLD16(f.k[0], kp, 0); GLD16(f.k[1], kp, 1024); GLD16(f.k[2], kp, 2048); GLD16(f.k[3], kp, 3072);
    GLD16(f.v[0], vp, 0); GLD16(f.v[1], vp, 1024); GLD16(f.v[2], vp, 2048); GLD16(f.v[3], vp, 3072);
}
#define KV_WAIT(f, N) asm volatile("s_waitcnt vmcnt(" #N ")" : "+v"(f.k[0]), "+v"(f.k[1]), "+v"(f.k[2]), "+v"(f.k[3]), "+v"(f.v[0]), "+v"(f.v[1]), "+v"(f.v[2]), "+v"(f.v[3]) :: "memory")
__device__ __forceinline__ void attn_tile(const KVFrag& f, const bf16x8 (&qf)[4], bool first, bool lastt, int r, int h, float& m, float& l, f32x16& o0, f32x16& o1) {
    f32x16 st;
#pragma unroll
    for (int e = 0; e < 16; ++e) st[e] = 0.f;
#pragma unroll
    for (int c = 0; c < 4; ++c) st = MFMA32(f.k[c], qf[c], st);
    if (first || lastt) {
        int rq = r - 4 * h; asm volatile("" : "+v"(rq));
        if (first) {
#pragma unroll
            for (int e = 0; e < 16; ++e) st[e] = ((e & 3) + 8 * (e >> 2) < rq) ? -1.0e30f : st[e];
        } else {
#pragma unroll
            for (int e = 0; e < 16; ++e) st[e] = ((e & 3) + 8 * (e >> 2) > rq) ? -1.0e30f : st[e];
        }
    }
    float tm = st[0];
#pragma unroll
    for (int e = 1; e < 16; ++e) tm = fmaxf(tm, st[e]);
    { auto rr = __builtin_amdgcn_permlane32_swap(__float_as_uint(tm), __float_as_uint(tm), false, false); tm = fmaxf(__uint_as_float(rr[0]), __uint_as_float(rr[1])); }
    const float mn = fmaxf(m, tm), alpha = fexp2(m - mn); m = mn;
    float ps = 0.f;
#pragma unroll
    for (int e = 0; e < 16; ++e) { st[e] = fexp2(st[e] - mn); ps += st[e]; }
    l = l * alpha + ps;
#pragma unroll
    for (int e = 0; e < 16; ++e) { o0[e] *= alpha; o1[e] *= alpha; }
    u32x4 pa, pb;
    pa.x = cvtpk(st[0], st[1]); pa.y = cvtpk(st[2], st[3]); pa.z = cvtpk(st[4], st[5]); pa.w = cvtpk(st[6], st[7]);
    pb.x = cvtpk(st[8], st[9]); pb.y = cvtpk(st[10], st[11]); pb.z = cvtpk(st[12], st[13]); pb.w = cvtpk(st[14], st[15]);
    const bf16x8 p0 = __builtin_bit_cast(bf16x8, pa), p1 = __builtin_bit_cast(bf16x8, pb);
    o0 = MFMA32(f.v[0], p0, o0); o0 = MFMA32(f.v[1], p1, o0);
    o1 = MFMA32(f.v[2], p0, o1); o1 = MFMA32(f.v[3], p1, o1);
}
template <int W>
__device__ __forceinline__ void attn_job(const bf16* __restrict__ Qp, const bf16* __restrict__ Kp, const bf16* __restrict__ Vp, int L, int t0, float m0, float l0,
                                         f32x16& o0, f32x16& o1, float& m_out, float& l_out, int lane) {
    constexpr int NT = 2 * W / 32 + 1;
    const int r = lane & 31, h = lane >> 5;
    bf16x8 qf[4];
    { const bf16* qp = Qp + (size_t)(t0 >> 5) * 2048 + lane * 8; GLD16(qf[0], qp, 0); GLD16(qf[1], qp, 1024); GLD16(qf[2], qp, 2048); GLD16(qf[3], qp, 3072); }
    float m = m0, l = (h == 0) ? l0 : 0.f;
#pragma unroll
    for (int i = 0; i < 16; ++i) { o0[i] = 0.f; o1[i] = 0.f; }
    const int i_lo = (W - t0) > 0 ? ((W - t0) >> 5) : 0, i_hi = ((L - t0 + W) >> 5) < NT ? ((L - t0 + W) >> 5) : NT;
    const bf16* kq = Kp + lane * 8; const bf16* vq = Vp + lane * 8;
#define TILE_OFF(ii) ((size_t)((t0 - W + 32 * ((ii) < i_hi ? (ii) : i_hi - 1)) >> 5) * 2048)
    KVFrag fa, fb;
    int i = i_lo;
    kv_load(fa, kq + TILE_OFF(i), vq + TILE_OFF(i));
#pragma unroll 1
    for (;;) {
        kv_load(fb, kq + TILE_OFF(i + 1), vq + TILE_OFF(i + 1));
        KV_WAIT(fa, 8); asm volatile("" : "+v"(qf[0]), "+v"(qf[1]), "+v"(qf[2]), "+v"(qf[3]));
        attn_tile(fa, qf, i == 0, i == NT - 1, r, h, m, l, o0, o1);
        if (++i >= i_hi) break;
        kv_load(fa, kq + TILE_OFF(i + 1), vq + TILE_OFF(i + 1));
        KV_WAIT(fb, 8);
        attn_tile(fb, qf, i == 0, i == NT - 1, r, h, m, l, o0, o1);
        if (++i >= i_hi) break;
    }
    KV_WAIT(fa, 0); KV_WAIT(fb, 0);
#undef TILE_OFF
    l += __shfl_xor(l, 32);
    m_out = m; l_out = l;
}

constexpr int PSTRIDE = 136;
__device__ __forceinline__ void attn_phase(Frame& F) {
    LAS unsigned char* P = F.lds;
    LAS f32x2* ML = (LAS f32x2*)(F.lds + 3 * 256 * PSTRIDE);
    const int lane = F.lane, r = lane & 31, h = lane >> 5;
    for (int uidx = F.vcu; uidx < 512; uidx += F.G) {
        if (uidx < 256) {
            const int b = uidx >> 6, hs = (uidx >> 4) & 3, c = uidx & 15;
#pragma unroll 1
            for (int jj = 0; jj < 4; ++jj) {
                const int j = F.wave + 8 * jj;
                int g, head, res, t0, L, slot; bool valid = true;
                if (j < 8) { g = 0; head = hs; res = 0; t0 = 256 * c + 32 * j; L = 4096; slot = 32 * j + r; }
                else if (j < 16) { const int q = j - 8; g = 1; head = 4 + hs; res = q >> 1; t0 = 64 * c + 32 * (q & 1); L = 1024; slot = res * 64 + 32 * (q & 1) + r; }
                else { const int q = j - 16; g = 2; head = 8 + hs; res = q; t0 = 32 * (c >> 1); L = 256; valid = (r >> 4) == (c & 1); slot = res * 16 + (r & 15); }
                const size_t hb = (size_t)(b * 12 + head);
                const bf16* Qp = F.QA + (hb * 4096 + (size_t)res * L) * 64;
                const bf16* Kp = F.KA + (hb * 4096 + (size_t)res * L) * 64;
                const bf16* Vt = F.VAT + (hb * 4096 + (size_t)res * L) * 64;
                f32x16 o0, o1; float m, l;
                attn_job<64>(Qp, Kp, Vt, L, t0, -1.0e30f, 0.f, o0, o1, m, l, lane);
                if (valid) {
                    LAS unsigned char* row = P + (g * 256 + slot) * PSTRIDE;
#pragma unroll
                    for (int q4 = 0; q4 < 4; ++q4) {
                        u32x2 w0, w1; w0.x = cvtpk(o0[4 * q4], o0[4 * q4 + 1]); w0.y = cvtpk(o0[4 * q4 + 2], o0[4 * q4 + 3]); w1.x = cvtpk(o1[4 * q4], o1[4 * q4 + 1]); w1.y = cvtpk(o1[4 * q4 + 2], o1[4 * q4 + 3]);
                        *(LAS u32x2*)(row + (8 * q4 + 4 * h) * 2) = w0; *(LAS u32x2*)(row + (32 + 8 * q4 + 4 * h) * 2) = w1; }
                    if (h == 0) ML[g * 256 + slot] = (f32x2){m, l};
                }
            }
            __syncthreads();
            {
                const int tau = F.tid >> 1, half = F.tid & 1;
                const int s0 = tau, s1 = 256 + (tau & 3) * 64 + (tau >> 2), s2 = 512 + (tau & 15) * 16 + (tau >> 4);
                const f32x2 a0 = ML[s0], a1 = ML[s1], a2 = ML[s2];
                const float M = fmaxf(a0.x, fmaxf(a1.x, a2.x));
                float w0 = fexp2(a0.x - M), w1 = fexp2(a1.x - M), w2 = fexp2(a2.x - M);
                const float inv = 1.0f / (w0 * a0.y + w1 * a1.y + w2 * a2.y); w0 *= inv; w1 *= inv; w2 *= inv;
                bf16* dst = F.OA + (size_t)(b * 4096 + 256 * c + tau) * 256 + hs * 64 + 32 * half;
#pragma unroll
                for (int q = 0; q < 4; ++q) {
                    const u32x4 x0 = *(const LAS u32x4*)(P + s0 * PSTRIDE + (32 * half + 8 * q) * 2), x1 = *(const LAS u32x4*)(P + s1 * PSTRIDE + (32 * half + 8 * q) * 2), x2 = *(const LAS u32x4*)(P + s2 * PSTRIDE + (32 * half + 8 * q) * 2);
                    u32x4 o;
#pragma unroll
                    for (int k = 0; k < 4; ++k) { const float lo = w0 * bflo(x0[k]) + w1 * bflo(x1[k]) + w2 * bflo(x2[k]), hi = w0 * bfhi(x0[k]) + w1 * bfhi(x1[k]) + w2 * bfhi(x2[k]); o[k] = cvtpk(lo, hi); }
                    *(u32x4*)(dst + 8 * q) = o; }
            }
            __syncthreads();
        } else {
            const int uu = uidx - 256, b = uu >> 6, kvh = (uu >> 5) & 1, qb = uu & 31, T0 = 4 * qb - 4;
            const bf16* Kb_ = F.KB + (size_t)(b * 2 + kvh) * 4096 * 64; const bf16* Vb_ = F.VBT + (size_t)(b * 2 + kvh) * 4096 * 64;
            for (int x = F.wave; x < 24; x += 8) { const int j = x >> 1, kv = x & 1, T = T0 + j; if (T < 0 || T > 127) continue;
                const bf16* src = (kv ? Vb_ : Kb_) + (size_t)T * 2048 + lane * 8;
#pragma unroll
                for (int c = 0; c < 4; ++c) __builtin_amdgcn_global_load_lds((const unsigned*)(src + c * 512), (LAS unsigned*)(F.lds + j * 8192 + kv * 4096 + c * 1024), 16, 0, 0); }
            VM_WAIT(); __syncthreads();
#pragma unroll 1
            for (int jj = 0; jj < 2; ++jj) {
                const int j = F.wave + 8 * jj, head = kvh * 4 + (j >> 2), qt = j & 3, t0 = 128 * qb + 32 * qt;
                const bf16* Qp = F.QB + (size_t)(b * 8 + head) * 4096 * 64 + (size_t)(t0 >> 5) * 2048 + lane * 8;
                bf16x8 qf[4];
#pragma unroll
                for (int c = 0; c < 4; ++c) qf[c] = *(const bf16x8*)(Qp + c * 512);
                float m = F.sink[head] * LOG2E, l = (h == 0) ? 1.0f : 0.f;
                f32x16 o0, o1;
#pragma unroll
                for (int e = 0; e < 16; ++e) { o0[e] = 0.f; o1[e] = 0.f; }
#pragma unroll 1
                for (int i = 0; i < 9; ++i) { const int T = T0 + qt + i; if (T < 0 || T > 127) continue;
                    const LAS unsigned char* tp = F.lds + (qt + i) * 8192 + lane * 16;
                    KVFrag f;
#pragma unroll
                    for (int c = 0; c < 4; ++c) { f.k[c] = *(const LAS bf16x8*)(tp + c * 1024); f.v[c] = *(const LAS bf16x8*)(tp + 4096 + c * 1024); }
                    attn_tile(f, qf, i == 0, i == 8, r, h, m, l, o0, o1); }
                l += __shfl_xor(l, 32);
                const float inv = 1.0f / l;
                bf16* dst = F.OB + (size_t)(b * 4096 + t0 + r) * 512 + head * 64;
#pragma unroll
                for (int q4 = 0; q4 < 4; ++q4) {
                    u32x2 w0, w1; w0.x = cvtpk(o0[4 * q4] * inv, o0[4 * q4 + 1] * inv); w0.y = cvtpk(o0[4 * q4 + 2] * inv, o0[4 * q4 + 3] * inv);
                    w1.x = cvtpk(o1[4 * q4] * inv, o1[4 * q4 + 1] * inv); w1.y = cvtpk(o1[4 * q4 + 2] * inv, o1[4 * q4 + 3] * inv);
                    *(u32x2*)(dst + 8 * q4 + 4 * h) = w0; *(u32x2*)(dst + 32 + 8 * q4 + 4 * h) = w1; }
            }
            __syncthreads();
        }
    }
}

__device__ __forceinline__ void norm_route_phase(Frame& F, int bank) {
    LAS unsigned char* A = F.lds;
    const int lane = F.lane, w = F.wave;
    for (int u = F.vcu; u < MT / 64; u += F.G) {
        {
            u32x4 xv[8][2];
#pragma unroll
            for (int q = 0; q < 8; ++q) { const u32x4* xr = (const u32x4*)(F.X1 + (size_t)(64 * u + 8 * w + q) * DM) + lane; xv[q][0] = xr[0]; xv[q][1] = xr[64]; }
            f32x4 gg[2][2], sc[2][2], sh[2][2];
            const float* md = F.mod + ((64 * u) >> 12) * NMOD;
#pragma unroll
            for (int j = 0; j < 2; ++j)
#pragma unroll
                for (int hh = 0; hh < 2; ++hh) { const int col = 8 * (lane + 64 * j) + 4 * hh; gg[j][hh] = *(const f32x4*)(F.g_ffn + col); sc[j][hh] = *(const f32x4*)(md + 4 * DM + col) + 1.0f; sh[j][hh] = *(const f32x4*)(md + 3 * DM + col); }
#pragma unroll
            for (int q = 0; q < 8; ++q) {
                const int rl = 8 * w + q, m = 64 * u + rl; float ss = 0.f; f32x4 f[2][2];
#pragma unroll
                for (int j = 0; j < 2; ++j) { f[j][0] = (f32x4){bflo(xv[q][j].x), bfhi(xv[q][j].x), bflo(xv[q][j].y), bfhi(xv[q][j].y)}; f[j][1] = (f32x4){bflo(xv[q][j].z), bfhi(xv[q][j].z), bflo(xv[q][j].w), bfhi(xv[q][j].w)};
#pragma unroll
                    for (int hh = 0; hh < 2; ++hh) ss += (f[j][hh].x * f[j][hh].x + f[j][hh].y * f[j][hh].y) + (f[j][hh].z * f[j][hh].z + f[j][hh].w * f[j][hh].w); }
                const float rinv = 1.0f / sqrtf(wave_sum(ss) * (1.0f / DM) + RMS_EPS);
#pragma unroll
                for (int j = 0; j < 2; ++j) { const int col = 8 * (lane + 64 * j);
                    const f32x4 h0 = f[j][0] * rinv * gg[j][0] * sc[j][0] + sh[j][0], h1 = f[j][1] * rinv * gg[j][1] * sc[j][1] + sh[j][1];
                    u32x4 o; o.x = cvtpk(h0.x, h0.y); o.y = cvtpk(h0.z, h0.w); o.z = cvtpk(h1.x, h1.y); o.w = cvtpk(h1.z, h1.w);
                    *(u32x4*)(F.H + (size_t)m * DM + col) = o;
                    *(LAS u32x4*)(A + rl * 2048 + ((((col >> 3) ^ (rl & 15))) << 4)) = o; }
            }
        }
        __syncthreads();
        const int rt = w & 1, ct = (w >> 1) & 1, kq = w >> 2, r = lane & 31, h = lane >> 5;
        f32x16 acc;
#pragma unroll
        for (int e = 0; e < 16; ++e) acc[e] = 0.f;
        {
            const bf16* bp = F.WrT + (size_t)(32 * ct + r) * DM + 512 * kq + 8 * h;
            const int arow = 32 * rt + r;
            const LAS unsigned char* ap = A + arow * 2048;
#pragma unroll 8
            for (int ks = 0; ks < 32; ++ks) {
                const bf16x8 bf = *(const bf16x8*)(bp + 16 * ks);
                const int chunk = 64 * kq + 2 * ks + h;
                const bf16x8 af = *(const LAS bf16x8*)(ap + ((chunk ^ (arow & 15)) << 4));
                acc = MFMA32(af, bf, acc);
            }
        }
        __syncthreads();
        LAS float* P = (LAS float*)F.lds;
        LAS int* lcnt = (LAS int*)(F.lds + 2 * 64 * 68 * 4);
#pragma unroll
        for (int e = 0; e < 16; ++e) P[(kq * 64 + 32 * rt + crow(e, h)) * 68 + 32 * ct + r] = acc[e];
        if (F.tid < 64) lcnt[F.tid] = 0;
        __syncthreads();
        int e1 = 0, e2 = 0, p1 = 0, p2 = 0; float w1 = 0.f, w2 = 0.f;
        if (F.tid < 64) {
            const LAS float* q0 = P + F.tid * 68; const LAS float* q1 = P + (64 + F.tid) * 68;
            float gl[4]; float gmax = -3.0e38f; int gs = 0;
#pragma unroll
            for (int j = 0; j < 4; ++j) { gl[j] = q0[j] + q1[j] + F.b_group[j]; if (gl[j] > gmax) { gmax = gl[j]; gs = j; } }
            float gz = 0.f;
#pragma unroll
            for (int j = 0; j < 4; ++j) gz += __expf(gl[j] - gmax);
            const float gw = 1.0f / gz;
            float el[8]; float m1 = -3.0e38f; int i1 = 0;
#pragma unroll
            for (int j = 0; j < 8; ++j) { el[j] = q0[4 + 8 * gs + j] + q1[4 + 8 * gs + j] + F.b_route[8 * gs + j]; if (el[j] > m1) { m1 = el[j]; i1 = j; } }
            float m2 = -3.0e38f; int i2 = 0;
#pragma unroll
            for (int j = 0; j < 8; ++j) { if (j != i1 && el[j] > m2) { m2 = el[j]; i2 = j; } }
            const float q2 = __expf(m2 - m1), inv = 1.0f / (1.0f + q2);
            w1 = inv * gw; w2 = q2 * inv * gw; e1 = 8 * gs + i1; e2 = 8 * gs + i2;
            p1 = atomicAdd((int*)(lcnt + e1), 1); p2 = atomicAdd((int*)(lcnt + e2), 1);
        }
        __syncthreads();
        const int shard = F.bx & 7;
        if (F.tid < 32) { const int c = lcnt[F.tid]; lcnt[32 + F.tid] = c ? (int)__hip_atomic_fetch_add(F.ctl + CW_CNT + bank * 49152 + 64 * (32 * shard + F.tid), (unsigned)c, RLX_AGENT) : 0; }
        __syncthreads();
        if (F.tid < 64) {
            const int tok = 64 * u + F.tid;
            F.list[(bank << 20) + ((32 * shard + e1) << 12) + lcnt[32 + e1] + p1] = 2 * tok; F.wts[2 * tok] = w1;
            F.list[(bank << 20) + ((32 * shard + e2) << 12) + lcnt[32 + e2] + p2] = 2 * tok + 1; F.wts[2 * tok + 1] = w2;
        }
        __syncthreads();
    }
}

__device__ __forceinline__ void moe_setup(Frame& F, int& n4_out, int& n7_out) {
    LAS int* rbtab = (LAS int*)(F.lds + TAB_RB); LAS int* cnttab = (LAS int*)(F.lds + TAB_CNT); LAS int* nbw = (LAS int*)(F.lds + TAB_NB);
    LAS int* gidx = (LAS int*)(F.lds + TAB_GIDX); LAS int* dtab = (LAS int*)(F.lds + TAB_D); LAS float* wtab = (LAS float*)(F.lds + TAB_W);
    LAS int* pref = (LAS int*)(F.lds + TAB_PREF);
    if (F.tid < 256) pref[(F.tid & 31) * 8 + (F.tid >> 5)] = (int)__hip_atomic_load(F.ctl + CW_CNT + 64 * F.tid, RLX_AGENT);
    __syncthreads();
    if (F.tid < 64) {
        int cnt = 0;
        if (F.tid < 32) { for (int sh = 0; sh < 8; ++sh) { const int c = pref[F.tid * 8 + sh]; pref[F.tid * 8 + sh] = cnt; cnt += c; } }
        const int nb = (cnt + 255) >> 8; int incl = nb;
#pragma unroll
        for (int o = 1; o < 32; o <<= 1) { const int t = __shfl_up(incl, o); if (F.lane >= o) incl += t; }
        if (F.tid < 32) { cnttab[F.tid] = cnt; const int st = incl - nb; for (int j = 0; j < nb; ++j) rbtab[st + j] = (F.tid << 8) | j; }
        if (F.tid == 31) nbw[0] = incl;
    }
    __syncthreads();
    const int n4 = 4 * nbw[0];
    const int n7 = n4 / F.G + (F.bx < n4 % F.G ? 1 : 0);
    for (int i = 0; i < 7; ++i) { const int t = moe_deal(i, F.bx, F.G, n4); if (t < 0) break;
        const bool down = t >= n4; const int rb = (down ? t - n4 : t) >> 2, slot = down ? i - n7 : i;
        if (slot < 3 && F.tid < 256) { const int v = rbtab[rb], e = v >> 8, j = v & 255; const int nvalid = cnttab[e] - 256 * j;
            int val = -1;
            if (F.tid < nvalid) { const int q = 256 * j + F.tid; int sh = 0;
#pragma unroll
                for (int k = 1; k < 8; ++k) sh += (pref[e * 8 + k] <= q) ? 1 : 0;
                val = F.list[((32 * sh + e) << 12) + q - pref[e * 8 + sh]]; }
            if (!down) gidx[slot * 256 + F.tid] = val >= 0 ? (val >> 1) : 0;
            else { dtab[slot * 256 + F.tid] = val; wtab[slot * 256 + F.tid] = val >= 0 ? F.wts[val] : 0.f; } } }
    __syncthreads();
    n4_out = n4; n7_out = n7;
}

__device__ __forceinline__ void final_rows(Frame& F) {
    const int gw = F.vcu * 8 + F.wave, NGW = F.G * 8;
    for (int m0 = gw; m0 < MT; m0 += 2 * NGW) {
        u32x4 xa[2][2], ya[2][2], yb[2][2];
#pragma unroll
        for (int q = 0; q < 2; ++q) { const int m = m0 + q * NGW; if (m < MT) {
            const u32x4* xr = (const u32x4*)(F.X1 + (size_t)m * DM) + F.lane; const u32x4* y0 = (const u32x4*)(F.Y + (size_t)(2 * m) * DM) + F.lane; const u32x4* y1 = (const u32x4*)(F.Y + (size_t)(2 * m + 1) * DM) + F.lane;
#pragma unroll
            for (int j = 0; j < 2; ++j) { xa[q][j] = xr[64 * j]; ya[q][j] = y0[64 * j]; yb[q][j] = y1[64 * j]; } } }
#pragma unroll
        for (int q = 0; q < 2; ++q) { const int m = m0 + q * NGW; if (m >= MT) continue;
            const float* gt = F.mod + (m >> 12) * NMOD + 5 * DM; float s = 0.f; f32x4 v[2][2];
#pragma unroll
            for (int j = 0; j < 2; ++j)
#pragma unroll
                for (int hh = 0; hh < 2; ++hh) { const int col = 8 * (F.lane + 64 * j) + 4 * hh; const f32x4 g = *(const f32x4*)(gt + col);
                    const unsigned x0 = hh ? xa[q][j].z : xa[q][j].x, x1 = hh ? xa[q][j].w : xa[q][j].y, a0 = hh ? ya[q][j].z : ya[q][j].x, a1 = hh ? ya[q][j].w : ya[q][j].y, b0 = hh ? yb[q][j].z : yb[q][j].x, b1 = hh ? yb[q][j].w : yb[q][j].y;
                    const f32x4 xs = {bflo(x0), bfhi(x0), bflo(x1), bfhi(x1)}, ys = {bflo(a0) + bflo(b0), bfhi(a0) + bfhi(b0), bflo(a1) + bflo(b1), bfhi(a1) + bfhi(b1)};
                    v[j][hh] = xs + g * ys; s += (v[j][hh].x * v[j][hh].x + v[j][hh].y * v[j][hh].y) + (v[j][hh].z * v[j][hh].z + v[j][hh].w * v[j][hh].w); }
            const float rinv = 1.0f / sqrtf(wave_sum(s) * (1.0f / DM) + RMS_EPS);
#pragma unroll
            for (int j = 0; j < 2; ++j)
#pragma unroll
                for (int hh = 0; hh < 2; ++hh) { const int col = 8 * (F.lane + 64 * j) + 4 * hh; *(f32x4*)(F.out + (size_t)m * DM + col) = v[j][hh] * rinv * *(const f32x4*)(F.g_final + col); }
        }
    }
}

struct Args { const void* in[20]; float* out; unsigned char* ws; int ph_lo, ph_hi, li, pad; };
__global__ void __launch_bounds__(512, 2) fwd_kernel(Args args) {
    extern __shared__ __attribute__((aligned(16))) unsigned char lds[];
    Frame F;
    F.lds = (LAS unsigned char*)lds;
    F.tid = threadIdx.x; F.lane = F.tid & 63; F.wave = __builtin_amdgcn_readfirstlane(F.tid >> 6);
    F.G = gridDim.x; F.bx = blockIdx.x; F.vcu = (F.G % 8 == 0) ? (F.bx % 8) * (F.G / 8) + F.bx / 8 : F.bx;
    unsigned char* ws = args.ws;
    F.ctl = (unsigned*)(ws + WS_CTL);
    F.x = (const float*)args.in[0]; F.c = (const float*)args.in[1]; F.positions = (const int*)args.in[2]; F.w_ada = (const float*)args.in[3]; F.b_ada = (const float*)args.in[4];
    F.g_mix = (const float*)args.in[5]; F.w_in = (const float*)args.in[6]; F.sink = (const float*)args.in[7]; F.w_a = (const float*)args.in[8]; F.w_b = (const float*)args.in[9];
    F.w_out = (const float*)args.in[10]; F.g_ffn = (const float*)args.in[11]; F.w_group = (const float*)args.in[12]; F.b_group = (const float*)args.in[13]; F.w_route = (const float*)args.in[14];
    F.b_route = (const float*)args.in[15]; F.w_gate = (const float*)args.in[16]; F.w_up = (const float*)args.in[17]; F.w_down = (const float*)args.in[18]; F.g_final = (const float*)args.in[19];
    F.out = args.out;
    F.mod = (float*)(ws + WS_MOD); F.rcos = (float*)(ws + WS_RCOS); F.rsin = (float*)(ws + WS_RSIN); F.wts = (float*)(ws + WS_WTS); F.list = (int*)(ws + WS_LIST);
    F.WrT = (bf16*)(ws + WS_WRT); F.WaT = (bf16*)(ws + WS_WAT); F.WbT = (bf16*)(ws + WS_WBT); F.WoT = (bf16*)(ws + WS_WOT); F.WinT = (bf16*)(ws + WS_WINT); F.GUT = (bf16*)(ws + WS_GUT); F.DT = (bf16*)(ws + WS_DT);
    F.H = (bf16*)(ws + WS_H); F.OA = (bf16*)(ws + WS_OA); F.OB = (bf16*)(ws + WS_OB); F.QA = (bf16*)(ws + WS_QA); F.KA = (bf16*)(ws + WS_KA); F.VAT = (bf16*)(ws + WS_VAT);
    F.QB = (bf16*)(ws + WS_QB); F.KB = (bf16*)(ws + WS_KB); F.VBT = (bf16*)(ws + WS_VBT); F.MERGED = (bf16*)(ws + WS_MERGED); F.ACT = (bf16*)(ws + WS_ACT); F.Y = (bf16*)(ws + WS_Y);
    F.X1 = (bf16*)(ws + WS_X1);
    F.SGA = (unsigned char*)args.out; F.SGB = (unsigned char*)args.out + (size_t)MT * DM;
    for (int u = F.tid; u < (LDS_BYTES - MISC_OFF) / 4; u += 512) ((LAS unsigned*)(F.lds + MISC_OFF))[u] = 0u;
    __syncthreads();
    F.bg_done = 0;
#if MK_PER_PHASE
#define GRID_BAR() do {} while (0)
#else
    XcdBarrier bar = xcd_barrier_post(F.ctl + CW_BAR + args.li * XCD_BAR_WORDS, (volatile LAS unsigned*)(F.lds + MISC_OFF));
#define GRID_BAR() xcd_barrier(bar)
#endif
    volatile LAS unsigned* relw = (volatile LAS unsigned*)(F.lds + MISC_OFF + 64);
    const int lo = args.ph_lo, hi = args.ph_hi;
#define IN(k) (lo <= (k) && (k) < hi)
#if MK_PER_PHASE
#define SEAM(k) do { if ((k) == 5) { while (bg_step(F)) {} } } while (0)
#else
#define SEAM(k) do { if ((k) == 5) { while (bg_step(F)) {} }         \
        if (IN(k) && IN((k) + 1)) { if ((k) < 5) xcd_barrier_bg(bar, F, relw, (unsigned)(k) + 1u); else GRID_BAR(); } } while (0)
#endif

#define PHASE_BEGIN(k) if (IN(k)) {
#define PHASE_END(k) SEAM(k); }
    PHASE_BEGIN(0) p0_prologue(F); norm_rows(F, F.x, F.g_mix, 0, DM, F.H); PHASE_END(0)
    PHASE_BEGIN(1)
        SchedTiles S{(const char*)F.H, (const char*)F.WinT, 2048, 2048, 16, 64, 20, F.G, F.bx};
        EpiIn E{F.QA, F.KA, F.VAT, F.QB, F.KB, F.VBT, F.SGA, F.SGB, F.rcos, F.rsin};
        pg8::gemm_run<EpiIn, SchedTiles, false, true>(F.lds, nullptr, S, E);
    PHASE_END(1)
    PHASE_BEGIN(2) attn_phase(F); PHASE_END(2)
    PHASE_BEGIN(3)
        SchedBranch S{(const char*)F.OA, (const char*)F.OB, (const char*)F.WaT, (const char*)F.WbT, F.G, F.bx};
        EpiMerge E{F.SGA, F.SGB, F.MERGED};
        pg8::gemm_run<EpiMerge, SchedBranch, false, false>(F.lds, nullptr, S, E);
    PHASE_END(3)
    PHASE_BEGIN(4)
        SchedTiles S{(const char*)F.MERGED, (const char*)F.WoT, 2048, 2048, 16, 64, 4, F.G, F.bx};
        EpiX1 E{F.x, F.mod, F.X1};
        pg8::gemm_run<EpiX1, SchedTiles, false, false>(F.lds, nullptr, S, E);
    PHASE_END(4)
    PHASE_BEGIN(5) norm_route_phase(F, (MK_REPEAT_MASK != 0 && args.li == 1) ? 1 : 0); PHASE_END(5)
    PHASE_BEGIN(6)
        int n4, n7; moe_setup(F, n4, n7);
        SchedMoe S{(const char*)F.H, (const char*)F.ACT, (const char*)F.GUT, (const char*)F.DT, (const LAS int*)(F.lds + TAB_RB), F.ctl + CW_ACT, n4, n7, F.G, F.bx};
        EpiMoe E{F.ACT, F.Y, (const LAS int*)(F.lds + TAB_D), (const LAS float*)(F.lds + TAB_W), F.ctl + CW_ACT};
        pg8::gemm_run<EpiMoe, SchedMoe, true, true>(F.lds, (const LAS int*)(F.lds + TAB_GIDX), S, E);
    PHASE_END(6)
    PHASE_BEGIN(7) final_rows(F); PHASE_END(7)
#undef IN
#undef SEAM
}

extern "C" void kernel_launch(void* const* d_in, const int* in_sizes, int n_in, void* d_out, int out_size, void* d_ws, size_t ws_size, hipStream_t stream) {
    static int grid = 0;
    if (grid == 0) {
        if (n_in != 20 || out_size != MT * DM || ws_size < WS_END) { fprintf(stderr, "kernel_launch: unexpected shapes (n_in %d out %d ws %zu)\n", n_in, out_size, ws_size); grid = -1; return; }
        int dev = 0, cus = 0, per_cu = 0;
        if (hipGetDevice(&dev) != hipSuccess || hipDeviceGetAttribute(&cus, hipDeviceAttributeMultiprocessorCount, dev) != hipSuccess) { grid = -1; return; }
        if (hipFuncSetAttribute((const void*)fwd_kernel, hipFuncAttributeMaxDynamicSharedMemorySize, LDS_BYTES) != hipSuccess) { fprintf(stderr, "kernel_launch: hipFuncSetAttribute failed\n"); grid = -1; return; }
        if (hipOccupancyMaxActiveBlocksPerMultiprocessor(&per_cu, (const void*)fwd_kernel, 512, LDS_BYTES) != hipSuccess || per_cu < 1) { fprintf(stderr, "kernel_launch: occupancy query says %d\n", per_cu); }
        (void)hipGetLastError();
        grid = cus;
    }
    if (grid < 0) return;
    (void)hipMemsetAsync((char*)d_ws + WS_CTL, 0, CTL_ZERO_BYTES, stream);
    Args a{};
    for (int i = 0; i < 20; ++i) a.in[i] = d_in[i];
    a.out = (float*)d_out; a.ws = (unsigned char*)d_ws;
#if MK_PER_PHASE
    for (int p = 0; p < NPHASE; ++p) { a.ph_lo = p; a.ph_hi = p + 1; hipLaunchKernelGGL(fwd_kernel, dim3(grid), dim3(512), LDS_BYTES, stream, a); }
#else
    if (MK_REPEAT_MASK == 0) { a.ph_lo = 0; a.ph_hi = NPHASE; a.li = 0; hipLaunchKernelGGL(fwd_kernel, dim3(grid), dim3(512), LDS_BYTES, stream, a); }
    else {
        int k0 = 0, k1 = 0; for (int k = 0; k < NPHASE; ++k) if ((MK_REPEAT_MASK >> k) & 1) { k0 = k; break; }
        for (int k = 0; k < NPHASE; ++k) if ((MK_REPEAT_MASK >> k) & 1) k1 = k;
        a.ph_lo = 0; a.ph_hi = k1 + 1; a.li = 0; hipLaunchKernelGGL(fwd_kernel, dim3(grid), dim3(512), LDS_BYTES, stream, a);
        a.ph_lo = k0; a.ph_hi = k1 + 1; a.li = 1; hipLaunchKernelGGL(fwd_kernel, dim3(grid), dim3(512), LDS_BYTES, stream, a);
        if (k1 + 1 < NPHASE) { a.ph_lo = k1 + 1; a.ph_hi = NPHASE; a.li = 2; hipLaunchKernelGGL(fwd_kernel, dim3(grid), dim3(512), LDS_BYTES, stream, a); }
    }
#endif
}
```

```cpp
#include <hip/hip_runtime.h>
#include <cstdio>
#include <cstdint>

#ifndef MK_PER_PHASE
#define MK_PER_PHASE 0
#endif

#ifndef MK_REPEAT_MASK
#define MK_REPEAT_MASK 0
#endif
#define LAS __attribute__((address_space(3)))
#define GAS __attribute__((address_space(1)))
typedef unsigned short bf16;
typedef short bf16x8 __attribute__((ext_vector_type(8)));
typedef short s16x4 __attribute__((ext_vector_type(4)));
typedef float f32x4 __attribute__((ext_vector_type(4)));
typedef float f32x2 __attribute__((ext_vector_type(2)));
typedef float f32x16 __attribute__((ext_vector_type(16)));
typedef unsigned u32x4 __attribute__((ext_vector_type(4)));
typedef unsigned u32x2 __attribute__((ext_vector_type(2)));
typedef __bf16 bf16x2_t __attribute__((ext_vector_type(2)));

constexpr int NBATCH = 4, SEQ = 4096, DM = 1024, MT = NBATCH * SEQ;
constexpr int NIN = 5120, NMOD = 6 * DM;
constexpr int NEXP = 32, DEXP = 512;
constexpr float RMS_EPS = 1e-6f;
constexpr float LOG2E = 1.4426950408889634f;
constexpr float QSCALE = 0.125f * LOG2E;
constexpr int NPHASE = 8;

constexpr size_t MiB = 1u << 20;
constexpr size_t WS_CTL = 0, CTL_ZERO_BYTES = 1 * MiB;
constexpr size_t WS_MOD = 1 * MiB;
constexpr size_t WS_RCOS = 2 * MiB, WS_RSIN = 4 * MiB;
constexpr size_t WS_LIST = 288 * MiB;
constexpr size_t WS_WTS = 8 * MiB;
constexpr size_t WS_WRT = 8 * MiB + 512 * 1024;
constexpr size_t WS_WAT = 9 * MiB;
constexpr size_t WS_WBT = 9 * MiB + 512 * 1024;
constexpr size_t WS_WOT = 10 * MiB + 512 * 1024;
constexpr size_t WS_WINT = 13 * MiB;
constexpr size_t WS_GUT = 24 * MiB;
constexpr size_t WS_DT = 88 * MiB;
constexpr size_t WS_H = 120 * MiB;
constexpr size_t WS_OA = 120 * MiB;
constexpr size_t WS_OB = 128 * MiB;
constexpr size_t WS_QA = 152 * MiB, WS_KA = 176 * MiB, WS_VAT = 200 * MiB, WS_QB = 224 * MiB, WS_KB = 240 * MiB, WS_VBT = 244 * MiB;
constexpr size_t WS_MERGED = 152 * MiB;
constexpr size_t WS_ACT = 152 * MiB;
constexpr size_t WS_Y = 192 * MiB;
constexpr size_t WS_X1 = 256 * MiB;
constexpr size_t WS_END = 296 * MiB;
constexpr int CW_BAR = 4096;
constexpr int CW_CNT = 16384;
constexpr int CW_MODCNT = 49152;
constexpr int CW_ACT = 32768;

constexpr int RING_BYTES = 131072;
constexpr int TAB_OFF = RING_BYTES;
constexpr int TAB_GIDX = TAB_OFF, TAB_D = TAB_OFF + 3072, TAB_W = TAB_OFF + 6144, TAB_RB = TAB_OFF + 9216, TAB_CNT = TAB_RB + 768, TAB_NB = TAB_CNT + 128, TAB_PREF = TAB_NB + 16;
constexpr int MISC_OFF = TAB_OFF + 12288;
constexpr int LDS_BYTES = 147456;

#define LDS_WAIT() asm volatile("s_waitcnt lgkmcnt(0)" ::: "memory")
#define VM_WAIT() asm volatile("s_waitcnt vmcnt(0)" ::: "memory")
#define RLX_AGENT __ATOMIC_RELAXED, __HIP_MEMORY_SCOPE_AGENT
__device__ __forceinline__ unsigned cvtpk(float lo, float hi) { f32x2 v = {lo, hi}; bf16x2_t b = __builtin_convertvector(v, bf16x2_t); return __builtin_bit_cast(unsigned, b); }
__device__ __forceinline__ float bflo(unsigned u) { return __builtin_bit_cast(float, u << 16); }
__device__ __forceinline__ float bfhi(unsigned u) { return __builtin_bit_cast(float, u & 0xffff0000u); }
__device__ __forceinline__ float fexp2(float x) { return __builtin_amdgcn_exp2f(x); }
__device__ __forceinline__ float frcp(float x) { return __builtin_amdgcn_rcpf(x); }
__device__ __forceinline__ float fsigmoid(float x) { return frcp(1.0f + fexp2(-x * LOG2E)); }
__device__ __forceinline__ void st16_sc1(void* p, u32x4 v) { asm volatile("global_store_dwordx4 %0, %1, off sc1\n\ts_nop 1" :: "v"(p), "v"(v) : "memory"); }
__device__ __forceinline__ float wave_sum(float v) {
#pragma unroll
    for (int o = 1; o < 64; o <<= 1) v += __shfl_xor(v, o);
    return v;
}

namespace pg8 {
constexpr int BM = 256, BK = 64, HALF = 128, HTB = HALF * BK * 2, STAGE_BYTES = 8 * HTB;
__host__ __device__ __forceinline__ int lds_byte(int r, int c) { const int st = (r >> 4) * 2 + (c >> 5), rr = r & 15, cc = c & 31, ob = rr * 64 + cc * 2; return st * 1024 + (ob ^ (((ob >> 9) & 1) << 5)); }
__host__ __device__ __forceinline__ void stage_rc(int b, int& R, int& C) { const int st = b / 1024, sb = b % 1024, swz = sb ^ (((sb >> 9) & 1) << 5); R = (st >> 1) * 16 + swz / 64; C = (st & 1) * 32 + (swz % 64) / 2; }
__host__ __device__ __forceinline__ int perm32(int rho) { const int n = rho >> 4, i = rho & 15; return 8 * (i >> 2) + 4 * n + (i & 3); }

struct GU {
    const char* A;
    const char* B;
    int lda, ldb;
    int nt;
    int zero;
    int gslot;
    int pm, pn, aux;
    int eslot;
};

__device__ __forceinline__ bool static_tile(int i, int G, int c, int nM, int nN, int& pm, int& pn) {
    const int nwg = nM * nN; const long L = (long)i * G + c; if (L >= nwg) return false;
    int wgid = (int)L; { const int q = nwg / 8, r = nwg % 8, xcd = wgid % 8, off = wgid / 8; wgid = (xcd < r ? xcd * (q + 1) : r * (q + 1) + (xcd - r) * q) + off; }
    const int nig = 8 * nN, gid = wgid / nig, fm = gid * 8, gsz = (nM - fm) < 8 ? (nM - fm) : 8;
    pm = fm + ((wgid % nig) % gsz); pn = (wgid % nig) / gsz; return true;
}

template <class Epi, class Sched, bool GATHER, bool ALIGN_EPI>
__device__ __forceinline__ void gemm_run(LAS unsigned char* lds, const LAS int* gidx, const Sched& S, const Epi& E) {
    const int tid = threadIdx.x, wid = __builtin_amdgcn_readfirstlane(tid >> 6), lane = tid & 63, wr = wid >> 2, wc = wid & 3, fr = lane & 15, fq = lane >> 4;
    int R[2], C2[2], Rb[2];
#pragma unroll
    for (int i = 0; i < 2; ++i) { int C; stage_rc(tid * 16 + i * 8192, R[i], C); C2[i] = C * 2; Rb[i] = Epi::PERM ? ((R[i] & ~31) + perm32(R[i] & 31)) : R[i]; }
    const unsigned ldsw = (unsigned)wid * 1024u;
    const int aoff = lds_byte(wr * 64 + fr, fq * 8), boff = lds_byte(wc * 32 + fr, fq * 8);
#define PG8_SA(b, h) (((b) * 2 + (h)) * HTB)
#define PG8_SB(b, h) ((4 + (b) * 2 + (h)) * HTB)
#define PG8_STAGE(bufoff, gbase, voff) do { _Pragma("unroll") for (int _i = 0; _i < 2; ++_i) \
        __builtin_amdgcn_global_load_lds((const unsigned*)((const char*)(gbase) + (voff)[_i]), (LAS unsigned*)(lds + (bufoff) + ldsw + _i * 8192), 16, 0, 0); } while (0)
#define PG8_LDA(dst, b, h) do { _Pragma("unroll") for (int m = 0; m < 4; ++m) _Pragma("unroll") for (int k = 0; k < 2; ++k) dst[m][k] = *(const LAS bf16x8*)(lds + PG8_SA(b, h) + aoff + m * 2048 + k * 1024); } while (0)
#define PG8_LDB(dst, b, h) do { _Pragma("unroll") for (int n = 0; n < 2; ++n) _Pragma("unroll") for (int k = 0; k < 2; ++k) dst[n][k] = *(const LAS bf16x8*)(lds + PG8_SB(b, h) + boff + n * 2048 + k * 1024); } while (0)
#define PG8_MMA(ai, bj, At, Bt) do { __builtin_amdgcn_s_setprio(1); _Pragma("unroll") for (int m = 0; m < 4; ++m) _Pragma("unroll") for (int n = 0; n < 2; ++n) _Pragma("unroll") for (int k = 0; k < 2; ++k) \
        acc[ai][bj][m][n] = __builtin_amdgcn_mfma_f32_16x16x32_bf16(Bt[n][k], At[m][k], acc[ai][bj][m][n], 0, 0, 0); __builtin_amdgcn_s_setprio(0); } while (0)
#define PG8_WAIT_V(n) asm volatile("s_waitcnt vmcnt(" #n ")" ::: "memory")
#define PG8_WAIT_L(n) asm volatile("s_waitcnt lgkmcnt(" #n ")" ::: "memory")
#define PG8_BAR __builtin_amdgcn_s_barrier()
#define PG8_SCHED __builtin_amdgcn_sched_barrier(0)
#define PG8_SETV(u) do { _Pragma("unroll") for (int _i = 0; _i < 2; ++_i) { int r0, r1; \
        if (GATHER && (u).gslot >= 0) { r0 = gidx[(u).gslot * 256 + R[_i]]; r1 = gidx[(u).gslot * 256 + 128 + R[_i]]; } else { r0 = R[_i]; r1 = R[_i] + 128; } \
        vA[0][_i] = (unsigned)(r0 * (u).lda + C2[_i]); vA[1][_i] = (unsigned)(r1 * (u).lda + C2[_i]); vB[_i] = (unsigned)(Rb[_i] * (u).ldb + C2[_i]); } hB = (unsigned)(128 * (u).ldb); } while (0)
    GU cur, nxt; int ui = 0; int pend = -1;
    if (!S.next(0, cur)) return;
    f32x4 acc[2][2][4][2];
#pragma unroll
    for (int a = 0; a < 2; ++a)
#pragma unroll
        for (int b = 0; b < 2; ++b)
#pragma unroll
            for (int m = 0; m < 4; ++m)
#pragma unroll
                for (int n = 0; n < 2; ++n) acc[a][b][m][n] = (f32x4){0.f, 0.f, 0.f, 0.f};
    bf16x8 At[4][2], B0[2][2], B1[2][2];
    unsigned vA[2][2], vB[2], hB;
    S.a_ready(cur);
    PG8_SETV(cur);
    const char* sA = cur.A; const char* sB = cur.B;
    PG8_STAGE(PG8_SB(0, 0), sB, vB); PG8_STAGE(PG8_SB(0, 1), sB + hB, vB); PG8_STAGE(PG8_SA(0, 0), sA, vA[0]); PG8_STAGE(PG8_SA(0, 1), sA, vA[1]);
    if (wr == 1) PG8_BAR;
    PG8_WAIT_V(2); PG8_BAR;
    PG8_STAGE(PG8_SB(1, 0), sB + 128, vB); PG8_STAGE(PG8_SA(1, 0), sA + 128, vA[0]); PG8_STAGE(PG8_SB(1, 1), sB + hB + 128, vB);
    PG8_WAIT_V(6); PG8_BAR;
    sA += 256; sB += 256;
    for (;;) {
        bool has_next = false;
        const int nt = cur.nt;
        for (int t = 0; t < nt; t += 2) {
            const bool last = (t == nt - 2);
            PG8_LDB(B0, 0, 0); PG8_LDB(B1, 0, 1); PG8_SCHED; PG8_LDA(At, 0, 0); PG8_STAGE(PG8_SA(1, 1), sA - 128, vA[1]);
            PG8_WAIT_V(8); PG8_WAIT_L(0); PG8_BAR; PG8_MMA(0, 0, At, B0); PG8_MMA(0, 1, At, B1); PG8_BAR; PG8_SCHED;
            if (last) {
                has_next = S.next(ui + 1, nxt);
                if (has_next) { S.a_ready(nxt); PG8_SETV(nxt); sA = nxt.A; sB = nxt.B; } else { sA = cur.A; sB = cur.B; }
            }
            PG8_LDA(At, 0, 1); PG8_STAGE(PG8_SB(0, 0), sB, vB); PG8_STAGE(PG8_SB(0, 1), sB + hB, vB); PG8_STAGE(PG8_SA(0, 0), sA, vA[0]);
            PG8_WAIT_V(8);
            if constexpr (Epi::DEFER_PUBLISH) { if (pend >= 0) { E.publish(pend, lane); pend = -1; } }
            PG8_WAIT_L(0); PG8_BAR; PG8_MMA(1, 0, At, B0); PG8_MMA(1, 1, At, B1); PG8_BAR; PG8_SCHED;
            PG8_LDB(B0, 1, 0); PG8_LDB(B1, 1, 1); PG8_SCHED; PG8_LDA(At, 1, 0); PG8_STAGE(PG8_SA(0, 1), sA, vA[1]);
            PG8_WAIT_V(8); PG8_WAIT_L(0); PG8_BAR; PG8_MMA(0, 0, At, B0); PG8_MMA(0, 1, At, B1); PG8_BAR; PG8_SCHED;
            PG8_LDA(At, 1, 1); PG8_STAGE(PG8_SB(1, 0), sB + 128, vB); PG8_STAGE(PG8_SB(1, 1), sB + hB + 128, vB); PG8_STAGE(PG8_SA(1, 0), sA + 128, vA[0]);
            PG8_WAIT_V(8); PG8_WAIT_L(0); PG8_BAR; PG8_MMA(1, 0, At, B0); PG8_MMA(1, 1, At, B1); PG8_BAR; PG8_SCHED;
            sA += 256; sB += 256;
        }
        if constexpr (ALIGN_EPI) { if (wr == 0) PG8_BAR; }
        if constexpr (!Epi::AFTER_DRAIN) { E(acc, cur, wr, wc, fr, fq); }
        if constexpr (Epi::DEFER_PUBLISH) { if (E.wants_publish(cur)) pend = cur.pm; }
        if (!has_next) break;
        if (nxt.zero) {
#pragma unroll
            for (int a = 0; a < 2; ++a)
#pragma unroll
                for (int b = 0; b < 2; ++b)
#pragma unroll
                    for (int m = 0; m < 4; ++m)
#pragma unroll
                        for (int n = 0; n < 2; ++n) acc[a][b][m][n] = (f32x4){0.f, 0.f, 0.f, 0.f};
        }
        cur = nxt; ++ui;
        if constexpr (ALIGN_EPI) { if (wr == 1) PG8_BAR; }
    }
    PG8_WAIT_V(0);
    if constexpr (Epi::DEFER_PUBLISH) { if (pend >= 0) { E.publish(pend, lane); pend = -1; } }
    if constexpr (!ALIGN_EPI) { if (wr == 0) PG8_BAR; }
    PG8_BAR;
    if constexpr (Epi::AFTER_DRAIN) { E.fused(acc, cur, wr, wc, fr, fq, lds, wid, lane); }
#undef PG8_SA
#undef PG8_SB
#undef PG8_STAGE
#undef PG8_LDA
#undef PG8_LDB
#undef PG8_MMA
#undef PG8_WAIT_V
#undef PG8_WAIT_L
#undef PG8_BAR
#undef PG8_SCHED
#undef PG8_SETV
}
}

#define XB_TMO      128
#define XB_XCNT(j)  (256  + 64 * (j))
#define XB_XSUB(j)  (1280 + 64 * (j))
#define XB_XGEN(j)  (2304 + 64 * (j))
#define XB_TOP      3328
#define XB_TOPGEN   3392
#define XCD_BAR_WORDS 3456
#define XB_SPIN_CAP (1u << 18)
__device__ __forceinline__ unsigned xb_ld(unsigned* p)              { return __hip_atomic_load(p, __ATOMIC_RELAXED, __HIP_MEMORY_SCOPE_AGENT); }
__device__ __forceinline__ unsigned xb_add(unsigned* p, unsigned v) { return __hip_atomic_fetch_add(p, v, __ATOMIC_RELAXED, __HIP_MEMORY_SCOPE_AGENT); }
__device__ __forceinline__ unsigned xb_xcc_id() { return (unsigned)__builtin_amdgcn_s_getreg((3 << 11) | 20) & 0xFu; }
#define XB_SPIN(cond, bar) do { unsigned _sp = 0; while (cond) { __builtin_amdgcn_s_sleep(1); \
    if ((++_sp & 255u) == 0u) { if (xb_ld(&(bar)[XB_TMO])) break; if (_sp > XB_SPIN_CAP) { atomicAdd(&(bar)[XB_TMO], 1u); break; } } } } while (0)
struct XcdBarrier { unsigned* bar; unsigned x; volatile LAS unsigned* st; };
__device__ __forceinline__ XcdBarrier xcd_barrier_post(unsigned* bar, volatile LAS unsigned* st) {
    XcdBarrier b; b.bar = bar; b.x = xb_xcc_id(); b.st = st;
    if (threadIdx.x == 0) (void)xb_add(&bar[XB_XCNT(b.x)], 1u);
    return b;
}
__device__ __forceinline__ void xcd_barrier_complete(unsigned* bar, unsigned x, unsigned& nloc, unsigned& nx) {
    const unsigned G = gridDim.x * gridDim.y * gridDim.z;
    unsigned sum, cnt, mine, sp = 0u;
    for (;;) {
        sum = 0u; cnt = 0u; mine = 0u;
#pragma unroll
        for (unsigned j = 0; j < 16; ++j) { const unsigned c = xb_ld(&bar[XB_XCNT(j)]); sum += c; cnt += (c > 0u) ? 1u : 0u; mine = (j == x) ? c : mine; }
        if (sum == G) break;
        __builtin_amdgcn_s_sleep(1);
        if ((++sp & 255u) == 0u) { if (xb_ld(&bar[XB_TMO])) break; if (sp > XB_SPIN_CAP) { atomicAdd(&bar[XB_TMO], 1u); break; } }
    }
    nloc = mine > 0u ? mine : 1u; nx = cnt > 0u ? cnt : 1u;
}
__device__ __forceinline__ void xcd_barrier(const XcdBarrier& b) {
    asm volatile("s_waitcnt vmcnt(0)" ::: "memory");
    __syncthreads();
    if (threadIdx.x == 0) {
        unsigned* bar = b.bar;
        __builtin_amdgcn_s_waitcnt(0);
        unsigned nloc = b.st[0], nx = b.st[1];
        if (nloc == 0u) { xcd_barrier_complete(bar, b.x, nloc, nx); b.st[0] = nloc; b.st[1] = nx; }
        const unsigned old = xb_add(&bar[XB_XSUB(b.x)], 1u);
        const unsigned gen = old / nloc;
        if (old + 1u == (gen + 1u) * nloc) {
            __builtin_amdgcn_fence(__ATOMIC_RELEASE, "agent");
            asm volatile("s_waitcnt vmcnt(0)" ::: "memory");
            const unsigned og = xb_add(&bar[XB_TOP], 1u);
            const unsigned tg = og / nx;
            if (og + 1u == (tg + 1u) * nx) xb_add(&bar[XB_TOPGEN], 1u);
            else XB_SPIN(xb_ld(&bar[XB_TOPGEN]) == tg, bar);
            __builtin_amdgcn_fence(__ATOMIC_ACQUIRE, "agent");
            xb_add(&bar[XB_XGEN(b.x)], 1u);
            asm volatile("s_waitcnt vmcnt(0)" ::: "memory");
        } else {
            XB_SPIN(xb_ld(&bar[XB_XGEN(b.x)]) == gen, bar);
            __builtin_amdgcn_fence(__ATOMIC_ACQUIRE, "agent");
            asm volatile("s_waitcnt vmcnt(0)" ::: "memory");
        }
    }
    __syncthreads();
}

struct Frame {
    LAS unsigned char* lds;
    unsigned* ctl;
    int tid, lane, wave, vcu, G, bx;
    int bg_done;
    const float *x, *c, *w_ada, *b_ada, *g_mix, *w_in, *sink, *w_a, *w_b, *w_out, *g_ffn, *w_group, *b_group, *w_route, *b_route, *w_gate, *w_up, *w_down, *g_final;
    const int* positions;
    float* out;
    float *mod, *rcos, *rsin, *wts;
    int* list;
    bf16 *WrT, *WaT, *WbT, *WoT, *WinT, *GUT, *DT, *H, *OA, *OB, *QA, *KA, *VAT, *QB, *KB, *VBT, *MERGED, *ACT, *Y, *X1;
    unsigned char *SGA, *SGB;
};

__device__ const double INVF[32] = {1, 0.74989420933245587, 0.56234132519034907, 0.42169650342858223, 0.31622776601683794, 0.23713737056616552, 0.17782794100389229, 0.1333521432163324,
    0.10000000000000001, 0.074989420933245579, 0.056234132519034911, 0.042169650342858224, 0.031622776601683791, 0.023713737056616554, 0.017782794100389229, 0.013335214321633241,
    0.01, 0.0074989420933245579, 0.005623413251903491, 0.0042169650342858229, 0.0031622776601683794, 0.0023713737056616554, 0.0017782794100389228, 0.0013335214321633241,
    0.001, 0.00074989420933245586, 0.0005623413251903491, 0.00042169650342858224, 0.00031622776601683794, 0.00023713737056616554, 0.00017782794100389227, 0.0001333521432163324};

template <int KIND> __device__ __forceinline__ int rowmap(int n) {
    if (KIND == 0) return n;
    if (KIND == 1) { const bool rp = (n < 1536) || (n >= 2304 && n < 2944); if (!rp) return n; const int j = n & 63; return (n & ~63) + (((j & 31) >> 2) << 3) + ((j >> 5) << 2) + (j & 3); }
    if (KIND == 2) return ((n >> 7) << 8) + (n & 127);
    return ((n >> 7) << 8) + 128 + (n & 127);
}
template <int KIND> __device__ __forceinline__ void transpose_item(const float* W, int K, int N, bf16* WT, int item, int lane) {
    const int nblk = N >> 5, kb = item / nblk, nb = item - kb * nblk, k0 = 64 * kb + 8 * (lane >> 3), n0 = 32 * nb + 4 * (lane & 7);
    f32x4 v[8];
#pragma unroll
    for (int j = 0; j < 8; ++j) v[j] = __builtin_nontemporal_load((const f32x4*)(W + (size_t)(k0 + j) * N + n0));
#pragma unroll
    for (int i = 0; i < 4; ++i) { u32x4 o; o.x = cvtpk(v[0][i], v[1][i]); o.y = cvtpk(v[2][i], v[3][i]); o.z = cvtpk(v[4][i], v[5][i]); o.w = cvtpk(v[6][i], v[7][i]);
        __builtin_nontemporal_store(o, (u32x4*)(WT + (size_t)rowmap<KIND>(n0 + i) * K + k0)); }
}


constexpr int EXP_ITEMS = NEXP * 3 * 256;
#ifndef BGW
#define BGW 3
#endif
#ifndef EXP_DEFER
#define EXP_DEFER 3072
#endif
struct FillRegs { f32x4 a, b, c, d, e, f, g, h; };
__device__ __forceinline__ void expert_item(const float* wg, const float* wu, const float* wd, bf16* gut, bf16* dt, int r, int lane) {
    const int e = r / 768, q = r - e * 768, kind = q >> 8, item = q & 255;
    const float* W = (kind == 0 ? wg : (kind == 1 ? wu : wd)) + (size_t)e * DM * DEXP;
    const int N = kind == 2 ? DM : DEXP, K = kind == 2 ? DEXP : DM, nblk = N >> 5, kb = item / nblk, nb = item - kb * nblk, k0 = 64 * kb + 8 * (lane >> 3), n0 = 32 * nb + 4 * (lane & 7);
    const f32x4* p = (const f32x4*)(W + (size_t)k0 * N + n0); const size_t st = (size_t)(N >> 2);
    FillRegs v;
    v.a = __builtin_nontemporal_load(p); v.b = __builtin_nontemporal_load(p + st); v.c = __builtin_nontemporal_load(p + 2 * st); v.d = __builtin_nontemporal_load(p + 3 * st);
    v.e = __builtin_nontemporal_load(p + 4 * st); v.f = __builtin_nontemporal_load(p + 5 * st); v.g = __builtin_nontemporal_load(p + 6 * st); v.h = __builtin_nontemporal_load(p + 7 * st);
    bf16* WT = kind == 2 ? dt + (size_t)e * 1024 * 512 : gut + (size_t)e * 1024 * 1024;
#pragma unroll
    for (int i = 0; i < 4; ++i) { u32x4 o; o.x = cvtpk(v.a[i], v.b[i]); o.y = cvtpk(v.c[i], v.d[i]); o.z = cvtpk(v.e[i], v.f[i]); o.w = cvtpk(v.g[i], v.h[i]);
        const int n = n0 + i, row = kind == 2 ? n : (((n >> 7) << 8) + 128 * kind + (n & 127));
        __builtin_nontemporal_store(o, (u32x4*)(WT + (size_t)row * K + k0)); }
}

__device__ __forceinline__ bool bg_step(Frame& F) {
    if (F.bg_done) return false;
    volatile LAS unsigned* bgk = (volatile LAS unsigned*)(F.lds + MISC_OFF + 128);
    int k = 0; if (F.lane == 0) k = (int)__hip_atomic_fetch_add((LAS unsigned*)bgk, 1u, __ATOMIC_RELAXED, __HIP_MEMORY_SCOPE_WORKGROUP);
    k = __builtin_amdgcn_readfirstlane(k);
    const int r = EXP_DEFER + F.vcu + k * F.G;
    if (r >= EXP_ITEMS) { F.bg_done = 1; return false; }
    expert_item(F.w_gate, F.w_up, F.w_down, F.GUT, F.DT, r, F.lane); return true;
}
__device__ __forceinline__ void xcd_barrier_bg(const XcdBarrier& b, Frame& F, volatile LAS unsigned* relw, unsigned epoch) {
    asm volatile("s_waitcnt vmcnt(0)" ::: "memory");
    __syncthreads();
    if (threadIdx.x < 64) {
        if (threadIdx.x == 0) {
            unsigned* bar = b.bar;
            __builtin_amdgcn_s_waitcnt(0);
            unsigned nloc = b.st[0], nx = b.st[1];
            if (nloc == 0u) { xcd_barrier_complete(bar, b.x, nloc, nx); b.st[0] = nloc; b.st[1] = nx; }
            const unsigned old = xb_add(&bar[XB_XSUB(b.x)], 1u);
            const unsigned gen = old / nloc;
            if (old + 1u == (gen + 1u) * nloc) {
                __builtin_amdgcn_fence(__ATOMIC_RELEASE, "agent");
                asm volatile("s_waitcnt vmcnt(0)" ::: "memory");
                const unsigned og = xb_add(&bar[XB_TOP], 1u);
                const unsigned tg = og / nx;
                if (og + 1u == (tg + 1u) * nx) xb_add(&bar[XB_TOPGEN], 1u);
                else XB_SPIN(xb_ld(&bar[XB_TOPGEN]) == tg, bar);
                relw[1] = epoch;
                __builtin_amdgcn_fence(__ATOMIC_ACQUIRE, "agent");
                xb_add(&bar[XB_XGEN(b.x)], 1u);
                asm volatile("s_waitcnt vmcnt(0)" ::: "memory");
            } else {
                XB_SPIN(xb_ld(&bar[XB_XGEN(b.x)]) == gen, bar);
                relw[1] = epoch;
                __builtin_amdgcn_fence(__ATOMIC_ACQUIRE, "agent");
                asm volatile("s_waitcnt vmcnt(0)" ::: "memory");
            }
            relw[0] = epoch;
        }
    } else {
        while (relw[0] != epoch) { if (F.wave > BGW || relw[1] == epoch || !bg_step(F)) __builtin_amdgcn_s_sleep(2); }
    }
    asm volatile("s_waitcnt lgkmcnt(0)" ::: "memory"); __builtin_amdgcn_s_barrier(); asm volatile("" ::: "memory");
}

__device__ __forceinline__ void p0_prologue(Frame& F) {
    {
        LAS float* cs = (LAS float*)(F.lds);
        LAS float* red = (LAS float*)(F.lds + 16384);
        for (int item = F.vcu; item < NMOD / 32; item += F.G) {
            for (int i = F.tid; i < 4096; i += 512) { const float v = F.c[i]; cs[i] = v / (1.0f + __expf(-v)); }
            __syncthreads();
            const int kq = F.tid >> 3, cq = F.tid & 7, n0 = 32 * item + 4 * cq;
            f32x4 a[4];
#pragma unroll
            for (int b = 0; b < 4; ++b) a[b] = (f32x4){0.f, 0.f, 0.f, 0.f};
#pragma unroll 4
            for (int it = 0; it < 16; ++it) { const int k = kq + 64 * it; const f32x4 w = __builtin_nontemporal_load((const f32x4*)(F.w_ada + (size_t)k * NMOD + n0));
#pragma unroll
                for (int b = 0; b < 4; ++b) a[b] += cs[b * 1024 + k] * w; }
#pragma unroll
            for (int b = 0; b < 4; ++b) *(LAS f32x4*)(red + kq * 132 + b * 32 + cq * 4) = a[b];
            __syncthreads();
            if (F.tid < 128) { float s = 0.f; for (int q = 0; q < 64; ++q) s += red[q * 132 + F.tid];
                const int b = F.tid >> 5, col = 32 * item + (F.tid & 31); __hip_atomic_store(F.mod + b * NMOD + col, s + F.b_ada[col], RLX_AGENT); }
            VM_WAIT(); __syncthreads();
            if (F.tid == 0) __hip_atomic_fetch_add(F.ctl + CW_MODCNT, 1u, RLX_AGENT);
        }
    }
    {
        const int gw = F.vcu * 8 + F.wave, NGW = F.G * 8;
        constexpr int I_IN = 16 * 160, I_A = 4 * 32, I_B = 8 * 32, I_O = 16 * 32, I_E = 256;
        constexpr int NITEMS = I_IN + I_A + I_B + I_O + EXP_DEFER;
        for (int it = gw; it < NITEMS; it += NGW) {
            int r = it;
            if (r < I_IN) { transpose_item<1>(F.w_in, DM, NIN, F.WinT, r, F.lane); continue; } r -= I_IN;
            if (r < I_A) { transpose_item<0>(F.w_a, 256, DM, F.WaT, r, F.lane); continue; } r -= I_A;
            if (r < I_B) { transpose_item<0>(F.w_b, 512, DM, F.WbT, r, F.lane); continue; } r -= I_B;
            if (r < I_O) { transpose_item<0>(F.w_out, DM, DM, F.WoT, r, F.lane); continue; } r -= I_O;
            const int e = r / (3 * I_E), q = r - e * 3 * I_E;
            if (q < I_E) transpose_item<2>(F.w_gate + (size_t)e * DM * DEXP, DM, DEXP, F.GUT + (size_t)e * 1024 * 1024, q, F.lane);
            else if (q < 2 * I_E) transpose_item<3>(F.w_up + (size_t)e * DM * DEXP, DM, DEXP, F.GUT + (size_t)e * 1024 * 1024, q - I_E, F.lane);
            else transpose_item<0>(F.w_down + (size_t)e * DEXP * DM, DEXP, DM, F.DT + (size_t)e * 1024 * 512, q - 2 * I_E, F.lane);
        }
    }
    {
        const int gt = F.vcu * 512 + F.tid, NT = F.G * 512;
        for (int idx = gt; idx < MT * 32; idx += NT) { const int tok = idx >> 5, i = idx & 31;
            double rev = (double)F.positions[tok] * INVF[i] * 0.15915494309189535; rev -= __builtin_rint(rev);
            const float fr = (float)rev; F.rcos[idx] = __builtin_amdgcn_cosf(fr); F.rsin[idx] = __builtin_amdgcn_sinf(fr); }
        for (int idx = gt; idx < 256 * 1024; idx += NT) { const int n = idx >> 10, k = idx & 1023;
            const float v = n < 4 ? F.w_group[k * 4 + n] : (n < 36 ? F.w_route[k * 32 + (n - 4)] : 0.f);
            F.WrT[idx] = (bf16)(cvtpk(v, 0.f) & 0xffffu); }
    }
    if (F.tid == 0) {
        unsigned sp = 0; while (__hip_atomic_load(F.ctl + CW_MODCNT, RLX_AGENT) < (unsigned)(NMOD / 32)) { __builtin_amdgcn_s_sleep(2); if (++sp > (1u << 22)) break; }
        __builtin_amdgcn_fence(__ATOMIC_ACQUIRE, "agent"); VM_WAIT();
    }
    __syncthreads();
}

__device__ __forceinline__ void norm_rows(Frame& F, const float* src, const float* g, int sh_off, int sc_off, bf16* dst) {
    const int gw = F.vcu * 8 + F.wave, NGW = F.G * 8;
    for (int m0 = gw; m0 < MT; m0 += 4 * NGW) {
        f32x4 v[4][4]; float s[4];
#pragma unroll
        for (int q = 0; q < 4; ++q) { const int m = m0 + q * NGW; s[q] = 0.f;
            if (m < MT) { const f32x4* xr = (const f32x4*)(src + (size_t)m * DM) + F.lane;
#pragma unroll
                for (int j = 0; j < 4; ++j) v[q][j] = xr[64 * j]; } }
#pragma unroll
        for (int q = 0; q < 4; ++q) { const int m = m0 + q * NGW; if (m >= MT) continue;
#pragma unroll
            for (int j = 0; j < 4; ++j) s[q] += (v[q][j].x * v[q][j].x + v[q][j].y * v[q][j].y) + (v[q][j].z * v[q][j].z + v[q][j].w * v[q][j].w);
            const float rinv = 1.0f / sqrtf(wave_sum(s[q]) * (1.0f / DM) + RMS_EPS);
            const float* md = F.mod + (m >> 12) * NMOD;
#pragma unroll
            for (int j = 0; j < 4; ++j) { const int col = 4 * (F.lane + 64 * j);
                const f32x4 g4 = *(const f32x4*)(g + col), sc = *(const f32x4*)(md + sc_off + col), sh = *(const f32x4*)(md + sh_off + col);
                const f32x4 h = v[q][j] * rinv * g4 * (1.0f + sc) + sh;
                u32x2 o; o.x = cvtpk(h.x, h.y); o.y = cvtpk(h.z, h.w);
                *(u32x2*)(dst + (size_t)m * DM + col) = o; } }
    }
}

using pg8::GU;
struct SchedTiles {
    const char* A; const char* B; int lda, ldb, nt, nM, nN, G, c;
    __device__ __forceinline__ bool next(int i, GU& u) const {
        int pm, pn; if (!pg8::static_tile(i, G, c, nM, nN, pm, pn)) return false;
        u.A = A + (size_t)pm * 256 * lda; u.B = B + (size_t)pn * 256 * ldb; u.lda = lda; u.ldb = ldb; u.nt = nt; u.zero = 1; u.gslot = 0; u.pm = pm; u.pn = pn; u.aux = 0; u.eslot = 0; return true;
    }
    __device__ __forceinline__ void a_ready(const GU&) const {}
};
struct SchedBranch {
    const char* OA; const char* OB; const char* WaT; const char* WbT; int G, c;
    __device__ __forceinline__ bool next(int i, GU& u) const {
        int pm, pn; if (!pg8::static_tile(i >> 1, G, c, 64, 4, pm, pn)) return false;
        if ((i & 1) == 0) { u.A = OB + (size_t)pm * 256 * 1024; u.B = WbT + (size_t)pn * 256 * 1024; u.lda = 1024; u.ldb = 1024; u.nt = 8; u.zero = 1; u.aux = 0; }
        else { u.A = OA + (size_t)pm * 256 * 512; u.B = WaT + (size_t)pn * 256 * 512; u.lda = 512; u.ldb = 512; u.nt = 4; u.zero = 0; u.aux = 1; }
        u.gslot = 0; u.pm = pm; u.pn = pn; u.eslot = 0; return true;
    }
    __device__ __forceinline__ void a_ready(const GU&) const {}
};
__device__ __forceinline__ int moe_deal(int i, int c, int G, int n4) {
    const int q = n4 / G, r = n4 - q * G, n7 = q + (c < r ? 1 : 0);
    if (i < n7) return i * G + c;
    const int k = i - n7, Lc = G - r; int j;
    if (c >= r) j = k == 0 ? (c - r) : (k == 1 ? Lc + (c - r) : 2 * Lc + (k - 2) * G + c);
    else j = 2 * Lc + k * G + c;
    return j < n4 ? n4 + j : -1;
}
struct SchedMoe {
    const char* H; const char* ACT; const char* GUT; const char* DT; const LAS int* rbtab; unsigned* cnt; int n4, n7, G, c;
    __device__ __forceinline__ bool next(int i, GU& u) const {
        const int t = moe_deal(i, c, G, n4); if (t < 0) return false;
        if (t < n4) { const int rb = t >> 2, pn = t & 3, e = rbtab[rb] >> 8;
            u.A = H; u.B = GUT + (size_t)e * (1024 * 2048) + (size_t)pn * 256 * 2048; u.lda = 2048; u.ldb = 2048; u.nt = 16; u.gslot = i; u.eslot = 0; u.pm = rb; u.pn = pn; u.aux = 0; }
        else { const int j = t - n4, rb = j >> 2, pn = j & 3, e = rbtab[rb] >> 8;
            u.A = ACT + (size_t)rb * 256 * 1024; u.B = DT + (size_t)e * (1024 * 1024) + (size_t)pn * 256 * 1024; u.lda = 1024; u.ldb = 1024; u.nt = 8; u.gslot = -1; u.eslot = i - n7; u.pm = rb; u.pn = pn; u.aux = 1; }
        u.zero = 1; return true;
    }
    __device__ __forceinline__ void a_ready(const GU& u) const {
        if (u.aux != 1) return;
        if (threadIdx.x < 64) {
            unsigned sp = 0;
            while ((unsigned)__builtin_amdgcn_readfirstlane(__hip_atomic_load(cnt + 64 * u.pm, RLX_AGENT)) < 32u) { __builtin_amdgcn_s_sleep(2); if (++sp > (1u << 20)) break; }
            __builtin_amdgcn_fence(__ATOMIC_ACQUIRE, "agent");
            asm volatile("s_waitcnt vmcnt(0)" ::: "memory");
        }
        asm volatile("" ::: "memory"); __builtin_amdgcn_s_barrier(); asm volatile("" ::: "memory");
    }
};

__device__ __forceinline__ int strided_row(int s, int sh) { return ((s & ((1 << sh) - 1)) << (12 - sh)) | (s >> sh); }

struct EpiIn {
    static constexpr bool PERM = true, AFTER_DRAIN = false, DEFER_PUBLISH = false;
    bf16 *QA, *KA, *VAT, *QB, *KB, *VBT; unsigned char *SGA, *SGB; const float *rcos, *rsin;
    __device__ __forceinline__ void operator()(f32x4 (&acc)[2][2][4][2], const GU& u, int wr, int wc, int fr, int fq) const {
        const int row0 = u.pm * 256 + wr * 64 + fr;
        if (u.pn >= 12) {
            unsigned char* base = (u.pn < 16 ? SGA : SGB) + (size_t)(u.pm * 4 + ((u.pn - 12) & 3)) * 65536 + (size_t)(((wr * 4 + wc) * 64 + fq * 16 + fr) * 16);
#pragma unroll
            for (int ai = 0; ai < 2; ++ai)
#pragma unroll
                for (int m = 0; m < 4; ++m) { u32x4 w;
#pragma unroll
                    for (int bj = 0; bj < 2; ++bj)
#pragma unroll
                        for (int n = 0; n < 2; ++n) { unsigned p = 0;
#pragma unroll
                            for (int j = 0; j < 4; ++j) p = __builtin_amdgcn_cvt_pk_u8_f32(fmaxf(fsigmoid(acc[ai][bj][m][n][j]) * 255.0f, 1.0f), j, p);
                            w[bj * 2 + n] = p; }
                    *(u32x4*)(base + (size_t)(ai * 4 + m) * 8192) = w; }
            return;
        }
#pragma unroll
        for (int bj = 0; bj < 2; ++bj) {
            const int blk = 2 * u.pn + bj;
            const int pc = 32 * (wc & 1) + 8 * fq;
            if (blk < 12 || (blk >= 18 && blk < 23)) {
                const bool isq = (blk < 6) || (blk >= 18 && blk < 22);
                const float sc = isq ? QSCALE : 1.0f;
                const int g4 = 4 * (pc >> 3);
                bf16* base; int hd, nh, sh;
                if (blk < 6) { base = QA; hd = 2 * blk + (wc >> 1); nh = 12; sh = 2 * (hd >> 2); }
                else if (blk < 12) { base = KA; hd = 2 * (blk - 6) + (wc >> 1); nh = 12; sh = 2 * (hd >> 2); }
                else if (blk < 22) { base = QB; hd = 2 * (blk - 18) + (wc >> 1); nh = 8; sh = 0; }
                else { base = KB; hd = (wc >> 1); nh = 2; sh = 0; }
                f32x4 cs[2][4], sn[2][4];
#pragma unroll
                for (int ai = 0; ai < 2; ++ai)
#pragma unroll
                    for (int m = 0; m < 4; ++m) { const size_t ro = (size_t)(row0 + ai * 128 + m * 16) * 32 + g4; cs[ai][m] = *(const f32x4*)(rcos + ro); sn[ai][m] = *(const f32x4*)(rsin + ro); }
#pragma unroll
                for (int ai = 0; ai < 2; ++ai)
#pragma unroll
                    for (int m = 0; m < 4; ++m) {
                        const int row = row0 + ai * 128 + m * 16, b = row >> 12, s = row & 4095;
                        const f32x4 x1 = acc[ai][bj][m][0], x2 = acc[ai][bj][m][1];
                        const f32x4 o1 = (x1 * cs[ai][m] - x2 * sn[ai][m]) * sc, o2 = (x2 * cs[ai][m] + x1 * sn[ai][m]) * sc;
                        u32x4 w; w.x = cvtpk(o1[0], o1[1]); w.y = cvtpk(o1[2], o1[3]); w.z = cvtpk(o2[0], o2[1]); w.w = cvtpk(o2[2], o2[3]);
                        const int srow = strided_row(s, sh), q8 = pc >> 3;
                        *(u32x4*)(base + ((size_t)(b * nh + hd) * 4096 + (srow & ~31)) * 64 + (q8 >> 1) * 512 + (32 * (q8 & 1) + (srow & 31)) * 8) = w;
                    }
            } else if (blk < 24) {
                bf16* base; int hd, nh, sh;
                if (blk < 18) { base = VAT; hd = 2 * (blk - 12) + (wc >> 1); nh = 12; sh = 2 * (hd >> 2); }
                else { base = VBT; hd = (wc >> 1); nh = 2; sh = 0; }
                if (sh == 4) {
#pragma unroll
                    for (int ai = 0; ai < 2; ++ai) {
                        const int row = row0 + ai * 128, b = row >> 12, s = row & 4095;
                        const int srow = strided_row(s, 4), kap = srow & 31;
                        bf16* p = base + ((size_t)(b * nh + hd) * 4096 + (srow & ~31)) * 64 + ((pc >> 5) * 2 + (kap >> 4)) * 512 + (32 * ((kap >> 2) & 1) + (pc & 31)) * 8 + 4 * ((kap >> 3) & 1);
#pragma unroll
                        for (int n = 0; n < 2; ++n)
#pragma unroll
                            for (int j = 0; j < 4; ++j) { u32x2 w; w.x = cvtpk(acc[ai][bj][0][n][j], acc[ai][bj][1][n][j]); w.y = cvtpk(acc[ai][bj][2][n][j], acc[ai][bj][3][n][j]);
                                *(u32x2*)(p + (4 * n + j) * 8) = w; }
                    }
                } else {
#pragma unroll
                for (int ai = 0; ai < 2; ++ai)
#pragma unroll
                    for (int m = 0; m < 4; ++m) {
                        const int row = row0 + ai * 128 + m * 16, b = row >> 12, s = row & 4095;
                        const int srow = strided_row(s, sh), kap = srow & 31;
                        bf16* p = base + ((size_t)(b * nh + hd) * 4096 + (srow & ~31)) * 64 + ((pc >> 5) * 2 + (kap >> 4)) * 512 + (32 * ((kap >> 2) & 1) + (pc & 31)) * 8 + 4 * ((kap >> 3) & 1) + (kap & 3);
                        const f32x4 v0 = acc[ai][bj][m][0], v1 = acc[ai][bj][m][1];
                        const unsigned a = cvtpk(v0[0], v0[1]), bb = cvtpk(v0[2], v0[3]), c = cvtpk(v1[0], v1[1]), d = cvtpk(v1[2], v1[3]);
                        p[0 * 8] = (bf16)(a & 0xffffu); p[1 * 8] = (bf16)(a >> 16); p[2 * 8] = (bf16)(bb & 0xffffu); p[3 * 8] = (bf16)(bb >> 16);
                        p[4 * 8] = (bf16)(c & 0xffffu); p[5 * 8] = (bf16)(c >> 16); p[6 * 8] = (bf16)(d & 0xffffu); p[7 * 8] = (bf16)(d >> 16);
                    }
                }
            }
        }
    }
};

struct EpiMerge {
    static constexpr bool PERM = true, AFTER_DRAIN = false, DEFER_PUBLISH = false;
    const unsigned char *SGA, *SGB; bf16* MERGED;
    __device__ __forceinline__ void operator()(f32x4 (&acc)[2][2][4][2], const GU& u, int wr, int wc, int fr, int fq) const {
        const int row0 = u.pm * 256 + wr * 64 + fr, col0 = u.pn * 256 + wc * 32 + 8 * fq;
        const size_t gbase = (size_t)(u.pm * 4 + u.pn) * 65536 + (size_t)(((wr * 4 + wc) * 64 + fq * 16 + fr) * 16);
#pragma unroll
        for (int ai = 0; ai < 2; ++ai)
#pragma unroll
            for (int m = 0; m < 4; ++m) {
                const u32x4 ga = *(const u32x4*)(SGA + gbase + (size_t)(ai * 4 + m) * 8192);
                if (u.aux == 0) {
                    const u32x4 gb = *(const u32x4*)(SGB + gbase + (size_t)(ai * 4 + m) * 8192);
#pragma unroll
                    for (int bj = 0; bj < 2; ++bj)
#pragma unroll
                        for (int n = 0; n < 2; ++n)
#pragma unroll
                            for (int j = 0; j < 4; ++j) acc[ai][bj][m][n][j] *= (float)((gb[bj * 2 + n] >> (8 * j)) & 255u) * frcp((float)((ga[bj * 2 + n] >> (8 * j)) & 255u));
                } else {
#pragma unroll
                    for (int bj = 0; bj < 2; ++bj) { f32x4 v0, v1;
#pragma unroll
                        for (int j = 0; j < 4; ++j) { v0[j] = acc[ai][bj][m][0][j] * ((float)((ga[bj * 2] >> (8 * j)) & 255u) * (1.0f / 255.0f)); v1[j] = acc[ai][bj][m][1][j] * ((float)((ga[bj * 2 + 1] >> (8 * j)) & 255u) * (1.0f / 255.0f)); }
                        u32x4 w; w.x = cvtpk(v0[0], v0[1]); w.y = cvtpk(v0[2], v0[3]); w.z = cvtpk(v1[0], v1[1]); w.w = cvtpk(v1[2], v1[3]);
                        *(u32x4*)(MERGED + (size_t)(row0 + ai * 128 + m * 16) * DM + col0 + bj * 128) = w; }
                }
            }
    }
};

struct EpiX1 {
    static constexpr bool PERM = true, AFTER_DRAIN = false, DEFER_PUBLISH = false;
    const float* x; const float* mod; bf16* X1;
    __device__ __forceinline__ void operator()(f32x4 (&acc)[2][2][4][2], const GU& u, int wr, int wc, int fr, int fq) const {
        const int row0 = u.pm * 256 + wr * 64 + fr, col0 = u.pn * 256 + wc * 32 + 8 * fq, b = (u.pm * 256) >> 12;
        const float* gt = mod + b * NMOD + 2 * DM;
#pragma unroll
        for (int bj = 0; bj < 2; ++bj) { const int col = col0 + bj * 128; const f32x4 g0 = *(const f32x4*)(gt + col), g1 = *(const f32x4*)(gt + col + 4);
#pragma unroll
            for (int ai = 0; ai < 2; ++ai)
#pragma unroll
                for (int m = 0; m < 4; ++m) { const size_t off = (size_t)(row0 + ai * 128 + m * 16) * DM + col;
                    const f32x4 v0 = __builtin_nontemporal_load((const f32x4*)(x + off)) + g0 * acc[ai][bj][m][0], v1 = __builtin_nontemporal_load((const f32x4*)(x + off + 4)) + g1 * acc[ai][bj][m][1];
                    u32x4 w; w.x = cvtpk(v0[0], v0[1]); w.y = cvtpk(v0[2], v0[3]); w.z = cvtpk(v1[0], v1[1]); w.w = cvtpk(v1[2], v1[3]);
                    *(u32x4*)(X1 + off) = w; } }
    }
};

struct EpiMoe {
    static constexpr bool PERM = true, AFTER_DRAIN = false, DEFER_PUBLISH = true;
    bf16* ACT; bf16* Y; const LAS int* dtab; const LAS float* wtab; unsigned* cnt;
    __device__ __forceinline__ bool wants_publish(const GU& u) const { return u.aux == 0; }
    __device__ __forceinline__ void publish(int rb, int lane) const { if (lane == 0) __hip_atomic_fetch_add(cnt + 64 * rb, 1u, RLX_AGENT); }
    __device__ __forceinline__ void operator()(f32x4 (&acc)[2][2][4][2], const GU& u, int wr, int wc, int fr, int fq) const {
        if (u.aux == 0) {
            const int row0 = u.pm * 256 + wr * 64 + fr, col0 = u.pn * 128 + wc * 32 + 8 * fq;
#pragma unroll
            for (int ai = 0; ai < 2; ++ai)
#pragma unroll
                for (int m = 0; m < 4; ++m) { f32x4 a0, a1;
#pragma unroll
                    for (int j = 0; j < 4; ++j) { const float g0 = acc[ai][0][m][0][j], g1 = acc[ai][0][m][1][j]; a0[j] = g0 * fsigmoid(g0) * acc[ai][1][m][0][j]; a1[j] = g1 * fsigmoid(g1) * acc[ai][1][m][1][j]; }
                    u32x4 w; w.x = cvtpk(a0[0], a0[1]); w.y = cvtpk(a0[2], a0[3]); w.z = cvtpk(a1[0], a1[1]); w.w = cvtpk(a1[2], a1[3]);
                    st16_sc1(ACT + (size_t)(row0 + ai * 128 + m * 16) * DEXP + col0, w); }
        } else {
            const int r0 = wr * 64 + fr, col0 = u.pn * 256 + wc * 32 + 8 * fq;
#pragma unroll
            for (int ai = 0; ai < 2; ++ai)
#pragma unroll
                for (int m = 0; m < 4; ++m) { const int r = r0 + ai * 128 + m * 16; const int dest = dtab[u.eslot * 256 + r]; const float w = wtab[u.eslot * 256 + r];
                    if (dest >= 0) {
#pragma unroll
                        for (int bj = 0; bj < 2; ++bj) { const f32x4 v0 = acc[ai][bj][m][0] * w, v1 = acc[ai][bj][m][1] * w;
                            u32x4 o; o.x = cvtpk(v0[0], v0[1]); o.y = cvtpk(v0[2], v0[3]); o.z = cvtpk(v1[0], v1[1]); o.w = cvtpk(v1[2], v1[3]);
                            *(u32x4*)(Y + (size_t)dest * DM + col0 + bj * 128) = o; } } }
        }
    }
};

#define MFMA32(a, b, c) __builtin_amdgcn_mfma_f32_32x32x16_bf16((a), (b), (c), 0, 0, 0)
__device__ __forceinline__ int crow(int reg, int h) { return (reg & 3) + 8 * (reg >> 2) + 4 * h; }
struct KVFrag { bf16x8 k[4], v[4]; };
#define GLD16(dst, ptr, OFF) asm volatile("global_load_dwordx4 %0, %1, off offset:" #OFF : "=v"(dst) : "v"(ptr) : "memory")
__device__ __forceinline__ void kv_load(KVFrag& f, const bf16* kp, const bf16* vp) {
    GLD16(f.k[0], kp, 0); GLD16(f.k[1], kp, 1024); GLD16(f.k[2], kp, 2048); GLD16(f.k[3], kp, 3072);
    GLD16(f.v[0], vp, 0); GLD16(f.v[1], vp, 1024); GLD16(f.v[2], vp, 2048); GLD16(f.v[3], vp, 3072);
}
#define KV_WAIT(f, N) asm volatile("s_waitcnt vmcnt(" #N ")" : "+v"(f.k[0]), "+v"(f.k[1]), "+v"(f.k[2]), "+v"(f.k[3]), "+v"(f.v[0]), "+v"(f.v[1]), "+v"(f.v[2]), "+v"(f.v[3]) :: "memory")
__device__ __forceinline__ void attn_tile(const KVFrag& f, const bf16x8 (&qf)[4], bool first, bool lastt, int r, int h, float& m, float& l, f32x16& o0, f32x16& o1) {
    f32x16 st;
#pragma unroll
    for (int e = 0; e < 16; ++e) st[e] = 0.f;
#pragma unroll
    for (int c = 0; c < 4; ++c) st = MFMA32(f.k[c], qf[c], st);
    if (first || lastt) {
        int rq = r - 4 * h; asm volatile("" : "+v"(rq));
        if (first) {
#pragma unroll
            for (int e = 0; e < 16; ++e) st[e] = ((e & 3) + 8 * (e >> 2) < rq) ? -1.0e30f : st[e];
        } else {
#pragma unroll
            for (int e = 0; e < 16; ++e) st[e] = ((e & 3) + 8 * (e >> 2) > rq) ? -1.0e30f : st[e];
        }
    }
    float tm = st[0];
#pragma unroll
    for (int e = 1; e < 16; ++e) tm = fmaxf(tm, st[e]);
    { auto rr = __builtin_amdgcn_permlane32_swap(__float_as_uint(tm), __float_as_uint(tm), false, false); tm = fmaxf(__uint_as_float(rr[0]), __uint_as_float(rr[1])); }
    const float mn = fmaxf(m, tm), alpha = fexp2(m - mn); m = mn;
    float ps = 0.f;
#pragma unroll
    for (int e = 0; e < 16; ++e) { st[e] = fexp2(st[e] - mn); ps += st[e]; }
    l = l * alpha + ps;
#pragma unroll
    for (int e = 0; e < 16; ++e) { o0[e] *= alpha; o1[e] *= alpha; }
    u32x4 pa, pb;
    pa.x = cvtpk(st[0], st[1]); pa.y = cvtpk(st[2], st[3]); pa.z = cvtpk(st[4], st[5]); pa.w = cvtpk(st[6], st[7]);
    pb.x = cvtpk(st[8], st[9]); pb.y = cvtpk(st[10], st[11]); pb.z = cvtpk(st[12], st[13]); pb.w = cvtpk(st[14], st[15]);
    const bf16x8 p0 = __builtin_bit_cast(bf16x8, pa), p1 = __builtin_bit_cast(bf16x8, pb);
    o0 = MFMA32(f.v[0], p0, o0); o0 = MFMA32(f.v[1], p1, o0);
    o1 = MFMA32(f.v[2], p0, o1); o1 = MFMA32(f.v[3], p1, o1);
}
template <int W>
__device__ __forceinline__ void attn_job(const bf16* __restrict__ Qp, const bf16* __restrict__ Kp, const bf16* __restrict__ Vp, int L, int t0, float m0, float l0,
                                         f32x16& o0, f32x16& o1, float& m_out, float& l_out, int lane) {
    constexpr int NT = 2 * W / 32 + 1;
    const int r = lane & 31, h = lane >> 5;
    bf16x8 qf[4];
    { const bf16* qp = Qp + (size_t)(t0 >> 5) * 2048 + lane * 8; GLD16(qf[0], qp, 0); GLD16(qf[1], qp, 1024); GLD16(qf[2], qp, 2048); GLD16(qf[3], qp, 3072); }
    float m = m0, l = (h == 0) ? l0 : 0.f;
#pragma unroll
    for (int i = 0; i < 16; ++i) { o0[i] = 0.f; o1[i] = 0.f; }
    const int i_lo = (W - t0) > 0 ? ((W - t0) >> 5) : 0, i_hi = ((L - t0 + W) >> 5) < NT ? ((L - t0 + W) >> 5) : NT;
    const bf16* kq = Kp + lane * 8; const bf16* vq = Vp + lane * 8;
#define TILE_OFF(ii) ((size_t)((t0 - W + 32 * ((ii) < i_hi ? (ii) : i_hi - 1)) >> 5) * 2048)
    KVFrag fa, fb;
    int i = i_lo;
    kv_load(fa, kq + TILE_OFF(i), vq + TILE_OFF(i));
#pragma unroll 1
    for (;;) {
        kv_load(fb, kq + TILE_OFF(i + 1), vq + TILE_OFF(i + 1));
        KV_WAIT(fa, 8); asm volatile("" : "+v"(qf[0]), "+v"(qf[1]), "+v"(qf[2]), "+v"(qf[3]));
        attn_tile(fa, qf, i == 0, i == NT - 1, r, h, m, l, o0, o1);
        if (++i >= i_hi) break;
        kv_load(fa, kq + TILE_OFF(i + 1), vq + TILE_OFF(i + 1));
        KV_WAIT(fb, 8);
        attn_tile(fb, qf, i == 0, i == NT - 1, r, h, m, l, o0, o1);
        if (++i >= i_hi) break;
    }
    KV_WAIT(fa, 0); KV_WAIT(fb, 0);
#undef TILE_OFF
    l += __shfl_xor(l, 32);
    m_out = m; l_out = l;
}

constexpr int PSTRIDE = 136;
__device__ __forceinline__ void attn_phase(Frame& F) {
    LAS unsigned char* P = F.lds;
    LAS f32x2* ML = (LAS f32x2*)(F.lds + 3 * 256 * PSTRIDE);
    const int lane = F.lane, r = lane & 31, h = lane >> 5;
    for (int uidx = F.vcu; uidx < 512; uidx += F.G) {
        if (uidx < 256) {
            const int b = uidx >> 6, hs = (uidx >> 4) & 3, c = uidx & 15;
#pragma unroll 1
            for (int jj = 0; jj < 4; ++jj) {
                const int j = F.wave + 8 * jj;
                int g, head, res, t0, L, slot; bool valid = true;
                if (j < 8) { g = 0; head = hs; res = 0; t0 = 256 * c + 32 * j; L = 4096; slot = 32 * j + r; }
                else if (j < 16) { const int q = j - 8; g = 1; head = 4 + hs; res = q >> 1; t0 = 64 * c + 32 * (q & 1); L = 1024; slot = res * 64 + 32 * (q & 1) + r; }
                else { const int q = j - 16; g = 2; head = 8 + hs; res = q; t0 = 32 * (c >> 1); L = 256; valid = (r >> 4) == (c & 1); slot = res * 16 + (r & 15); }
                const size_t hb = (size_t)(b * 12 + head);
                const bf16* Qp = F.QA + (hb * 4096 + (size_t)res * L) * 64;
                const bf16* Kp = F.KA + (hb * 4096 + (size_t)res * L) * 64;
                const bf16* Vt = F.VAT + (hb * 4096 + (size_t)res * L) * 64;
                f32x16 o0, o1; float m, l;
                attn_job<64>(Qp, Kp, Vt, L, t0, -1.0e30f, 0.f, o0, o1, m, l, lane);
                if (valid) {
                    LAS unsigned char* row = P + (g * 256 + slot) * PSTRIDE;
#pragma unroll
                    for (int q4 = 0; q4 < 4; ++q4) {
                        u32x2 w0, w1; w0.x = cvtpk(o0[4 * q4], o0[4 * q4 + 1]); w0.y = cvtpk(o0[4 * q4 + 2], o0[4 * q4 + 3]); w1.x = cvtpk(o1[4 * q4], o1[4 * q4 + 1]); w1.y = cvtpk(o1[4 * q4 + 2], o1[4 * q4 + 3]);
                        *(LAS u32x2*)(row + (8 * q4 + 4 * h) * 2) = w0; *(LAS u32x2*)(row + (32 + 8 * q4 + 4 * h) * 2) = w1; }
                    if (h == 0) ML[g * 256 + slot] = (f32x2){m, l};
                }
            }
            __syncthreads();
            {
                const int tau = F.tid >> 1, half = F.tid & 1;
                const int s0 = tau, s1 = 256 + (tau & 3) * 64 + (tau >> 2), s2 = 512 + (tau & 15) * 16 + (tau >> 4);
                const f32x2 a0 = ML[s0], a1 = ML[s1], a2 = ML[s2];
                const float M = fmaxf(a0.x, fmaxf(a1.x, a2.x));
                float w0 = fexp2(a0.x - M), w1 = fexp2(a1.x - M), w2 = fexp2(a2.x - M);
                const float inv = 1.0f / (w0 * a0.y + w1 * a1.y + w2 * a2.y); w0 *= inv; w1 *= inv; w2 *= inv;
                bf16* dst = F.OA + (size_t)(b * 4096 + 256 * c + tau) * 256 + hs * 64 + 32 * half;
#pragma unroll
                for (int q = 0; q < 4; ++q) {
                    const u32x4 x0 = *(const LAS u32x4*)(P + s0 * PSTRIDE + (32 * half + 8 * q) * 2), x1 = *(const LAS u32x4*)(P + s1 * PSTRIDE + (32 * half + 8 * q) * 2), x2 = *(const LAS u32x4*)(P + s2 * PSTRIDE + (32 * half + 8 * q) * 2);
                    u32x4 o;
#pragma unroll
                    for (int k = 0; k < 4; ++k) { const float lo = w0 * bflo(x0[k]) + w1 * bflo(x1[k]) + w2 * bflo(x2[k]), hi = w0 * bfhi(x0[k]) + w1 * bfhi(x1[k]) + w2 * bfhi(x2[k]); o[k] = cvtpk(lo, hi); }
                    *(u32x4*)(dst + 8 * q) = o; }
            }
            __syncthreads();
        } else {
            const int uu = uidx - 256, b = uu >> 6, kvh = (uu >> 5) & 1, qb = uu & 31, T0 = 4 * qb - 4;
            const bf16* Kb_ = F.KB + (size_t)(b * 2 + kvh) * 4096 * 64; const bf16* Vb_ = F.VBT + (size_t)(b * 2 + kvh) * 4096 * 64;
            for (int x = F.wave; x < 24; x += 8) { const int j = x >> 1, kv = x & 1, T = T0 + j; if (T < 0 || T > 127) continue;
                const bf16* src = (kv ? Vb_ : Kb_) + (size_t)T * 2048 + lane * 8;
#pragma unroll
                for (int c = 0; c < 4; ++c) __builtin_amdgcn_global_load_lds((const unsigned*)(src + c * 512), (LAS unsigned*)(F.lds + j * 8192 + kv * 4096 + c * 1024), 16, 0, 0); }
            VM_WAIT(); __syncthreads();
#pragma unroll 1
            for (int jj = 0; jj < 2; ++jj) {
                const int j = F.wave + 8 * jj, head = kvh * 4 + (j >> 2), qt = j & 3, t0 = 128 * qb + 32 * qt;
                const bf16* Qp = F.QB + (size_t)(b * 8 + head) * 4096 * 64 + (size_t)(t0 >> 5) * 2048 + lane * 8;
                bf16x8 qf[4];
#pragma unroll
                for (int c = 0; c < 4; ++c) qf[c] = *(const bf16x8*)(Qp + c * 512);
                float m = F.sink[head] * LOG2E, l = (h == 0) ? 1.0f : 0.f;
                f32x16 o0, o1;
#pragma unroll
                for (int e = 0; e < 16; ++e) { o0[e] = 0.f; o1[e] = 0.f; }
#pragma unroll 1
                for (int i = 0; i < 9; ++i) { const int T = T0 + qt + i; if (T < 0 || T > 127) continue;
                    const LAS unsigned char* tp = F.lds + (qt + i) * 8192 + lane * 16;
                    KVFrag f;
#pragma unroll
                    for (int c = 0; c < 4; ++c) { f.k[c] = *(const LAS bf16x8*)(tp + c * 1024); f.v[c] = *(const LAS bf16x8*)(tp + 4096 + c * 1024); }
                    attn_tile(f, qf, i == 0, i == 8, r, h, m, l, o0, o1); }
                l += __shfl_xor(l, 32);
                const float inv = 1.0f / l;
                bf16* dst = F.OB + (size_t)(b * 4096 + t0 + r) * 512 + head * 64;
#pragma unroll
                for (int q4 = 0; q4 < 4; ++q4) {
                    u32x2 w0, w1; w0.x = cvtpk(o0[4 * q4] * inv, o0[4 * q4 + 1] * inv); w0.y = cvtpk(o0[4 * q4 + 2] * inv, o0[4 * q4 + 3] * inv);
                    w1.x = cvtpk(o1[4 * q4] * inv, o1[4 * q4 + 1] * inv); w1.y = cvtpk(o1[4 * q4 + 2] * inv, o1[4 * q4 + 3] * inv);
                    *(u32x2*)(dst + 8 * q4 + 4 * h) = w0; *(u32x2*)(dst + 32 + 8 * q4 + 4 * h) = w1; }
            }
            __syncthreads();
        }
    }
}

__device__ __forceinline__ void norm_route_phase(Frame& F, int bank) {
    LAS unsigned char* A = F.lds;
    const int lane = F.lane, w = F.wave;
    for (int u = F.vcu; u < MT / 64; u += F.G) {
        {
            u32x4 xv[8][2];
#pragma unroll
            for (int q = 0; q < 8; ++q) { const u32x4* xr = (const u32x4*)(F.X1 + (size_t)(64 * u + 8 * w + q) * DM) + lane; xv[q][0] = xr[0]; xv[q][1] = xr[64]; }
            f32x4 gg[2][2], sc[2][2], sh[2][2];
            const float* md = F.mod + ((64 * u) >> 12) * NMOD;
#pragma unroll
            for (int j = 0; j < 2; ++j)
#pragma unroll
                for (int hh = 0; hh < 2; ++hh) { const int col = 8 * (lane + 64 * j) + 4 * hh; gg[j][hh] = *(const f32x4*)(F.g_ffn + col); sc[j][hh] = *(const f32x4*)(md + 4 * DM + col) + 1.0f; sh[j][hh] = *(const f32x4*)(md + 3 * DM + col); }
#pragma unroll
            for (int q = 0; q < 8; ++q) {
                const int rl = 8 * w + q, m = 64 * u + rl; float ss = 0.f; f32x4 f[2][2];
#pragma unroll
                for (int j = 0; j < 2; ++j) { f[j][0] = (f32x4){bflo(xv[q][j].x), bfhi(xv[q][j].x), bflo(xv[q][j].y), bfhi(xv[q][j].y)}; f[j][1] = (f32x4){bflo(xv[q][j].z), bfhi(xv[q][j].z), bflo(xv[q][j].w), bfhi(xv[q][j].w)};
#pragma unroll
                    for (int hh = 0; hh < 2; ++hh) ss += (f[j][hh].x * f[j][hh].x + f[j][hh].y * f[j][hh].y) + (f[j][hh].z * f[j][hh].z + f[j][hh].w * f[j][hh].w); }
                const float rinv = 1.0f / sqrtf(wave_sum(ss) * (1.0f / DM) + RMS_EPS);
#pragma unroll
                for (int j = 0; j < 2; ++j) { const int col = 8 * (lane + 64 * j);
                    const f32x4 h0 = f[j][0] * rinv * gg[j][0] * sc[j][0] + sh[j][0], h1 = f[j][1] * rinv * gg[j][1] * sc[j][1] + sh[j][1];
                    u32x4 o; o.x = cvtpk(h0.x, h0.y); o.y = cvtpk(h0.z, h0.w); o.z = cvtpk(h1.x, h1.y); o.w = cvtpk(h1.z, h1.w);
                    *(u32x4*)(F.H + (size_t)m * DM + col) = o;
                    *(LAS u32x4*)(A + rl * 2048 + ((((col >> 3) ^ (rl & 15))) << 4)) = o; }
            }
        }
        __syncthreads();
        const int rt = w & 1, ct = (w >> 1) & 1, kq = w >> 2, r = lane & 31, h = lane >> 5;
        f32x16 acc;
#pragma unroll
        for (int e = 0; e < 16; ++e) acc[e] = 0.f;
        {
            const bf16* bp = F.WrT + (size_t)(32 * ct + r) * DM + 512 * kq + 8 * h;
            const int arow = 32 * rt + r;
            const LAS unsigned char* ap = A + arow * 2048;
#pragma unroll 8
            for (int ks = 0; ks < 32; ++ks) {
                const bf16x8 bf = *(const bf16x8*)(bp + 16 * ks);
                const int chunk = 64 * kq + 2 * ks + h;
                const bf16x8 af = *(const LAS bf16x8*)(ap + ((chunk ^ (arow & 15)) << 4));
                acc = MFMA32(af, bf, acc);
            }
        }
        __syncthreads();
        LAS float* P = (LAS float*)F.lds;
        LAS int* lcnt = (LAS int*)(F.lds + 2 * 64 * 68 * 4);
#pragma unroll
        for (int e = 0; e < 16; ++e) P[(kq * 64 + 32 * rt + crow(e, h)) * 68 + 32 * ct + r] = acc[e];
        if (F.tid < 64) lcnt[F.tid] = 0;
        __syncthreads();
        int e1 = 0, e2 = 0, p1 = 0, p2 = 0; float w1 = 0.f, w2 = 0.f;
        if (F.tid < 64) {
            const LAS float* q0 = P + F.tid * 68; const LAS float* q1 = P + (64 + F.tid) * 68;
            float gl[4]; float gmax = -3.0e38f; int gs = 0;
#pragma unroll
            for (int j = 0; j < 4; ++j) { gl[j] = q0[j] + q1[j] + F.b_group[j]; if (gl[j] > gmax) { gmax = gl[j]; gs = j; } }
            float gz = 0.f;
#pragma unroll
            for (int j = 0; j < 4; ++j) gz += __expf(gl[j] - gmax);
            const float gw = 1.0f / gz;
            float el[8]; float m1 = -3.0e38f; int i1 = 0;
#pragma unroll
            for (int j = 0; j < 8; ++j) { el[j] = q0[4 + 8 * gs + j] + q1[4 + 8 * gs + j] + F.b_route[8 * gs + j]; if (el[j] > m1) { m1 = el[j]; i1 = j; } }
            float m2 = -3.0e38f; int i2 = 0;
#pragma unroll
            for (int j = 0; j < 8; ++j) { if (j != i1 && el[j] > m2) { m2 = el[j]; i2 = j; } }
            const float q2 = __expf(m2 - m1), inv = 1.0f / (1.0f + q2);
            w1 = inv * gw; w2 = q2 * inv * gw; e1 = 8 * gs + i1; e2 = 8 * gs + i2;
            p1 = atomicAdd((int*)(lcnt + e1), 1); p2 = atomicAdd((int*)(lcnt + e2), 1);
        } else if (F.wave >= 1) bg_step(F);
        __syncthreads();
        const int shard = F.bx & 7;
        if (F.tid < 32) { const int c = lcnt[F.tid]; lcnt[32 + F.tid] = c ? (int)__hip_atomic_fetch_add(F.ctl + CW_CNT + bank * 49152 + 64 * (32 * shard + F.tid), (unsigned)c, RLX_AGENT) : 0; }
        __syncthreads();
        if (F.tid < 64) {
            const int tok = 64 * u + F.tid;
            F.list[(bank << 20) + ((32 * shard + e1) << 12) + lcnt[32 + e1] + p1] = 2 * tok; F.wts[2 * tok] = w1;
            F.list[(bank << 20) + ((32 * shard + e2) << 12) + lcnt[32 + e2] + p2] = 2 * tok + 1; F.wts[2 * tok + 1] = w2;
        }
        __syncthreads();
    }
}

__device__ __forceinline__ void moe_setup(Frame& F, int& n4_out, int& n7_out) {
    LAS int* rbtab = (LAS int*)(F.lds + TAB_RB); LAS int* cnttab = (LAS int*)(F.lds + TAB_CNT); LAS int* nbw = (LAS int*)(F.lds + TAB_NB);
    LAS int* gidx = (LAS int*)(F.lds + TAB_GIDX); LAS int* dtab = (LAS int*)(F.lds + TAB_D); LAS float* wtab = (LAS float*)(F.lds + TAB_W);
    LAS int* pref = (LAS int*)(F.lds + TAB_PREF);
    if (F.tid < 256) pref[(F.tid & 31) * 8 + (F.tid >> 5)] = (int)__hip_atomic_load(F.ctl + CW_CNT + 64 * F.tid, RLX_AGENT);
    __syncthreads();
    if (F.tid < 64) {
        int cnt = 0;
        if (F.tid < 32) { for (int sh = 0; sh < 8; ++sh) { const int c = pref[F.tid * 8 + sh]; pref[F.tid * 8 + sh] = cnt; cnt += c; } }
        const int nb = (cnt + 255) >> 8; int incl = nb;
#pragma unroll
        for (int o = 1; o < 32; o <<= 1) { const int t = __shfl_up(incl, o); if (F.lane >= o) incl += t; }
        if (F.tid < 32) { cnttab[F.tid] = cnt; const int st = incl - nb; for (int j = 0; j < nb; ++j) rbtab[st + j] = (F.tid << 8) | j; }
        if (F.tid == 31) nbw[0] = incl;
    }
    __syncthreads();
    const int n4 = 4 * nbw[0];
    const int n7 = n4 / F.G + (F.bx < n4 % F.G ? 1 : 0);
    for (int i = 0; i < 7; ++i) { const int t = moe_deal(i, F.bx, F.G, n4); if (t < 0) break;
        const bool down = t >= n4; const int rb = (down ? t - n4 : t) >> 2, slot = down ? i - n7 : i;
        if (slot < 3 && F.tid < 256) { const int v = rbtab[rb], e = v >> 8, j = v & 255; const int nvalid = cnttab[e] - 256 * j;
            int val = -1;
            if (F.tid < nvalid) { const int q = 256 * j + F.tid; int sh = 0;
#pragma unroll
                for (int k = 1; k < 8; ++k) sh += (pref[e * 8 + k] <= q) ? 1 : 0;
                val = F.list[((32 * sh + e) << 12) + q - pref[e * 8 + sh]]; }
            if (!down) gidx[slot * 256 + F.tid] = val >= 0 ? (val >> 1) : 0;
            else { dtab[slot * 256 + F.tid] = val; wtab[slot * 256 + F.tid] = val >= 0 ? F.wts[val] : 0.f; } } }
    __syncthreads();
    n4_out = n4; n7_out = n7;
}

__device__ __forceinline__ void final_rows(Frame& F) {
    const int gw = F.vcu * 8 + F.wave, NGW = F.G * 8;
    for (int m0 = gw; m0 < MT; m0 += 2 * NGW) {
        u32x4 xa[2][2], ya[2][2], yb[2][2];
#pragma unroll
        for (int q = 0; q < 2; ++q) { const int m = m0 + q * NGW; if (m < MT) {
            const u32x4* xr = (const u32x4*)(F.X1 + (size_t)m * DM) + F.lane; const u32x4* y0 = (const u32x4*)(F.Y + (size_t)(2 * m) * DM) + F.lane; const u32x4* y1 = (const u32x4*)(F.Y + (size_t)(2 * m + 1) * DM) + F.lane;
#pragma unroll
            for (int j = 0; j < 2; ++j) { xa[q][j] = xr[64 * j]; ya[q][j] = y0[64 * j]; yb[q][j] = y1[64 * j]; } } }
#pragma unroll
        for (int q = 0; q < 2; ++q) { const int m = m0 + q * NGW; if (m >= MT) continue;
            const float* gt = F.mod + (m >> 12) * NMOD + 5 * DM; float s = 0.f; f32x4 v[2][2];
#pragma unroll
            for (int j = 0; j < 2; ++j)
#pragma unroll
                for (int hh = 0; hh < 2; ++hh) { const int col = 8 * (F.lane + 64 * j) + 4 * hh; const f32x4 g = *(const f32x4*)(gt + col);
                    const unsigned x0 = hh ? xa[q][j].z : xa[q][j].x, x1 = hh ? xa[q][j].w : xa[q][j].y, a0 = hh ? ya[q][j].z : ya[q][j].x, a1 = hh ? ya[q][j].w : ya[q][j].y, b0 = hh ? yb[q][j].z : yb[q][j].x, b1 = hh ? yb[q][j].w : yb[q][j].y;
                    const f32x4 xs = {bflo(x0), bfhi(x0), bflo(x1), bfhi(x1)}, ys = {bflo(a0) + bflo(b0), bfhi(a0) + bfhi(b0), bflo(a1) + bflo(b1), bfhi(a1) + bfhi(b1)};
                    v[j][hh] = xs + g * ys; s += (v[j][hh].x * v[j][hh].x + v[j][hh].y * v[j][hh].y) + (v[j][hh].z * v[j][hh].z + v[j][hh].w * v[j][hh].w); }
            const float rinv = 1.0f / sqrtf(wave_sum(s) * (1.0f / DM) + RMS_EPS);
#pragma unroll
            for (int j = 0; j < 2; ++j)
#pragma unroll
                for (int hh = 0; hh < 2; ++hh) { const int col = 8 * (F.lane + 64 * j) + 4 * hh; *(f32x4*)(F.out + (size_t)m * DM + col) = v[j][hh] * rinv * *(const f32x4*)(F.g_final + col); }
        }
    }
}

struct Args { const void* in[20]; float* out; unsigned char* ws; int ph_lo, ph_hi, li, pad; };
__global__ void __launch_bounds__(512, 2) fwd_kernel(Args args) {
    extern __shared__ __attribute__((aligned(16))) unsigned char lds[];
    Frame F;
    F.lds = (LAS unsigned char*)lds;
    F.tid = threadIdx.x; F.lane = F.tid & 63; F.wave = __builtin_amdgcn_readfirstlane(F.tid >> 6);
    F.G = gridDim.x; F.bx = blockIdx.x; F.vcu = (F.G % 8 == 0) ? (F.bx % 8) * (F.G / 8) + F.bx / 8 : F.bx;
    unsigned char* ws = args.ws;
    F.ctl = (unsigned*)(ws + WS_CTL);
    F.x = (const float*)args.in[0]; F.c = (const float*)args.in[1]; F.positions = (const int*)args.in[2]; F.w_ada = (const float*)args.in[3]; F.b_ada = (const float*)args.in[4];
    F.g_mix = (const float*)args.in[5]; F.w_in = (const float*)args.in[6]; F.sink = (const float*)args.in[7]; F.w_a = (const float*)args.in[8]; F.w_b = (const float*)args.in[9];
    F.w_out = (const float*)args.in[10]; F.g_ffn = (const float*)args.in[11]; F.w_group = (const float*)args.in[12]; F.b_group = (const float*)args.in[13]; F.w_route = (const float*)args.in[14];
    F.b_route = (const float*)args.in[15]; F.w_gate = (const float*)args.in[16]; F.w_up = (const float*)args.in[17]; F.w_down = (const float*)args.in[18]; F.g_final = (const float*)args.in[19];
    F.out = args.out;
    F.mod = (float*)(ws + WS_MOD); F.rcos = (float*)(ws + WS_RCOS); F.rsin = (float*)(ws + WS_RSIN); F.wts = (float*)(ws + WS_WTS); F.list = (int*)(ws + WS_LIST);
    F.WrT = (bf16*)(ws + WS_WRT); F.WaT = (bf16*)(ws + WS_WAT); F.WbT = (bf16*)(ws + WS_WBT); F.WoT = (bf16*)(ws + WS_WOT); F.WinT = (bf16*)(ws + WS_WINT); F.GUT = (bf16*)(ws + WS_GUT); F.DT = (bf16*)(ws + WS_DT);
    F.H = (bf16*)(ws + WS_H); F.OA = (bf16*)(ws + WS_OA); F.OB = (bf16*)(ws + WS_OB); F.QA = (bf16*)(ws + WS_QA); F.KA = (bf16*)(ws + WS_KA); F.VAT = (bf16*)(ws + WS_VAT);
    F.QB = (bf16*)(ws + WS_QB); F.KB = (bf16*)(ws + WS_KB); F.VBT = (bf16*)(ws + WS_VBT); F.MERGED = (bf16*)(ws + WS_MERGED); F.ACT = (bf16*)(ws + WS_ACT); F.Y = (bf16*)(ws + WS_Y);
    F.X1 = (bf16*)(ws + WS_X1);
    F.SGA = (unsigned char*)args.out; F.SGB = (unsigned char*)args.out + (size_t)MT * DM;
    for (int u = F.tid; u < (LDS_BYTES - MISC_OFF) / 4; u += 512) ((LAS unsigned*)(F.lds + MISC_OFF))[u] = 0u;
    __syncthreads();
    F.bg_done = 0;
#if MK_PER_PHASE
#define GRID_BAR() do {} while (0)
#else
    XcdBarrier bar = xcd_barrier_post(F.ctl + CW_BAR + args.li * XCD_BAR_WORDS, (volatile LAS unsigned*)(F.lds + MISC_OFF));
#define GRID_BAR() xcd_barrier(bar)
#endif
    volatile LAS unsigned* relw = (volatile LAS unsigned*)(F.lds + MISC_OFF + 64);
    const int lo = args.ph_lo, hi = args.ph_hi;
#define IN(k) (lo <= (k) && (k) < hi)
#if MK_PER_PHASE
#define SEAM(k) do { if ((k) == 5) { while (bg_step(F)) {} } } while (0)
#else
#define SEAM(k) do { if ((k) == 5) { while (bg_step(F)) {} }         \
        if (IN(k) && IN((k) + 1)) { if ((k) < 5) xcd_barrier_bg(bar, F, relw, (unsigned)(k) + 1u); else GRID_BAR(); } } while (0)
#endif

#define PHASE_BEGIN(k) if (IN(k)) {
#define PHASE_END(k) SEAM(k); }
    PHASE_BEGIN(0) p0_prologue(F); norm_rows(F, F.x, F.g_mix, 0, DM, F.H); PHASE_END(0)
    PHASE_BEGIN(1)
        SchedTiles S{(const char*)F.H, (const char*)F.WinT, 2048, 2048, 16, 64, 20, F.G, F.bx};
        EpiIn E{F.QA, F.KA, F.VAT, F.QB, F.KB, F.VBT, F.SGA, F.SGB, F.rcos, F.rsin};
        pg8::gemm_run<EpiIn, SchedTiles, false, true>(F.lds, nullptr, S, E);
    PHASE_END(1)
    PHASE_BEGIN(2) attn_phase(F); PHASE_END(2)
    PHASE_BEGIN(3)
        SchedBranch S{(const char*)F.OA, (const char*)F.OB, (const char*)F.WaT, (const char*)F.WbT, F.G, F.bx};
        EpiMerge E{F.SGA, F.SGB, F.MERGED};
        pg8::gemm_run<EpiMerge, SchedBranch, false, false>(F.lds, nullptr, S, E);
    PHASE_END(3)
    PHASE_BEGIN(4)
        SchedTiles S{(const char*)F.MERGED, (const char*)F.WoT, 2048, 2048, 16, 64, 4, F.G, F.bx};
        EpiX1 E{F.x, F.mod, F.X1};
        pg8::gemm_run<EpiX1, SchedTiles, false, false>(F.lds, nullptr, S, E);
    PHASE_END(4)
    PHASE_BEGIN(5) norm_route_phase(F, (MK_REPEAT_MASK != 0 && args.li == 1) ? 1 : 0); PHASE_END(5)
    PHASE_BEGIN(6)
        int n4, n7; moe_setup(F, n4, n7);
        SchedMoe S{(const char*)F.H, (const char*)F.ACT, (const char*)F.GUT, (const char*)F.DT, (const LAS int*)(F.lds + TAB_RB), F.ctl + CW_ACT, n4, n7, F.G, F.bx};
        EpiMoe E{F.ACT, F.Y, (const LAS int*)(F.lds + TAB_D), (const LAS float*)(F.lds + TAB_W), F.ctl + CW_ACT};
        pg8::gemm_run<EpiMoe, SchedMoe, true, true>(F.lds, (const LAS int*)(F.lds + TAB_GIDX), S, E);
    PHASE_END(6)
    PHASE_BEGIN(7) final_rows(F); PHASE_END(7)
#undef IN
#undef SEAM
}

extern "C" void kernel_launch(void* const* d_in, const int* in_sizes, int n_in, void* d_out, int out_size, void* d_ws, size_t ws_size, hipStream_t stream) {
    static int grid = 0;
    if (grid == 0) {
        if (n_in != 20 || out_size != MT * DM || ws_size < WS_END) { fprintf(stderr, "kernel_launch: unexpected shapes (n_in %d out %d ws %zu)\n", n_in, out_size, ws_size); grid = -1; return; }
        int dev = 0, cus = 0, per_cu = 0;
        if (hipGetDevice(&dev) != hipSuccess || hipDeviceGetAttribute(&cus, hipDeviceAttributeMultiprocessorCount, dev) != hipSuccess) { grid = -1; return; }
        if (hipFuncSetAttribute((const void*)fwd_kernel, hipFuncAttributeMaxDynamicSharedMemorySize, LDS_BYTES) != hipSuccess) { fprintf(stderr, "kernel_launch: hipFuncSetAttribute failed\n"); grid = -1; return; }
        if (hipOccupancyMaxActiveBlocksPerMultiprocessor(&per_cu, (const void*)fwd_kernel, 512, LDS_BYTES) != hipSuccess || per_cu < 1) { fprintf(stderr, "kernel_launch: occupancy query says %d\n", per_cu); }
        (void)hipGetLastError();
        grid = cus;
    }
    if (grid < 0) return;
    (void)hipMemsetAsync((char*)d_ws + WS_CTL, 0, CTL_ZERO_BYTES, stream);
    Args a{};
    for (int i = 0; i < 20; ++i) a.in[i] = d_in[i];
    a.out = (float*)d_out; a.ws = (unsigned char*)d_ws;
#if MK_PER_PHASE
    for (int p = 0; p < NPHASE; ++p) { a.ph_lo = p; a.ph_hi = p + 1; hipLaunchKernelGGL(fwd_kernel, dim3(grid), dim3(512), LDS_BYTES, stream, a); }
#else
    if (MK_REPEAT_MASK == 0) { a.ph_lo = 0; a.ph_hi = NPHASE; a.li = 0; hipLaunchKernelGGL(fwd_kernel, dim3(grid), dim3(512), LDS_BYTES, stream, a); }
    else {
        int k0 = 0, k1 = 0; for (int k = 0; k < NPHASE; ++k) if ((MK_REPEAT_MASK >> k) & 1) { k0 = k; break; }
        for (int k = 0; k < NPHASE; ++k) if ((MK_REPEAT_MASK >> k) & 1) k1 = k;
        a.ph_lo = 0; a.ph_hi = k1 + 1; a.li = 0; hipLaunchKernelGGL(fwd_kernel, dim3(grid), dim3(512), LDS_BYTES, stream, a);
        a.ph_lo = k0; a.ph_hi = k1 + 1; a.li = 1; hipLaunchKernelGGL(fwd_kernel, dim3(grid), dim3(512), LDS_BYTES, stream, a);
        if (k1 + 1 < NPHASE) { a.ph_lo = k1 + 1; a.ph_hi = NPHASE; a.li = 2; hipLaunchKernelGGL(fwd_kernel, dim3(grid), dim3(512), LDS_BYTES, stream, a); }
    }
#endif
}
```

```cpp
#include <hip/hip_runtime.h>
#include <cstdio>
#include <cstdint>

#ifndef MK_PER_PHASE
#define MK_PER_PHASE 0
#endif

#ifndef MK_REPEAT_MASK
#define MK_REPEAT_MASK 0
#endif
#define LAS __attribute__((address_space(3)))
#define GAS __attribute__((address_space(1)))
typedef unsigned short bf16;
typedef short bf16x8 __attribute__((ext_vector_type(8)));
typedef short s16x4 __attribute__((ext_vector_type(4)));
typedef float f32x4 __attribute__((ext_vector_type(4)));
typedef float f32x2 __attribute__((ext_vector_type(2)));
typedef float f32x16 __attribute__((ext_vector_type(16)));
typedef unsigned u32x4 __attribute__((ext_vector_type(4)));
typedef unsigned u32x2 __attribute__((ext_vector_type(2)));
typedef __bf16 bf16x2_t __attribute__((ext_vector_type(2)));

constexpr int NBATCH = 4, SEQ = 4096, DM = 1024, MT = NBATCH * SEQ;
constexpr int NIN = 5120, NMOD = 6 * DM;
constexpr int NEXP = 32, DEXP = 512;
constexpr float RMS_EPS = 1e-6f;
constexpr float LOG2E = 1.4426950408889634f;
constexpr float QSCALE = 0.125f * LOG2E;
constexpr int NPHASE = 8;

constexpr size_t MiB = 1u << 20;
constexpr size_t WS_CTL = 0, CTL_ZERO_BYTES = 1 * MiB;
constexpr size_t WS_MOD = 1 * MiB;
constexpr size_t WS_RCOS = 2 * MiB, WS_RSIN = 4 * MiB;
constexpr size_t WS_LIST = 288 * MiB;
constexpr size_t WS_WTS = 8 * MiB;
constexpr size_t WS_WRT = 8 * MiB + 512 * 1024;
constexpr size_t WS_WAT = 9 * MiB;
constexpr size_t WS_WBT = 9 * MiB + 512 * 1024;
constexpr size_t WS_WOT = 10 * MiB + 512 * 1024;
constexpr size_t WS_WINT = 13 * MiB;
constexpr size_t WS_GUT = 24 * MiB;
constexpr size_t WS_DT = 88 * MiB;
constexpr size_t WS_H = 120 * MiB;
constexpr size_t WS_OA = 120 * MiB;
constexpr size_t WS_OB = 128 * MiB;
constexpr size_t WS_QA = 152 * MiB, WS_KA = 176 * MiB, WS_VAT = 200 * MiB, WS_QB = 224 * MiB, WS_KB = 240 * MiB, WS_VBT = 244 * MiB;
constexpr size_t WS_MERGED = 152 * MiB;
constexpr size_t WS_ACT = 152 * MiB;
constexpr size_t WS_Y = 192 * MiB;
constexpr size_t WS_X1 = 256 * MiB;
constexpr size_t WS_END = 296 * MiB;
constexpr int CW_BAR = 4096;
constexpr int CW_CNT = 16384;
constexpr int CW_MODCNT = 49152;
constexpr int CW_ACT = 32768;

constexpr int RING_BYTES = 131072;
constexpr int TAB_OFF = RING_BYTES;
constexpr int TAB_GIDX = TAB_OFF, TAB_D = TAB_OFF + 3072, TAB_W = TAB_OFF + 6144, TAB_RB = TAB_OFF + 9216, TAB_CNT = TAB_RB + 768, TAB_NB = TAB_CNT + 128, TAB_PREF = TAB_NB + 16;
constexpr int MISC_OFF = TAB_OFF + 12288;
constexpr int LDS_BYTES = 147456;

#define LDS_WAIT() asm volatile("s_waitcnt lgkmcnt(0)" ::: "memory")
#define VM_WAIT() asm volatile("s_waitcnt vmcnt(0)" ::: "memory")
#define RLX_AGENT __ATOMIC_RELAXED, __HIP_MEMORY_SCOPE_AGENT
__device__ __forceinline__ unsigned cvtpk(float lo, float hi) { f32x2 v = {lo, hi}; bf16x2_t b = __builtin_convertvector(v, bf16x2_t); return __builtin_bit_cast(unsigned, b); }
__device__ __forceinline__ float bflo(unsigned u) { return __builtin_bit_cast(float, u << 16); }
__device__ __forceinline__ float bfhi(unsigned u) { return __builtin_bit_cast(float, u & 0xffff0000u); }
__device__ __forceinline__ float fexp2(float x) { return __builtin_amdgcn_exp2f(x); }
__device__ __forceinline__ float frcp(float x) { return __builtin_amdgcn_rcpf(x); }
__device__ __forceinline__ float fsigmoid(float x) { return frcp(1.0f + fexp2(-x * LOG2E)); }
__device__ __forceinline__ void st16_sc1(void* p, u32x4 v) { asm volatile("global_store_dwordx4 %0, %1, off sc1\n\ts_nop 1" :: "v"(p), "v"(v) : "memory"); }
__device__ __forceinline__ float wave_sum(float v) {
#pragma unroll
    for (int o = 1; o < 64; o <<= 1) v += __shfl_xor(v, o);
    return v;
}

namespace pg8 {
constexpr int BM = 256, BK = 64, HALF = 128, HTB = HALF * BK * 2, STAGE_BYTES = 8 * HTB;
__host__ __device__ __forceinline__ int lds_byte(int r, int c) { const int st = (r >> 4) * 2 + (c >> 5), rr = r & 15, cc = c & 31, ob = rr * 64 + cc * 2; return st * 1024 + (ob ^ (((ob >> 9) & 1) << 5)); }
__host__ __device__ __forceinline__ void stage_rc(int b, int& R, int& C) { const int st = b / 1024, sb = b % 1024, swz = sb ^ (((sb >> 9) & 1) << 5); R = (st >> 1) * 16 + swz / 64; C = (st & 1) * 32 + (swz % 64) / 2; }
__host__ __device__ __forceinline__ int perm32(int rho) { const int n = rho >> 4, i = rho & 15; return 8 * (i >> 2) + 4 * n + (i & 3); }

struct GU {
    const char* A;
    const char* B;
    int lda, ldb;
    int nt;
    int zero;
    int gslot;
    int pm, pn, aux;
    int eslot;
};

__device__ __forceinline__ bool static_tile(int i, int G, int c, int nM, int nN, int& pm, int& pn, int WG = 8) {
    const int nwg = nM * nN; const long L = (long)i * G + c; if (L >= nwg) return false;
    int wgid = (int)L; { const int q = nwg / 8, r = nwg % 8, xcd = wgid % 8, off = wgid / 8; wgid = (xcd < r ? xcd * (q + 1) : r * (q + 1) + (xcd - r) * q) + off; }
    const int nig = WG * nN, gid = wgid / nig, fm = gid * WG, gsz = (nM - fm) < WG ? (nM - fm) : WG;
    pm = fm + ((wgid % nig) % gsz); pn = (wgid % nig) / gsz; return true;
}

template <class Epi, class Sched, bool GATHER, bool ALIGN_EPI>
__device__ __forceinline__ void gemm_run(LAS unsigned char* lds, const LAS int* gidx, const Sched& S, const Epi& E) {
    const int tid = threadIdx.x, wid = __builtin_amdgcn_readfirstlane(tid >> 6), lane = tid & 63, wr = wid >> 2, wc = wid & 3, fr = lane & 15, fq = lane >> 4;
    int R[2], C2[2], Rb[2];
#pragma unroll
    for (int i = 0; i < 2; ++i) { int C; stage_rc(tid * 16 + i * 8192, R[i], C); C2[i] = C * 2; Rb[i] = Epi::PERM ? ((R[i] & ~31) + perm32(R[i] & 31)) : R[i]; }
    const unsigned ldsw = (unsigned)wid * 1024u;
    const int aoff = lds_byte(wr * 64 + fr, fq * 8), boff = lds_byte(wc * 32 + fr, fq * 8);
#define PG8_SA(b, h) (((b) * 2 + (h)) * HTB)
#define PG8_SB(b, h) ((4 + (b) * 2 + (h)) * HTB)
#define PG8_STAGE(bufoff, gbase, voff) do { _Pragma("unroll") for (int _i = 0; _i < 2; ++_i) \
        __builtin_amdgcn_global_load_lds((const unsigned*)((const char*)(gbase) + (voff)[_i]), (LAS unsigned*)(lds + (bufoff) + ldsw + _i * 8192), 16, 0, 0); } while (0)
#define PG8_LDA(dst, b, h) do { _Pragma("unroll") for (int m = 0; m < 4; ++m) _Pragma("unroll") for (int k = 0; k < 2; ++k) dst[m][k] = *(const LAS bf16x8*)(lds + PG8_SA(b, h) + aoff + m * 2048 + k * 1024); } while (0)
#define PG8_LDB(dst, b, h) do { _Pragma("unroll") for (int n = 0; n < 2; ++n) _Pragma("unroll") for (int k = 0; k < 2; ++k) dst[n][k] = *(const LAS bf16x8*)(lds + PG8_SB(b, h) + boff + n * 2048 + k * 1024); } while (0)
#define PG8_MMA(ai, bj, At, Bt) do { __builtin_amdgcn_s_setprio(1); _Pragma("unroll") for (int m = 0; m < 4; ++m) _Pragma("unroll") for (int n = 0; n < 2; ++n) _Pragma("unroll") for (int k = 0; k < 2; ++k) \
        acc[ai][bj][m][n] = __builtin_amdgcn_mfma_f32_16x16x32_bf16(Bt[n][k], At[m][k], acc[ai][bj][m][n], 0, 0, 0); __builtin_amdgcn_s_setprio(0); } while (0)
#define PG8_WAIT_V(n) asm volatile("s_waitcnt vmcnt(" #n ")" ::: "memory")
#define PG8_WAIT_L(n) asm volatile("s_waitcnt lgkmcnt(" #n ")" ::: "memory")
#define PG8_BAR __builtin_amdgcn_s_barrier()
#define PG8_SCHED __builtin_amdgcn_sched_barrier(0)
#define PG8_SETV(u) do { _Pragma("unroll") for (int _i = 0; _i < 2; ++_i) { int r0, r1; \
        if (GATHER && (u).gslot >= 0) { r0 = gidx[(u).gslot * 256 + R[_i]]; r1 = gidx[(u).gslot * 256 + 128 + R[_i]]; } else { r0 = R[_i]; r1 = R[_i] + 128; } \
        vA[0][_i] = (unsigned)(r0 * (u).lda + C2[_i]); vA[1][_i] = (unsigned)(r1 * (u).lda + C2[_i]); vB[_i] = (unsigned)(Rb[_i] * (u).ldb + C2[_i]); } hB = (unsigned)(128 * (u).ldb); } while (0)
    GU cur, nxt; int ui = 0; int pend = -1;
    if (!S.next(0, cur)) return;
    f32x4 acc[2][2][4][2];
#pragma unroll
    for (int a = 0; a < 2; ++a)
#pragma unroll
        for (int b = 0; b < 2; ++b)
#pragma unroll
            for (int m = 0; m < 4; ++m)
#pragma unroll
                for (int n = 0; n < 2; ++n) acc[a][b][m][n] = (f32x4){0.f, 0.f, 0.f, 0.f};
    bf16x8 At[4][2], B0[2][2], B1[2][2];
    unsigned vA[2][2], vB[2], hB;
    S.a_ready(cur);
    PG8_SETV(cur);
    const char* sA = cur.A; const char* sB = cur.B;
    PG8_STAGE(PG8_SB(0, 0), sB, vB); PG8_STAGE(PG8_SB(0, 1), sB + hB, vB); PG8_STAGE(PG8_SA(0, 0), sA, vA[0]); PG8_STAGE(PG8_SA(0, 1), sA, vA[1]);
    if (wr == 1) PG8_BAR;
    PG8_WAIT_V(2); PG8_BAR;
    PG8_STAGE(PG8_SB(1, 0), sB + 128, vB); PG8_STAGE(PG8_SA(1, 0), sA + 128, vA[0]); PG8_STAGE(PG8_SB(1, 1), sB + hB + 128, vB);
    PG8_WAIT_V(6); PG8_BAR;
    sA += 256; sB += 256;
    for (;;) {
        bool has_next = false;
        const int nt = cur.nt;
        for (int t = 0; t < nt; t += 2) {
            const bool last = (t == nt - 2);
            PG8_LDB(B0, 0, 0); PG8_LDB(B1, 0, 1); PG8_SCHED; PG8_LDA(At, 0, 0); PG8_STAGE(PG8_SA(1, 1), sA - 128, vA[1]);
            PG8_WAIT_V(8); PG8_WAIT_L(0); PG8_BAR; PG8_MMA(0, 0, At, B0); PG8_MMA(0, 1, At, B1); PG8_BAR; PG8_SCHED;
            if (last) {
                has_next = S.next(ui + 1, nxt);
                if (has_next) { S.a_ready(nxt); PG8_SETV(nxt); sA = nxt.A; sB = nxt.B; } else { sA = cur.A; sB = cur.B; }
            }
            PG8_LDA(At, 0, 1); PG8_STAGE(PG8_SB(0, 0), sB, vB); PG8_STAGE(PG8_SB(0, 1), sB + hB, vB); PG8_STAGE(PG8_SA(0, 0), sA, vA[0]);
            PG8_WAIT_V(8);
            if constexpr (Epi::DEFER_PUBLISH) { if (pend >= 0) { E.publish(pend, lane); pend = -1; } }
            PG8_WAIT_L(0); PG8_BAR; PG8_MMA(1, 0, At, B0); PG8_MMA(1, 1, At, B1); PG8_BAR; PG8_SCHED;
            PG8_LDB(B0, 1, 0); PG8_LDB(B1, 1, 1); PG8_SCHED; PG8_LDA(At, 1, 0); PG8_STAGE(PG8_SA(0, 1), sA, vA[1]);
            PG8_WAIT_V(8); PG8_WAIT_L(0); PG8_BAR; PG8_MMA(0, 0, At, B0); PG8_MMA(0, 1, At, B1); PG8_BAR; PG8_SCHED;
            PG8_LDA(At, 1, 1); PG8_STAGE(PG8_SB(1, 0), sB + 128, vB); PG8_STAGE(PG8_SB(1, 1), sB + hB + 128, vB); PG8_STAGE(PG8_SA(1, 0), sA + 128, vA[0]);
            PG8_WAIT_V(8); PG8_WAIT_L(0); PG8_BAR; PG8_MMA(1, 0, At, B0); PG8_MMA(1, 1, At, B1); PG8_BAR; PG8_SCHED;
            sA += 256; sB += 256;
        }
        if constexpr (ALIGN_EPI) { if (wr == 0) PG8_BAR; }
        if constexpr (!Epi::AFTER_DRAIN) { E(acc, cur, wr, wc, fr, fq); }
        if constexpr (Epi::DEFER_PUBLISH) { if (E.wants_publish(cur)) pend = cur.pm; }
        if (!has_next) break;
        if (nxt.zero) {
#pragma unroll
            for (int a = 0; a < 2; ++a)
#pragma unroll
                for (int b = 0; b < 2; ++b)
#pragma unroll
                    for (int m = 0; m < 4; ++m)
#pragma unroll
                        for (int n = 0; n < 2; ++n) acc[a][b][m][n] = (f32x4){0.f, 0.f, 0.f, 0.f};
        }
        cur = nxt; ++ui;
        if constexpr (ALIGN_EPI) { if (wr == 1) PG8_BAR; }
    }
    PG8_WAIT_V(0);
    if constexpr (Epi::DEFER_PUBLISH) { if (pend >= 0) { E.publish(pend, lane); pend = -1; } }
    if constexpr (!ALIGN_EPI) { if (wr == 0) PG8_BAR; }
    PG8_BAR;
    if constexpr (Epi::AFTER_DRAIN) { E.fused(acc, cur, wr, wc, fr, fq, lds, wid, lane); }
#undef PG8_SA
#undef PG8_SB
#undef PG8_STAGE
#undef PG8_LDA
#undef PG8_LDB
#undef PG8_MMA
#undef PG8_WAIT_V
#undef PG8_WAIT_L
#undef PG8_BAR
#undef PG8_SCHED
#undef PG8_SETV
}
}

#define XB_TMO      128
#define XB_XCNT(j)  (256  + 64 * (j))
#define XB_XSUB(j)  (1280 + 64 * (j))
#define XB_XGEN(j)  (2304 + 64 * (j))
#define XB_TOP      3328
#define XB_TOPGEN   3392
#define XCD_BAR_WORDS 3456
#define XB_SPIN_CAP (1u << 18)
__device__ __forceinline__ unsigned xb_ld(unsigned* p)              { return __hip_atomic_load(p, __ATOMIC_RELAXED, __HIP_MEMORY_SCOPE_AGENT); }
__device__ __forceinline__ unsigned xb_add(unsigned* p, unsigned v) { return __hip_atomic_fetch_add(p, v, __ATOMIC_RELAXED, __HIP_MEMORY_SCOPE_AGENT); }
__device__ __forceinline__ unsigned xb_xcc_id() { return (unsigned)__builtin_amdgcn_s_getreg((3 << 11) | 20) & 0xFu; }
#define XB_SPIN(cond, bar) do { unsigned _sp = 0; while (cond) { __builtin_amdgcn_s_sleep(1); \
    if ((++_sp & 255u) == 0u) { if (xb_ld(&(bar)[XB_TMO])) break; if (_sp > XB_SPIN_CAP) { atomicAdd(&(bar)[XB_TMO], 1u); break; } } } } while (0)
struct XcdBarrier { unsigned* bar; unsigned x; volatile LAS unsigned* st; };
__device__ __forceinline__ XcdBarrier xcd_barrier_post(unsigned* bar, volatile LAS unsigned* st) {
    XcdBarrier b; b.bar = bar; b.x = xb_xcc_id(); b.st = st;
    if (threadIdx.x == 0) (void)xb_add(&bar[XB_XCNT(b.x)], 1u);
    return b;
}
__device__ __forceinline__ void xcd_barrier_complete(unsigned* bar, unsigned x, unsigned& nloc, unsigned& nx) {
    const unsigned G = gridDim.x * gridDim.y * gridDim.z;
    unsigned sum, cnt, mine, sp = 0u;
    for (;;) {
        sum = 0u; cnt = 0u; mine = 0u;
#pragma unroll
        for (unsigned j = 0; j < 16; ++j) { const unsigned c = xb_ld(&bar[XB_XCNT(j)]); sum += c; cnt += (c > 0u) ? 1u : 0u; mine = (j == x) ? c : mine; }
        if (sum == G) break;
        __builtin_amdgcn_s_sleep(1);
        if ((++sp & 255u) == 0u) { if (xb_ld(&bar[XB_TMO])) break; if (sp > XB_SPIN_CAP) { atomicAdd(&bar[XB_TMO], 1u); break; } }
    }
    nloc = mine > 0u ? mine : 1u; nx = cnt > 0u ? cnt : 1u;
}
__device__ __forceinline__ void xcd_barrier(const XcdBarrier& b) {
    asm volatile("s_waitcnt vmcnt(0)" ::: "memory");
    __syncthreads();
    if (threadIdx.x == 0) {
        unsigned* bar = b.bar;
        __builtin_amdgcn_s_waitcnt(0);
        unsigned nloc = b.st[0], nx = b.st[1];
        if (nloc == 0u) { xcd_barrier_complete(bar, b.x, nloc, nx); b.st[0] = nloc; b.st[1] = nx; }
        const unsigned old = xb_add(&bar[XB_XSUB(b.x)], 1u);
        const unsigned gen = old / nloc;
        if (old + 1u == (gen + 1u) * nloc) {
            __builtin_amdgcn_fence(__ATOMIC_RELEASE, "agent");
            asm volatile("s_waitcnt vmcnt(0)" ::: "memory");
            const unsigned og = xb_add(&bar[XB_TOP], 1u);
            const unsigned tg = og / nx;
            if (og + 1u == (tg + 1u) * nx) xb_add(&bar[XB_TOPGEN], 1u);
            else XB_SPIN(xb_ld(&bar[XB_TOPGEN]) == tg, bar);
            __builtin_amdgcn_fence(__ATOMIC_ACQUIRE, "agent");
            xb_add(&bar[XB_XGEN(b.x)], 1u);
            asm volatile("s_waitcnt vmcnt(0)" ::: "memory");
        } else {
            XB_SPIN(xb_ld(&bar[XB_XGEN(b.x)]) == gen, bar);
            __builtin_amdgcn_fence(__ATOMIC_ACQUIRE, "agent");
            asm volatile("s_waitcnt vmcnt(0)" ::: "memory");
        }
    }
    __syncthreads();
}

struct Frame {
    LAS unsigned char* lds;
    unsigned* ctl;
    int tid, lane, wave, vcu, G, bx;
    int bg_done;
    const float *x, *c, *w_ada, *b_ada, *g_mix, *w_in, *sink, *w_a, *w_b, *w_out, *g_ffn, *w_group, *b_group, *w_route, *b_route, *w_gate, *w_up, *w_down, *g_final;
    const int* positions;
    float* out;
    float *mod, *rcos, *rsin, *wts;
    int* list;
    bf16 *WrT, *WaT, *WbT, *WoT, *WinT, *GUT, *DT, *H, *OA, *OB, *QA, *KA, *VAT, *QB, *KB, *VBT, *MERGED, *ACT, *Y, *X1;
    unsigned char *SGA, *SGB;
};

__device__ const double INVF[32] = {1, 0.74989420933245587, 0.56234132519034907, 0.42169650342858223, 0.31622776601683794, 0.23713737056616552, 0.17782794100389229, 0.1333521432163324,
    0.10000000000000001, 0.074989420933245579, 0.056234132519034911, 0.042169650342858224, 0.031622776601683791, 0.023713737056616554, 0.017782794100389229, 0.013335214321633241,
    0.01, 0.0074989420933245579, 0.005623413251903491, 0.0042169650342858229, 0.0031622776601683794, 0.0023713737056616554, 0.0017782794100389228, 0.0013335214321633241,
    0.001, 0.00074989420933245586, 0.0005623413251903491, 0.00042169650342858224, 0.00031622776601683794, 0.00023713737056616554, 0.00017782794100389227, 0.0001333521432163324};

template <int KIND> __device__ __forceinline__ int rowmap(int n) {
    if (KIND == 0) return n;
    if (KIND == 1) { const bool rp = (n < 1536) || (n >= 2304 && n < 2944); if (!rp) return n; const int j = n & 63; return (n & ~63) + (((j & 31) >> 2) << 3) + ((j >> 5) << 2) + (j & 3); }
    if (KIND == 2) return ((n >> 7) << 8) + (n & 127);
    return ((n >> 7) << 8) + 128 + (n & 127);
}
template <int KIND> __device__ __forceinline__ void transpose_item(const float* W, int K, int N, bf16* WT, int item, int lane) {
    const int nblk = N >> 5, kb = item / nblk, nb = item - kb * nblk, k0 = 64 * kb + 8 * (lane >> 3), n0 = 32 * nb + 4 * (lane & 7);
    f32x4 v[8];
#pragma unroll
    for (int j = 0; j < 8; ++j) v[j] = __builtin_nontemporal_load((const f32x4*)(W + (size_t)(k0 + j) * N + n0));
#pragma unroll
    for (int i = 0; i < 4; ++i) { u32x4 o; o.x = cvtpk(v[0][i], v[1][i]); o.y = cvtpk(v[2][i], v[3][i]); o.z = cvtpk(v[4][i], v[5][i]); o.w = cvtpk(v[6][i], v[7][i]);
        __builtin_nontemporal_store(o, (u32x4*)(WT + (size_t)rowmap<KIND>(n0 + i) * K + k0)); }
}


constexpr int EXP_ITEMS = NEXP * 3 * 256;
#ifndef BGW
#define BGW 3
#endif
#ifndef EXP_DEFER
#define EXP_DEFER 3072
#endif
struct FillRegs { f32x4 a, b, c, d, e, f, g, h; };
__device__ __forceinline__ void expert_item(const float* wg, const float* wu, const float* wd, bf16* gut, bf16* dt, int r, int lane) {
    const int e = r / 768, q = r - e * 768, kind = q >> 8, item = q & 255;
    const float* W = (kind == 0 ? wg : (kind == 1 ? wu : wd)) + (size_t)e * DM * DEXP;
    const int N = kind == 2 ? DM : DEXP, K = kind == 2 ? DEXP : DM, nblk = N >> 5, kb = item / nblk, nb = item - kb * nblk, k0 = 64 * kb + 8 * (lane >> 3), n0 = 32 * nb + 4 * (lane & 7);
    const f32x4* p = (const f32x4*)(W + (size_t)k0 * N + n0); const size_t st = (size_t)(N >> 2);
    FillRegs v;
    v.a = __builtin_nontemporal_load(p); v.b = __builtin_nontemporal_load(p + st); v.c = __builtin_nontemporal_load(p + 2 * st); v.d = __builtin_nontemporal_load(p + 3 * st);
    v.e = __builtin_nontemporal_load(p + 4 * st); v.f = __builtin_nontemporal_load(p + 5 * st); v.g = __builtin_nontemporal_load(p + 6 * st); v.h = __builtin_nontemporal_load(p + 7 * st);
    bf16* WT = kind == 2 ? dt + (size_t)e * 1024 * 512 : gut + (size_t)e * 1024 * 1024;
#pragma unroll
    for (int i = 0; i < 4; ++i) { u32x4 o; o.x = cvtpk(v.a[i], v.b[i]); o.y = cvtpk(v.c[i], v.d[i]); o.z = cvtpk(v.e[i], v.f[i]); o.w = cvtpk(v.g[i], v.h[i]);
        const int n = n0 + i, row = kind == 2 ? n : (((n >> 7) << 8) + 128 * kind + (n & 127));
        __builtin_nontemporal_store(o, (u32x4*)(WT + (size_t)row * K + k0)); }
}

__device__ __forceinline__ bool bg_step(Frame& F) {
    if (F.bg_done) return false;
    volatile LAS unsigned* bgk = (volatile LAS unsigned*)(F.lds + MISC_OFF + 128);
    int k = 0; if (F.lane == 0) k = (int)__hip_atomic_fetch_add((LAS unsigned*)bgk, 1u, __ATOMIC_RELAXED, __HIP_MEMORY_SCOPE_WORKGROUP);
    k = __builtin_amdgcn_readfirstlane(k);
    const int r = EXP_DEFER + F.vcu + k * F.G;
    if (r >= EXP_ITEMS) { F.bg_done = 1; return false; }
    expert_item(F.w_gate, F.w_up, F.w_down, F.GUT, F.DT, r, F.lane); return true;
}
__device__ __forceinline__ void xcd_barrier_bg(const XcdBarrier& b, Frame& F, volatile LAS unsigned* relw, unsigned epoch) {
    asm volatile("s_waitcnt vmcnt(0)" ::: "memory");
    __syncthreads();
    if (threadIdx.x < 64) {
        if (threadIdx.x == 0) {
            unsigned* bar = b.bar;
            __builtin_amdgcn_s_waitcnt(0);
            unsigned nloc = b.st[0], nx = b.st[1];
            if (nloc == 0u) { xcd_barrier_complete(bar, b.x, nloc, nx); b.st[0] = nloc; b.st[1] = nx; }
            const unsigned old = xb_add(&bar[XB_XSUB(b.x)], 1u);
            const unsigned gen = old / nloc;
            if (old + 1u == (gen + 1u) * nloc) {
                __builtin_amdgcn_fence(__ATOMIC_RELEASE, "agent");
                asm volatile("s_waitcnt vmcnt(0)" ::: "memory");
                const unsigned og = xb_add(&bar[XB_TOP], 1u);
                const unsigned tg = og / nx;
                if (og + 1u == (tg + 1u) * nx) xb_add(&bar[XB_TOPGEN], 1u);
                else XB_SPIN(xb_ld(&bar[XB_TOPGEN]) == tg, bar);
                relw[1] = epoch;
                __builtin_amdgcn_fence(__ATOMIC_ACQUIRE, "agent");
                xb_add(&bar[XB_XGEN(b.x)], 1u);
                asm volatile("s_waitcnt vmcnt(0)" ::: "memory");
            } else {
                XB_SPIN(xb_ld(&bar[XB_XGEN(b.x)]) == gen, bar);
                relw[1] = epoch;
                __builtin_amdgcn_fence(__ATOMIC_ACQUIRE, "agent");
                asm volatile("s_waitcnt vmcnt(0)" ::: "memory");
            }
            relw[0] = epoch;
        }
    } else {
        while (relw[0] != epoch) { if (F.wave > BGW || relw[1] == epoch || !bg_step(F)) __builtin_amdgcn_s_sleep(2); }
    }
    asm volatile("s_waitcnt lgkmcnt(0)" ::: "memory"); __builtin_amdgcn_s_barrier(); asm volatile("" ::: "memory");
}

__device__ __forceinline__ void p0_prologue(Frame& F) {
    {
        LAS float* cs = (LAS float*)(F.lds);
        LAS float* red = (LAS float*)(F.lds + 16384);
        for (int item = F.vcu; item < NMOD / 32; item += F.G) {
            for (int i = F.tid; i < 4096; i += 512) { const float v = F.c[i]; cs[i] = v / (1.0f + __expf(-v)); }
            __syncthreads();
            const int kq = F.tid >> 3, cq = F.tid & 7, n0 = 32 * item + 4 * cq;
            f32x4 a[4];
#pragma unroll
            for (int b = 0; b < 4; ++b) a[b] = (f32x4){0.f, 0.f, 0.f, 0.f};
#pragma unroll 4
            for (int it = 0; it < 16; ++it) { const int k = kq + 64 * it; const f32x4 w = __builtin_nontemporal_load((const f32x4*)(F.w_ada + (size_t)k * NMOD + n0));
#pragma unroll
                for (int b = 0; b < 4; ++b) a[b] += cs[b * 1024 + k] * w; }
#pragma unroll
            for (int b = 0; b < 4; ++b) *(LAS f32x4*)(red + kq * 132 + b * 32 + cq * 4) = a[b];
            __syncthreads();
            if (F.tid < 128) { float s = 0.f; for (int q = 0; q < 64; ++q) s += red[q * 132 + F.tid];
                const int b = F.tid >> 5, col = 32 * item + (F.tid & 31); __hip_atomic_store(F.mod + b * NMOD + col, s + F.b_ada[col], RLX_AGENT); }
            VM_WAIT(); __syncthreads();
            if (F.tid == 0) __hip_atomic_fetch_add(F.ctl + CW_MODCNT, 1u, RLX_AGENT);
        }
    }
    {
        const int gw = F.vcu * 8 + F.wave, NGW = F.G * 8;
        constexpr int I_IN = 16 * 160, I_A = 4 * 32, I_B = 8 * 32, I_O = 16 * 32, I_E = 256;
        constexpr int NITEMS = I_IN + I_A + I_B + I_O + EXP_DEFER;
        for (int it = gw; it < NITEMS; it += NGW) {
            int r = it;
            if (r < I_IN) { transpose_item<1>(F.w_in, DM, NIN, F.WinT, r, F.lane); continue; } r -= I_IN;
            if (r < I_A) { transpose_item<0>(F.w_a, 256, DM, F.WaT, r, F.lane); continue; } r -= I_A;
            if (r < I_B) { transpose_item<0>(F.w_b, 512, DM, F.WbT, r, F.lane); continue; } r -= I_B;
            if (r < I_O) { transpose_item<0>(F.w_out, DM, DM, F.WoT, r, F.lane); continue; } r -= I_O;
            const int e = r / (3 * I_E), q = r - e * 3 * I_E;
            if (q < I_E) transpose_item<2>(F.w_gate + (size_t)e * DM * DEXP, DM, DEXP, F.GUT + (size_t)e * 1024 * 1024, q, F.lane);
            else if (q < 2 * I_E) transpose_item<3>(F.w_up + (size_t)e * DM * DEXP, DM, DEXP, F.GUT + (size_t)e * 1024 * 1024, q - I_E, F.lane);
            else transpose_item<0>(F.w_down + (size_t)e * DEXP * DM, DEXP, DM, F.DT + (size_t)e * 1024 * 512, q - 2 * I_E, F.lane);
        }
    }
    {
        const int gt = F.vcu * 512 + F.tid, NT = F.G * 512;
        for (int idx = gt; idx < MT * 32; idx += NT) { const int tok = idx >> 5, i = idx & 31;
            double rev = (double)F.positions[tok] * INVF[i] * 0.15915494309189535; rev -= __builtin_rint(rev);
            const float fr = (float)rev; F.rcos[idx] = __builtin_amdgcn_cosf(fr); F.rsin[idx] = __builtin_amdgcn_sinf(fr); }
        for (int idx = gt; idx < 256 * 1024; idx += NT) { const int n = idx >> 10, k = idx & 1023;
            const float v = n < 4 ? F.w_group[k * 4 + n] : (n < 36 ? F.w_route[k * 32 + (n - 4)] : 0.f);
            F.WrT[idx] = (bf16)(cvtpk(v, 0.f) & 0xffffu); }
    }
    if (F.tid == 0) {
        unsigned sp = 0; while (__hip_atomic_load(F.ctl + CW_MODCNT, RLX_AGENT) < (unsigned)(NMOD / 32)) { __builtin_amdgcn_s_sleep(2); if (++sp > (1u << 22)) break; }
        __builtin_amdgcn_fence(__ATOMIC_ACQUIRE, "agent"); VM_WAIT();
    }
    __syncthreads();
}

__device__ __forceinline__ void norm_rows(Frame& F, const float* src, const float* g, int sh_off, int sc_off, bf16* dst) {
    const int gw = F.vcu * 8 + F.wave, NGW = F.G * 8;
    for (int m0 = gw; m0 < MT; m0 += 4 * NGW) {
        f32x4 v[4][4]; float s[4];
#pragma unroll
        for (int q = 0; q < 4; ++q) { const int m = m0 + q * NGW; s[q] = 0.f;
            if (m < MT) { const f32x4* xr = (const f32x4*)(src + (size_t)m * DM) + F.lane;
#pragma unroll
                for (int j = 0; j < 4; ++j) v[q][j] = xr[64 * j]; } }
#pragma unroll
        for (int q = 0; q < 4; ++q) { const int m = m0 + q * NGW; if (m >= MT) continue;
#pragma unroll
            for (int j = 0; j < 4; ++j) s[q] += (v[q][j].x * v[q][j].x + v[q][j].y * v[q][j].y) + (v[q][j].z * v[q][j].z + v[q][j].w * v[q][j].w);
            const float rinv = 1.0f / sqrtf(wave_sum(s[q]) * (1.0f / DM) + RMS_EPS);
            const float* md = F.mod + (m >> 12) * NMOD;
#pragma unroll
            for (int j = 0; j < 4; ++j) { const int col = 4 * (F.lane + 64 * j);
                const f32x4 g4 = *(const f32x4*)(g + col), sc = *(const f32x4*)(md + sc_off + col), sh = *(const f32x4*)(md + sh_off + col);
                const f32x4 h = v[q][j] * rinv * g4 * (1.0f + sc) + sh;
                u32x2 o; o.x = cvtpk(h.x, h.y); o.y = cvtpk(h.z, h.w);
                *(u32x2*)(dst + (size_t)m * DM + col) = o; } }
    }
}

using pg8::GU;
struct SchedTiles {
    const char* A; const char* B; int lda, ldb, nt, nM, nN, G, c; int wg = 8;
    __device__ __forceinline__ bool next(int i, GU& u) const {
        int pm, pn; if (!pg8::static_tile(i, G, c, nM, nN, pm, pn, wg)) return false;
        u.A = A + (size_t)pm * 256 * lda; u.B = B + (size_t)pn * 256 * ldb; u.lda = lda; u.ldb = ldb; u.nt = nt; u.zero = 1; u.gslot = 0; u.pm = pm; u.pn = pn; u.aux = 0; u.eslot = 0; return true;
    }
    __device__ __forceinline__ void a_ready(const GU&) const {}
};
struct SchedBranch {
    const char* OA; const char* OB; const char* WaT; const char* WbT; int G, c;
    __device__ __forceinline__ bool next(int i, GU& u) const {
        int pm, pn; if (!pg8::static_tile(i >> 1, G, c, 64, 4, pm, pn)) return false;
        if ((i & 1) == 0) { u.A = OB + (size_t)pm * 256 * 1024; u.B = WbT + (size_t)pn * 256 * 1024; u.lda = 1024; u.ldb = 1024; u.nt = 8; u.zero = 1; u.aux = 0; }
        else { u.A = OA + (size_t)pm * 256 * 512; u.B = WaT + (size_t)pn * 256 * 512; u.lda = 512; u.ldb = 512; u.nt = 4; u.zero = 0; u.aux = 1; }
        u.gslot = 0; u.pm = pm; u.pn = pn; u.eslot = 0; return true;
    }
    __device__ __forceinline__ void a_ready(const GU&) const {}
};
__device__ __forceinline__ int moe_deal(int i, int c, int G, int n4) {
    const int q = n4 / G, r = n4 - q * G, n7 = q + (c < r ? 1 : 0);
    if (i < n7) return i * G + c;
    const int k = i - n7, Lc = G - r; int j;
    if (c >= r) j = k == 0 ? (c - r) : (k == 1 ? Lc + (c - r) : 2 * Lc + (k - 2) * G + c);
    else j = 2 * Lc + k * G + c;
    return j < n4 ? n4 + j : -1;
}
__device__ __forceinline__ void moe_map(int idx, int n4, int& rb, int& pn) {
    const int x = idx & 7, q = idx >> 3, nbh = ((n4 >> 2) + 1) >> 1;
    pn = x & 3; rb = (x >> 2) ? nbh + q : q;
}
struct SchedMoe {
    const char* H; const char* ACT; const char* GUT; const char* DT; const LAS int* rbtab; unsigned* cnt; int n4, n7, G, c;
    __device__ __forceinline__ bool next(int i, GU& u) const {
        const int t = moe_deal(i, c, G, n4); if (t < 0) return false;
        if (t < n4) { int rb, pn; moe_map(t, n4, rb, pn); const int e = rbtab[rb] >> 8;
            u.A = H; u.B = GUT + (size_t)e * (1024 * 2048) + (size_t)pn * 256 * 2048; u.lda = 2048; u.ldb = 2048; u.nt = 16; u.gslot = i; u.eslot = 0; u.pm = rb; u.pn = pn; u.aux = 0; }
        else { int rb, pn; moe_map(t - n4, n4, rb, pn); const int e = rbtab[rb] >> 8;
            u.A = ACT + (size_t)rb * 256 * 1024; u.B = DT + (size_t)e * (1024 * 1024) + (size_t)pn * 256 * 1024; u.lda = 1024; u.ldb = 1024; u.nt = 8; u.gslot = -1; u.eslot = i - n7; u.pm = rb; u.pn = pn; u.aux = 1; }
        u.zero = 1; return true;
    }
    __device__ __forceinline__ void a_ready(const GU& u) const {
        if (u.aux != 1) return;
        if (threadIdx.x < 64) {
            unsigned sp = 0;
            while ((unsigned)__builtin_amdgcn_readfirstlane(__hip_atomic_load(cnt + 64 * u.pm, RLX_AGENT)) < 32u) { __builtin_amdgcn_s_sleep(2); if (++sp > (1u << 20)) break; }
            __builtin_amdgcn_fence(__ATOMIC_ACQUIRE, "agent");
            asm volatile("s_waitcnt vmcnt(0)" ::: "memory");
        }
        asm volatile("" ::: "memory"); __builtin_amdgcn_s_barrier(); asm volatile("" ::: "memory");
    }
};

__device__ __forceinline__ int strided_row(int s, int sh) { return ((s & ((1 << sh) - 1)) << (12 - sh)) | (s >> sh); }

struct EpiIn {
    static constexpr bool PERM = true, AFTER_DRAIN = false, DEFER_PUBLISH = false;
    bf16 *QA, *KA, *VAT, *QB, *KB, *VBT; unsigned char *SGA, *SGB; const float *rcos, *rsin;
    __device__ __forceinline__ void operator()(f32x4 (&acc)[2][2][4][2], const GU& u, int wr, int wc, int fr, int fq) const {
        const int row0 = u.pm * 256 + wr * 64 + fr;
        if (u.pn >= 12) {
            unsigned char* base = (u.pn < 16 ? SGA : SGB) + (size_t)(u.pm * 4 + ((u.pn - 12) & 3)) * 65536 + (size_t)(((wr * 4 + wc) * 64 + fq * 16 + fr) * 16);
#pragma unroll
            for (int ai = 0; ai < 2; ++ai)
#pragma unroll
                for (int m = 0; m < 4; ++m) { u32x4 w;
#pragma unroll
                    for (int bj = 0; bj < 2; ++bj)
#pragma unroll
                        for (int n = 0; n < 2; ++n) { unsigned p = 0;
#pragma unroll
                            for (int j = 0; j < 4; ++j) p = __builtin_amdgcn_cvt_pk_u8_f32(fmaxf(fsigmoid(acc[ai][bj][m][n][j]) * 255.0f, 1.0f), j, p);
                            w[bj * 2 + n] = p; }
                    *(u32x4*)(base + (size_t)(ai * 4 + m) * 8192) = w; }
            return;
        }
#pragma unroll
        for (int bj = 0; bj < 2; ++bj) {
            const int blk = 2 * u.pn + bj;
            const int pc = 32 * (wc & 1) + 8 * fq;
            if (blk < 12 || (blk >= 18 && blk < 23)) {
                const bool isq = (blk < 6) || (blk >= 18 && blk < 22);
                const float sc = isq ? QSCALE : 1.0f;
                const int g4 = 4 * (pc >> 3);
                bf16* base; int hd, nh, sh;
                if (blk < 6) { base = QA; hd = 2 * blk + (wc >> 1); nh = 12; sh = 2 * (hd >> 2); }
                else if (blk < 12) { base = KA; hd = 2 * (blk - 6) + (wc >> 1); nh = 12; sh = 2 * (hd >> 2); }
                else if (blk < 22) { base = QB; hd = 2 * (blk - 18) + (wc >> 1); nh = 8; sh = 0; }
                else { base = KB; hd = (wc >> 1); nh = 2; sh = 0; }
                f32x4 cs[2][4], sn[2][4];
#pragma unroll
                for (int ai = 0; ai < 2; ++ai)
#pragma unroll
                    for (int m = 0; m < 4; ++m) { const size_t ro = (size_t)(row0 + ai * 128 + m * 16) * 32 + g4; cs[ai][m] = *(const f32x4*)(rcos + ro); sn[ai][m] = *(const f32x4*)(rsin + ro); }
#pragma unroll
                for (int ai = 0; ai < 2; ++ai)
#pragma unroll
                    for (int m = 0; m < 4; ++m) {
                        const int row = row0 + ai * 128 + m * 16, b = row >> 12, s = row & 4095;
                        const f32x4 x1 = acc[ai][bj][m][0], x2 = acc[ai][bj][m][1];
                        const f32x4 o1 = (x1 * cs[ai][m] - x2 * sn[ai][m]) * sc, o2 = (x2 * cs[ai][m] + x1 * sn[ai][m]) * sc;
                        u32x4 w; w.x = cvtpk(o1[0], o1[1]); w.y = cvtpk(o1[2], o1[3]); w.z = cvtpk(o2[0], o2[1]); w.w = cvtpk(o2[2], o2[3]);
                        const int srow = strided_row(s, sh), q8 = pc >> 3;
                        *(u32x4*)(base + ((size_t)(b * nh + hd) * 4096 + (srow & ~31)) * 64 + (q8 >> 1) * 512 + (32 * (q8 & 1) + (srow & 31)) * 8) = w;
                    }
            } else if (blk < 24) {
                bf16* base; int hd, nh, sh;
                if (blk < 18) { base = VAT; hd = 2 * (blk - 12) + (wc >> 1); nh = 12; sh = 2 * (hd >> 2); }
                else { base = VBT; hd = (wc >> 1); nh = 2; sh = 0; }
                if (sh == 4) {
#pragma unroll
                    for (int ai = 0; ai < 2; ++ai) {
                        const int row = row0 + ai * 128, b = row >> 12, s = row & 4095;
                        const int srow = strided_row(s, 4), kap = srow & 31;
                        bf16* p = base + ((size_t)(b * nh + hd) * 4096 + (srow & ~31)) * 64 + ((pc >> 5) * 2 + (kap >> 4)) * 512 + (32 * ((kap >> 2) & 1) + (pc & 31)) * 8 + 4 * ((kap >> 3) & 1);
#pragma unroll
                        for (int n = 0; n < 2; ++n)
#pragma unroll
                            for (int j = 0; j < 4; ++j) { u32x2 w; w.x = cvtpk(acc[ai][bj][0][n][j], acc[ai][bj][1][n][j]); w.y = cvtpk(acc[ai][bj][2][n][j], acc[ai][bj][3][n][j]);
                                *(u32x2*)(p + (4 * n + j) * 8) = w; }
                    }
                } else {
#pragma unroll
                for (int ai = 0; ai < 2; ++ai)
#pragma unroll
                    for (int m = 0; m < 4; ++m) {
                        const int row = row0 + ai * 128 + m * 16, b = row >> 12, s = row & 4095;
                        const int srow = strided_row(s, sh), kap = srow & 31;
                        bf16* p = base + ((size_t)(b * nh + hd) * 4096 + (srow & ~31)) * 64 + ((pc >> 5) * 2 + (kap >> 4)) * 512 + (32 * ((kap >> 2) & 1) + (pc & 31)) * 8 + 4 * ((kap >> 3) & 1) + (kap & 3);
                        const f32x4 v0 = acc[ai][bj][m][0], v1 = acc[ai][bj][m][1];
                        const unsigned a = cvtpk(v0[0], v0[1]), bb = cvtpk(v0[2], v0[3]), c = cvtpk(v1[0], v1[1]), d = cvtpk(v1[2], v1[3]);
                        p[0 * 8] = (bf16)(a & 0xffffu); p[1 * 8] = (bf16)(a >> 16); p[2 * 8] = (bf16)(bb & 0xffffu); p[3 * 8] = (bf16)(bb >> 16);
                        p[4 * 8] = (bf16)(c & 0xffffu); p[5 * 8] = (bf16)(c >> 16); p[6 * 8] = (bf16)(d & 0xffffu); p[7 * 8] = (bf16)(d >> 16);
                    }
                }
            }
        }
    }
};

struct EpiMerge {
    static constexpr bool PERM = true, AFTER_DRAIN = false, DEFER_PUBLISH = false;
    const unsigned char *SGA, *SGB; bf16* MERGED;
    __device__ __forceinline__ void operator()(f32x4 (&acc)[2][2][4][2], const GU& u, int wr, int wc, int fr, int fq) const {
        const int row0 = u.pm * 256 + wr * 64 + fr, col0 = u.pn * 256 + wc * 32 + 8 * fq;
        const size_t gbase = (size_t)(u.pm * 4 + u.pn) * 65536 + (size_t)(((wr * 4 + wc) * 64 + fq * 16 + fr) * 16);
#pragma unroll
        for (int ai = 0; ai < 2; ++ai)
#pragma unroll
            for (int m = 0; m < 4; ++m) {
                const u32x4 ga = *(const u32x4*)(SGA + gbase + (size_t)(ai * 4 + m) * 8192);
                if (u.aux == 0) {
                    const u32x4 gb = *(const u32x4*)(SGB + gbase + (size_t)(ai * 4 + m) * 8192);
#pragma unroll
                    for (int bj = 0; bj < 2; ++bj)
#pragma unroll
                        for (int n = 0; n < 2; ++n)
#pragma unroll
                            for (int j = 0; j < 4; ++j) acc[ai][bj][m][n][j] *= (float)((gb[bj * 2 + n] >> (8 * j)) & 255u) * frcp((float)((ga[bj * 2 + n] >> (8 * j)) & 255u));
                } else {
#pragma unroll
                    for (int bj = 0; bj < 2; ++bj) { f32x4 v0, v1;
#pragma unroll
                        for (int j = 0; j < 4; ++j) { v0[j] = acc[ai][bj][m][0][j] * ((float)((ga[bj * 2] >> (8 * j)) & 255u) * (1.0f / 255.0f)); v1[j] = acc[ai][bj][m][1][j] * ((float)((ga[bj * 2 + 1] >> (8 * j)) & 255u) * (1.0f / 255.0f)); }
                        u32x4 w; w.x = cvtpk(v0[0], v0[1]); w.y = cvtpk(v0[2], v0[3]); w.z = cvtpk(v1[0], v1[1]); w.w = cvtpk(v1[2], v1[3]);
                        *(u32x4*)(MERGED + (size_t)(row0 + ai * 128 + m * 16) * DM + col0 + bj * 128) = w; }
                }
            }
    }
};

struct EpiX1 {
    static constexpr bool PERM = true, AFTER_DRAIN = false, DEFER_PUBLISH = false;
    const float* x; const float* mod; bf16* X1;
    __device__ __forceinline__ void operator()(f32x4 (&acc)[2][2][4][2], const GU& u, int wr, int wc, int fr, int fq) const {
        const int row0 = u.pm * 256 + wr * 64 + fr, col0 = u.pn * 256 + wc * 32 + 8 * fq, b = (u.pm * 256) >> 12;
        const float* gt = mod + b * NMOD + 2 * DM;
#pragma unroll
        for (int bj = 0; bj < 2; ++bj) { const int col = col0 + bj * 128; const f32x4 g0 = *(const f32x4*)(gt + col), g1 = *(const f32x4*)(gt + col + 4);
#pragma unroll
            for (int ai = 0; ai < 2; ++ai)
#pragma unroll
                for (int m = 0; m < 4; ++m) { const size_t off = (size_t)(row0 + ai * 128 + m * 16) * DM + col;
                    const f32x4 v0 = __builtin_nontemporal_load((const f32x4*)(x + off)) + g0 * acc[ai][bj][m][0], v1 = __builtin_nontemporal_load((const f32x4*)(x + off + 4)) + g1 * acc[ai][bj][m][1];
                    u32x4 w; w.x = cvtpk(v0[0], v0[1]); w.y = cvtpk(v0[2], v0[3]); w.z = cvtpk(v1[0], v1[1]); w.w = cvtpk(v1[2], v1[3]);
                    *(u32x4*)(X1 + off) = w; } }
    }
};

struct EpiMoe {
    static constexpr bool PERM = true, AFTER_DRAIN = false, DEFER_PUBLISH = true;
    bf16* ACT; bf16* Y; const LAS int* dtab; const LAS float* wtab; unsigned* cnt;
    __device__ __forceinline__ bool wants_publish(const GU& u) const { return u.aux == 0; }
    __device__ __forceinline__ void publish(int rb, int lane) const { if (lane == 0) __hip_atomic_fetch_add(cnt + 64 * rb, 1u, RLX_AGENT); }
    __device__ __forceinline__ void operator()(f32x4 (&acc)[2][2][4][2], const GU& u, int wr, int wc, int fr, int fq) const {
        if (u.aux == 0) {
            const int row0 = u.pm * 256 + wr * 64 + fr, col0 = u.pn * 128 + wc * 32 + 8 * fq;
#pragma unroll
            for (int ai = 0; ai < 2; ++ai)
#pragma unroll
                for (int m = 0; m < 4; ++m) { f32x4 a0, a1;
#pragma unroll
                    for (int j = 0; j < 4; ++j) { const float g0 = acc[ai][0][m][0][j], g1 = acc[ai][0][m][1][j]; a0[j] = g0 * fsigmoid(g0) * acc[ai][1][m][0][j]; a1[j] = g1 * fsigmoid(g1) * acc[ai][1][m][1][j]; }
                    u32x4 w; w.x = cvtpk(a0[0], a0[1]); w.y = cvtpk(a0[2], a0[3]); w.z = cvtpk(a1[0], a1[1]); w.w = cvtpk(a1[2], a1[3]);
                    st16_sc1(ACT + (size_t)(row0 + ai * 128 + m * 16) * DEXP + col0, w); }
        } else {
            const int r0 = wr * 64 + fr, col0 = u.pn * 256 + wc * 32 + 8 * fq;
#pragma unroll
            for (int ai = 0; ai < 2; ++ai)
#pragma unroll
                for (int m = 0; m < 4; ++m) { const int r = r0 + ai * 128 + m * 16; const int dest = dtab[u.eslot * 256 + r]; const float w = wtab[u.eslot * 256 + r];
                    if (dest >= 0) {
#pragma unroll
                        for (int bj = 0; bj < 2; ++bj) { const f32x4 v0 = acc[ai][bj][m][0] * w, v1 = acc[ai][bj][m][1] * w;
                            u32x4 o; o.x = cvtpk(v0[0], v0[1]); o.y = cvtpk(v0[2], v0[3]); o.z = cvtpk(v1[0], v1[1]); o.w = cvtpk(v1[2], v1[3]);
                            *(u32x4*)(Y + (size_t)dest * DM + col0 + bj * 128) = o; } } }
        }
    }
};

#define MFMA32(a, b, c) __builtin_amdgcn_mfma_f32_32x32x16_bf16((a), (b), (c), 0, 0, 0)
__device__ __forceinline__ int crow(int reg, int h) { return (reg & 3) + 8 * (reg >> 2) + 4 * h; }
struct KVFrag { bf16x8 k[4], v[4]; };
#define GLD16(dst, ptr, OFF) asm volatile("global_load_dwordx4 %0, %1, off offset:" #OFF : "=v"(dst) : "v"(ptr) : "memory")
__device__ __forceinline__ void kv_load(KVFrag& f, const bf16* kp, const bf16* vp) {
    GLD16(f.k[0], kp, 0); GLD16(f.k[1], kp, 1024); GLD16(f.k[2], kp, 2048); GLD16(f.k[3], kp, 3072);
    GLD16(f.v[0], vp, 0); GLD16(f.v[1], vp, 1024); GLD16(f.v[2], vp, 2048); GLD16(f.v[3], vp, 3072);
}
#define KV_WAIT(f, N) asm volatile("s_waitcnt vmcnt(" #N ")" : "+v"(f.k[0]), "+v"(f.k[1]), "+v"(f.k[2]), "+v"(f.k[3]), "+v"(f.v[0]), "+v"(f.v[1]), "+v"(f.v[2]), "+v"(f.v[3]) :: "memory")
__device__ __forceinline__ void attn_tile(const KVFrag& f, const bf16x8 (&qf)[4], bool first, bool lastt, int r, int h, float& m, float& l, f32x16& o0, f32x16& o1) {
    f32x16 st;
#pragma unroll
    for (int e = 0; e < 16; ++e) st[e] = 0.f;
#pragma unroll
    for (int c = 0; c < 4; ++c) st = MFMA32(f.k[c], qf[c], st);
    if (first || lastt) {
        int rq = r - 4 * h; asm volatile("" : "+v"(rq));
        if (first) {
#pragma unroll
            for (int e = 0; e < 16; ++e) st[e] = ((e & 3) + 8 * (e >> 2) < rq) ? -1.0e30f : st[e];
        } else {
#pragma unroll
            for (int e = 0; e < 16; ++e) st[e] = ((e & 3) + 8 * (e >> 2) > rq) ? -1.0e30f : st[e];
        }
    }
    float tm = st[0];
#pragma unroll
    for (int e = 1; e < 16; ++e) tm = fmaxf(tm, st[e]);
    { auto rr = __builtin_amdgcn_permlane32_swap(__float_as_uint(tm), __float_as_uint(tm), false, false); tm = fmaxf(__uint_as_float(rr[0]), __uint_as_float(rr[1])); }
    const float mn = fmaxf(m, tm), alpha = fexp2(m - mn); m = mn;
    float ps = 0.f;
#pragma unroll
    for (int e = 0; e < 16; ++e) { st[e] = fexp2(st[e] - mn); ps += st[e]; }
    l = l * alpha + ps;
#pragma unroll
    for (int e = 0; e < 16; ++e) { o0[e] *= alpha; o1[e] *= alpha; }
    u32x4 pa, pb;
    pa.x = cvtpk(st[0], st[1]); pa.y = cvtpk(st[2], st[3]); pa.z = cvtpk(st[4], st[5]); pa.w = cvtpk(st[6], st[7]);
    pb.x = cvtpk(st[8], st[9]); pb.y = cvtpk(st[10], st[11]); pb.z = cvtpk(st[12], st[13]); pb.w = cvtpk(st[14], st[15]);
    const bf16x8 p0 = __builtin_bit_cast(bf16x8, pa), p1 = __builtin_bit_cast(bf16x8, pb);
    o0 = MFMA32(f.v[0], p0, o0); o0 = MFMA32(f.v[1], p1, o0);
    o1 = MFMA32(f.v[2], p0, o1); o1 = MFMA32(f.v[3], p1, o1);
}
template <int W>
__device__ __forceinline__ void attn_job(const bf16* __restrict__ Qp, const bf16* __restrict__ Kp, const bf16* __restrict__ Vp, int L, int t0, float m0, float l0,
                                         f32x16& o0, f32x16& o1, float& m_out, float& l_out, int lane) {
    constexpr int NT = 2 * W / 32 + 1;
    const int r = lane & 31, h = lane >> 5;
    bf16x8 qf[4];
    { const bf16* qp = Qp + (size_t)(t0 >> 5) * 2048 + lane * 8; GLD16(qf[0], qp, 0); GLD16(qf[1], qp, 1024); GLD16(qf[2], qp, 2048); GLD16(qf[3], qp, 3072); }
    float m = m0, l = (h == 0) ? l0 : 0.f;
#pragma unroll
    for (int i = 0; i < 16; ++i) { o0[i] = 0.f; o1[i] = 0.f; }
    const int i_lo = (W - t0) > 0 ? ((W - t0) >> 5) : 0, i_hi = ((L - t0 + W) >> 5) < NT ? ((L - t0 + W) >> 5) : NT;
    const bf16* kq = Kp + lane * 8; const bf16* vq = Vp + lane * 8;
#define TILE_OFF(ii) ((size_t)((t0 - W + 32 * ((ii) < i_hi ? (ii) : i_hi - 1)) >> 5) * 2048)
    KVFrag fa, fb;
    int i = i_lo;
    kv_load(fa, kq + TILE_OFF(i), vq + TILE_OFF(i));
#pragma unroll 1
    for (;;) {
        kv_load(fb, kq + TILE_OFF(i + 1), vq + TILE_OFF(i + 1));
        KV_WAIT(fa, 8); asm volatile("" : "+v"(qf[0]), "+v"(qf[1]), "+v"(qf[2]), "+v"(qf[3]));
        attn_tile(fa, qf, i == 0, i == NT - 1, r, h, m, l, o0, o1);
        if (++i >= i_hi) break;
        kv_load(fa, kq + TILE_OFF(i + 1), vq + TILE_OFF(i + 1));
        KV_WAIT(fb, 8);
        attn_tile(fb, qf, i == 0, i == NT - 1, r, h, m, l, o0, o1);
        if (++i >= i_hi) break;
    }
    KV_WAIT(fa, 0); KV_WAIT(fb, 0);
#undef TILE_OFF
    l += __shfl_xor(l, 32);
    m_out = m; l_out = l;
}

constexpr int PSTRIDE = 136;
__device__ __forceinline__ void attn_phase(Frame& F) {
    LAS unsigned char* P = F.lds;
    LAS f32x2* ML = (LAS f32x2*)(F.lds + 3 * 256 * PSTRIDE);
    const int lane = F.lane, r = lane & 31, h = lane >> 5;
    for (int uidx = F.vcu; uidx < 512; uidx += F.G) {
        if (uidx < 256) {
            const int b = uidx >> 6, hs = (uidx >> 4) & 3, c = uidx & 15;
#pragma unroll 1
            for (int jj = 0; jj < 4; ++jj) {
                const int j = F.wave + 8 * jj;
                int g, head, res, t0, L, slot; bool valid = true;
                if (j < 8) { g = 0; head = hs; res = 0; t0 = 256 * c + 32 * j; L = 4096; slot = 32 * j + r; }
                else if (j < 16) { const int q = j - 8; g = 1; head = 4 + hs; res = q >> 1; t0 = 64 * c + 32 * (q & 1); L = 1024; slot = res * 64 + 32 * (q & 1) + r; }
                else { const int q = j - 16; g = 2; head = 8 + hs; res = q; t0 = 32 * (c >> 1); L = 256; valid = (r >> 4) == (c & 1); slot = res * 16 + (r & 15); }
                const size_t hb = (size_t)(b * 12 + head);
                const bf16* Qp = F.QA + (hb * 4096 + (size_t)res * L) * 64;
                const bf16* Kp = F.KA + (hb * 4096 + (size_t)res * L) * 64;
                const bf16* Vt = F.VAT + (hb * 4096 + (size_t)res * L) * 64;
                f32x16 o0, o1; float m, l;
                attn_job<64>(Qp, Kp, Vt, L, t0, -1.0e30f, 0.f, o0, o1, m, l, lane);
                if (valid) {
                    LAS unsigned char* row = P + (g * 256 + slot) * PSTRIDE;
#pragma unroll
                    for (int q4 = 0; q4 < 4; ++q4) {
                        u32x2 w0, w1; w0.x = cvtpk(o0[4 * q4], o0[4 * q4 + 1]); w0.y = cvtpk(o0[4 * q4 + 2], o0[4 * q4 + 3]); w1.x = cvtpk(o1[4 * q4], o1[4 * q4 + 1]); w1.y = cvtpk(o1[4 * q4 + 2], o1[4 * q4 + 3]);
                        *(LAS u32x2*)(row + (8 * q4 + 4 * h) * 2) = w0; *(LAS u32x2*)(row + (32 + 8 * q4 + 4 * h) * 2) = w1; }
                    if (h == 0) ML[g * 256 + slot] = (f32x2){m, l};
                }
            }
            __syncthreads();
            {
                const int tau = F.tid >> 1, half = F.tid & 1;
                const int s0 = tau, s1 = 256 + (tau & 3) * 64 + (tau >> 2), s2 = 512 + (tau & 15) * 16 + (tau >> 4);
                const f32x2 a0 = ML[s0], a1 = ML[s1], a2 = ML[s2];
                const float M = fmaxf(a0.x, fmaxf(a1.x, a2.x));
                float w0 = fexp2(a0.x - M), w1 = fexp2(a1.x - M), w2 = fexp2(a2.x - M);
                const float inv = 1.0f / (w0 * a0.y + w1 * a1.y + w2 * a2.y); w0 *= inv; w1 *= inv; w2 *= inv;
                bf16* dst = F.OA + (size_t)(b * 4096 + 256 * c + tau) * 256 + hs * 64 + 32 * half;
#pragma unroll
                for (int q = 0; q < 4; ++q) {
                    const u32x4 x0 = *(const LAS u32x4*)(P + s0 * PSTRIDE + (32 * half + 8 * q) * 2), x1 = *(const LAS u32x4*)(P + s1 * PSTRIDE + (32 * half + 8 * q) * 2), x2 = *(const LAS u32x4*)(P + s2 * PSTRIDE + (32 * half + 8 * q) * 2);
                    u32x4 o;
#pragma unroll
                    for (int k = 0; k < 4; ++k) { const float lo = w0 * bflo(x0[k]) + w1 * bflo(x1[k]) + w2 * bflo(x2[k]), hi = w0 * bfhi(x0[k]) + w1 * bfhi(x1[k]) + w2 * bfhi(x2[k]); o[k] = cvtpk(lo, hi); }
                    *(u32x4*)(dst + 8 * q) = o; }
            }
            __syncthreads();
        } else {
            const int uu = uidx - 256, b = uu >> 6, kvh = (uu >> 5) & 1, qb = uu & 31, T0 = 4 * qb - 4;
            const bf16* Kb_ = F.KB + (size_t)(b * 2 + kvh) * 4096 * 64; const bf16* Vb_ = F.VBT + (size_t)(b * 2 + kvh) * 4096 * 64;
            for (int x = F.wave; x < 24; x += 8) { const int j = x >> 1, kv = x & 1, T = T0 + j; if (T < 0 || T > 127) continue;
                const bf16* src = (kv ? Vb_ : Kb_) + (size_t)T * 2048 + lane * 8;
#pragma unroll
                for (int c = 0; c < 4; ++c) __builtin_amdgcn_global_load_lds((const unsigned*)(src + c * 512), (LAS unsigned*)(F.lds + j * 8192 + kv * 4096 + c * 1024), 16, 0, 0); }
            VM_WAIT(); __syncthreads();
#pragma unroll 1
            for (int jj = 0; jj < 2; ++jj) {
                const int j = F.wave + 8 * jj, head = kvh * 4 + (j >> 2), qt = j & 3, t0 = 128 * qb + 32 * qt;
                const bf16* Qp = F.QB + (size_t)(b * 8 + head) * 4096 * 64 + (size_t)(t0 >> 5) * 2048 + lane * 8;
                bf16x8 qf[4];
#pragma unroll
                for (int c = 0; c < 4; ++c) qf[c] = *(const bf16x8*)(Qp + c * 512);
                float m = F.sink[head] * LOG2E, l = (h == 0) ? 1.0f : 0.f;
                f32x16 o0, o1;
#pragma unroll
                for (int e = 0; e < 16; ++e) { o0[e] = 0.f; o1[e] = 0.f; }
#pragma unroll 1
                for (int i = 0; i < 9; ++i) { const int T = T0 + qt + i; if (T < 0 || T > 127) continue;
                    const LAS unsigned char* tp = F.lds + (qt + i) * 8192 + lane * 16;
                    KVFrag f;
#pragma unroll
                    for (int c = 0; c < 4; ++c) { f.k[c] = *(const LAS bf16x8*)(tp + c * 1024); f.v[c] = *(const LAS bf16x8*)(tp + 4096 + c * 1024); }
                    attn_tile(f, qf, i == 0, i == 8, r, h, m, l, o0, o1); }
                l += __shfl_xor(l, 32);
                const float inv = 1.0f / l;
                bf16* dst = F.OB + (size_t)(b * 4096 + t0 + r) * 512 + head * 64;
#pragma unroll
                for (int q4 = 0; q4 < 4; ++q4) {
                    u32x2 w0, w1; w0.x = cvtpk(o0[4 * q4] * inv, o0[4 * q4 + 1] * inv); w0.y = cvtpk(o0[4 * q4 + 2] * inv, o0[4 * q4 + 3] * inv);
                    w1.x = cvtpk(o1[4 * q4] * inv, o1[4 * q4 + 1] * inv); w1.y = cvtpk(o1[4 * q4 + 2] * inv, o1[4 * q4 + 3] * inv);
                    *(u32x2*)(dst + 8 * q4 + 4 * h) = w0; *(u32x2*)(dst + 32 + 8 * q4 + 4 * h) = w1; }
            }
            __syncthreads();
        }
    }
}

__device__ __forceinline__ void norm_route_phase(Frame& F, int bank) {
    LAS unsigned char* A = F.lds;
    const int lane = F.lane, w = F.wave;
    for (int u = F.vcu; u < MT / 64; u += F.G) {
        {
            u32x4 xv[8][2];
#pragma unroll
            for (int q = 0; q < 8; ++q) { const u32x4* xr = (const u32x4*)(F.X1 + (size_t)(64 * u + 8 * w + q) * DM) + lane; xv[q][0] = xr[0]; xv[q][1] = xr[64]; }
            f32x4 gg[2][2], sc[2][2], sh[2][2];
            const float* md = F.mod + ((64 * u) >> 12) * NMOD;
#pragma unroll
            for (int j = 0; j < 2; ++j)
#pragma unroll
                for (int hh = 0; hh < 2; ++hh) { const int col = 8 * (lane + 64 * j) + 4 * hh; gg[j][hh] = *(const f32x4*)(F.g_ffn + col); sc[j][hh] = *(const f32x4*)(md + 4 * DM + col) + 1.0f; sh[j][hh] = *(const f32x4*)(md + 3 * DM + col); }
#pragma unroll
            for (int q = 0; q < 8; ++q) {
                const int rl = 8 * w + q, m = 64 * u + rl; float ss = 0.f; f32x4 f[2][2];
#pragma unroll
                for (int j = 0; j < 2; ++j) { f[j][0] = (f32x4){bflo(xv[q][j].x), bfhi(xv[q][j].x), bflo(xv[q][j].y), bfhi(xv[q][j].y)}; f[j][1] = (f32x4){bflo(xv[q][j].z), bfhi(xv[q][j].z), bflo(xv[q][j].w), bfhi(xv[q][j].w)};
#pragma unroll
                    for (int hh = 0; hh < 2; ++hh) ss += (f[j][hh].x * f[j][hh].x + f[j][hh].y * f[j][hh].y) + (f[j][hh].z * f[j][hh].z + f[j][hh].w * f[j][hh].w); }
                const float rinv = 1.0f / sqrtf(wave_sum(ss) * (1.0f / DM) + RMS_EPS);
#pragma unroll
                for (int j = 0; j < 2; ++j) { const int col = 8 * (lane + 64 * j);
                    const f32x4 h0 = f[j][0] * rinv * gg[j][0] * sc[j][0] + sh[j][0], h1 = f[j][1] * rinv * gg[j][1] * sc[j][1] + sh[j][1];
                    u32x4 o; o.x = cvtpk(h0.x, h0.y); o.y = cvtpk(h0.z, h0.w); o.z = cvtpk(h1.x, h1.y); o.w = cvtpk(h1.z, h1.w);
                    *(u32x4*)(F.H + (size_t)m * DM + col) = o;
                    *(LAS u32x4*)(A + rl * 2048 + ((((col >> 3) ^ (rl & 15))) << 4)) = o; }
            }
        }
        __syncthreads();
        const int rt = w & 1, ct = (w >> 1) & 1, kq = w >> 2, r = lane & 31, h = lane >> 5;
        f32x16 acc;
#pragma unroll
        for (int e = 0; e < 16; ++e) acc[e] = 0.f;
        {
            const bf16* bp = F.WrT + (size_t)(32 * ct + r) * DM + 512 * kq + 8 * h;
            const int arow = 32 * rt + r;
            const LAS unsigned char* ap = A + arow * 2048;
#pragma unroll 8
            for (int ks = 0; ks < 32; ++ks) {
                const bf16x8 bf = *(const bf16x8*)(bp + 16 * ks);
                const int chunk = 64 * kq + 2 * ks + h;
                const bf16x8 af = *(const LAS bf16x8*)(ap + ((chunk ^ (arow & 15)) << 4));
                acc = MFMA32(af, bf, acc);
            }
        }
        __syncthreads();
        LAS float* P = (LAS float*)F.lds;
        LAS int* lcnt = (LAS int*)(F.lds + 2 * 64 * 68 * 4);
#pragma unroll
        for (int e = 0; e < 16; ++e) P[(kq * 64 + 32 * rt + crow(e, h)) * 68 + 32 * ct + r] = acc[e];
        if (F.tid < 64) lcnt[F.tid] = 0;
        __syncthreads();
        int e1 = 0, e2 = 0, p1 = 0, p2 = 0; float w1 = 0.f, w2 = 0.f;
        if (F.tid < 64) {
            const LAS float* q0 = P + F.tid * 68; const LAS float* q1 = P + (64 + F.tid) * 68;
            float gl[4]; float gmax = -3.0e38f; int gs = 0;
#pragma unroll
            for (int j = 0; j < 4; ++j) { gl[j] = q0[j] + q1[j] + F.b_group[j]; if (gl[j] > gmax) { gmax = gl[j]; gs = j; } }
            float gz = 0.f;
#pragma unroll
            for (int j = 0; j < 4; ++j) gz += __expf(gl[j] - gmax);
            const float gw = 1.0f / gz;
            float el[8]; float m1 = -3.0e38f; int i1 = 0;
#pragma unroll
            for (int j = 0; j < 8; ++j) { el[j] = q0[4 + 8 * gs + j] + q1[4 + 8 * gs + j] + F.b_route[8 * gs + j]; if (el[j] > m1) { m1 = el[j]; i1 = j; } }
            float m2 = -3.0e38f; int i2 = 0;
#pragma unroll
            for (int j = 0; j < 8; ++j) { if (j != i1 && el[j] > m2) { m2 = el[j]; i2 = j; } }
            const float q2 = __expf(m2 - m1), inv = 1.0f / (1.0f + q2);
            w1 = inv * gw; w2 = q2 * inv * gw; e1 = 8 * gs + i1; e2 = 8 * gs + i2;
            p1 = atomicAdd((int*)(lcnt + e1), 1); p2 = atomicAdd((int*)(lcnt + e2), 1);
        } else if (F.wave >= 1) bg_step(F);
        __syncthreads();
        const int shard = F.bx & 7;
        if (F.tid < 32) { const int c = lcnt[F.tid]; lcnt[32 + F.tid] = c ? (int)__hip_atomic_fetch_add(F.ctl + CW_CNT + bank * 49152 + 64 * (32 * shard + F.tid), (unsigned)c, RLX_AGENT) : 0; }
        __syncthreads();
        if (F.tid < 64) {
            const int tok = 64 * u + F.tid;
            F.list[(bank << 20) + ((32 * shard + e1) << 12) + lcnt[32 + e1] + p1] = 2 * tok; F.wts[2 * tok] = w1;
            F.list[(bank << 20) + ((32 * shard + e2) << 12) + lcnt[32 + e2] + p2] = 2 * tok + 1; F.wts[2 * tok + 1] = w2;
        }
        __syncthreads();
    }
}

__device__ __forceinline__ void moe_setup(Frame& F, int& n4_out, int& n7_out) {
    LAS int* rbtab = (LAS int*)(F.lds + TAB_RB); LAS int* cnttab = (LAS int*)(F.lds + TAB_CNT); LAS int* nbw = (LAS int*)(F.lds + TAB_NB);
    LAS int* gidx = (LAS int*)(F.lds + TAB_GIDX); LAS int* dtab = (LAS int*)(F.lds + TAB_D); LAS float* wtab = (LAS float*)(F.lds + TAB_W);
    LAS int* pref = (LAS int*)(F.lds + TAB_PREF);
    if (F.tid < 256) pref[(F.tid & 31) * 8 + (F.tid >> 5)] = (int)__hip_atomic_load(F.ctl + CW_CNT + 64 * F.tid, RLX_AGENT);
    __syncthreads();
    if (F.tid < 64) {
        int cnt = 0;
        if (F.tid < 32) { for (int sh = 0; sh < 8; ++sh) { const int c = pref[F.tid * 8 + sh]; pref[F.tid * 8 + sh] = cnt; cnt += c; } }
        const int nb = (cnt + 255) >> 8; int incl = nb;
#pragma unroll
        for (int o = 1; o < 32; o <<= 1) { const int t = __shfl_up(incl, o); if (F.lane >= o) incl += t; }
        if (F.tid < 32) { cnttab[F.tid] = cnt; const int st = incl - nb; for (int j = 0; j < nb; ++j) rbtab[st + j] = (F.tid << 8) | j; }
        if (F.tid == 31) nbw[0] = incl;
    }
    __syncthreads();
    const int n4 = 4 * nbw[0];
    const int n7 = n4 / F.G + (F.bx < n4 % F.G ? 1 : 0);
    for (int i = 0; i < 7; ++i) { const int t = moe_deal(i, F.bx, F.G, n4); if (t < 0) break;
        const bool down = t >= n4; int rb, pnx; moe_map(down ? t - n4 : t, n4, rb, pnx); const int slot = down ? i - n7 : i;
        if (slot < 3 && F.tid < 256) { const int v = rbtab[rb], e = v >> 8, j = v & 255; const int nvalid = cnttab[e] - 256 * j;
            int val = -1;
            if (F.tid < nvalid) { const int q = 256 * j + F.tid; int sh = 0;
#pragma unroll
                for (int k = 1; k < 8; ++k) sh += (pref[e * 8 + k] <= q) ? 1 : 0;
                val = F.list[((32 * sh + e) << 12) + q - pref[e * 8 + sh]]; }
            if (!down) gidx[slot * 256 + F.tid] = val >= 0 ? (val >> 1) : 0;
            else { dtab[slot * 256 + F.tid] = val; wtab[slot * 256 + F.tid] = val >= 0 ? F.wts[val] : 0.f; } } }
    __syncthreads();
    n4_out = n4; n7_out = n7;
}

__device__ __forceinline__ void final_rows(Frame& F) {
    const int gw = F.vcu * 8 + F.wave, NGW = F.G * 8;
    for (int m0 = gw; m0 < MT; m0 += 2 * NGW) {
        u32x4 xa[2][2], ya[2][2], yb[2][2];
#pragma unroll
        for (int q = 0; q < 2; ++q) { const int m = m0 + q * NGW; if (m < MT) {
            const u32x4* xr = (const u32x4*)(F.X1 + (size_t)m * DM) + F.lane; const u32x4* y0 = (const u32x4*)(F.Y + (size_t)(2 * m) * DM) + F.lane; const u32x4* y1 = (const u32x4*)(F.Y + (size_t)(2 * m + 1) * DM) + F.lane;
#pragma unroll
            for (int j = 0; j < 2; ++j) { xa[q][j] = xr[64 * j]; ya[q][j] = y0[64 * j]; yb[q][j] = y1[64 * j]; } } }
#pragma unroll
        for (int q = 0; q < 2; ++q) { const int m = m0 + q * NGW; if (m >= MT) continue;
            const float* gt = F.mod + (m >> 12) * NMOD + 5 * DM; float s = 0.f; f32x4 v[2][2];
#pragma unroll
            for (int j = 0; j < 2; ++j)
#pragma unroll
                for (int hh = 0; hh < 2; ++hh) { const int col = 8 * (F.lane + 64 * j) + 4 * hh; const f32x4 g = *(const f32x4*)(gt + col);
                    const unsigned x0 = hh ? xa[q][j].z : xa[q][j].x, x1 = hh ? xa[q][j].w : xa[q][j].y, a0 = hh ? ya[q][j].z : ya[q][j].x, a1 = hh ? ya[q][j].w : ya[q][j].y, b0 = hh ? yb[q][j].z : yb[q][j].x, b1 = hh ? yb[q][j].w : yb[q][j].y;
                    const f32x4 xs = {bflo(x0), bfhi(x0), bflo(x1), bfhi(x1)}, ys = {bflo(a0) + bflo(b0), bfhi(a0) + bfhi(b0), bflo(a1) + bflo(b1), bfhi(a1) + bfhi(b1)};
                    v[j][hh] = xs + g * ys; s += (v[j][hh].x * v[j][hh].x + v[j][hh].y * v[j][hh].y) + (v[j][hh].z * v[j][hh].z + v[j][hh].w * v[j][hh].w); }
            const float rinv = 1.0f / sqrtf(wave_sum(s) * (1.0f / DM) + RMS_EPS);
#pragma unroll
            for (int j = 0; j < 2; ++j)
#pragma unroll
                for (int hh = 0; hh < 2; ++hh) { const int col = 8 * (F.lane + 64 * j) + 4 * hh; *(f32x4*)(F.out + (size_t)m * DM + col) = v[j][hh] * rinv * *(const f32x4*)(F.g_final + col); }
        }
    }
}

struct Args { const void* in[20]; float* out; unsigned char* ws; int ph_lo, ph_hi, li, pad; };
__global__ void __launch_bounds__(512, 2) fwd_kernel(Args args) {
    extern __shared__ __attribute__((aligned(16))) unsigned char lds[];
    Frame F;
    F.lds = (LAS unsigned char*)lds;
    F.tid = threadIdx.x; F.lane = F.tid & 63; F.wave = __builtin_amdgcn_readfirstlane(F.tid >> 6);
    F.G = gridDim.x; F.bx = blockIdx.x; F.vcu = (F.G % 8 == 0) ? (F.bx % 8) * (F.G / 8) + F.bx / 8 : F.bx;
    unsigned char* ws = args.ws;
    F.ctl = (unsigned*)(ws + WS_CTL);
    F.x = (const float*)args.in[0]; F.c = (const float*)args.in[1]; F.positions = (const int*)args.in[2]; F.w_ada = (const float*)args.in[3]; F.b_ada = (const float*)args.in[4];
    F.g_mix = (const float*)args.in[5]; F.w_in = (const float*)args.in[6]; F.sink = (const float*)args.in[7]; F.w_a = (const float*)args.in[8]; F.w_b = (const float*)args.in[9];
    F.w_out = (const float*)args.in[10]; F.g_ffn = (const float*)args.in[11]; F.w_group = (const float*)args.in[12]; F.b_group = (const float*)args.in[13]; F.w_route = (const float*)args.in[14];
    F.b_route = (const float*)args.in[15]; F.w_gate = (const float*)args.in[16]; F.w_up = (const float*)args.in[17]; F.w_down = (const float*)args.in[18]; F.g_final = (const float*)args.in[19];
    F.out = args.out;
    F.mod = (float*)(ws + WS_MOD); F.rcos = (float*)(ws + WS_RCOS); F.rsin = (float*)(ws + WS_RSIN); F.wts = (float*)(ws + WS_WTS); F.list = (int*)(ws + WS_LIST);
    F.WrT = (bf16*)(ws + WS_WRT); F.WaT = (bf16*)(ws + WS_WAT); F.WbT = (bf16*)(ws + WS_WBT); F.WoT = (bf16*)(ws + WS_WOT); F.WinT = (bf16*)(ws + WS_WINT); F.GUT = (bf16*)(ws + WS_GUT); F.DT = (bf16*)(ws + WS_DT);
    F.H = (bf16*)(ws + WS_H); F.OA = (bf16*)(ws + WS_OA); F.OB = (bf16*)(ws + WS_OB); F.QA = (bf16*)(ws + WS_QA); F.KA = (bf16*)(ws + WS_KA); F.VAT = (bf16*)(ws + WS_VAT);
    F.QB = (bf16*)(ws + WS_QB); F.KB = (bf16*)(ws + WS_KB); F.VBT = (bf16*)(ws + WS_VBT); F.MERGED = (bf16*)(ws + WS_MERGED); F.ACT = (bf16*)(ws + WS_ACT); F.Y = (bf16*)(ws + WS_Y);
    F.X1 = (bf16*)(ws + WS_X1);
    F.SGA = (unsigned char*)args.out; F.SGB = (unsigned char*)args.out + (size_t)MT * DM;
    for (int u = F.tid; u < (LDS_BYTES - MISC_OFF) / 4; u += 512) ((LAS unsigned*)(F.lds + MISC_OFF))[u] = 0u;
    __syncthreads();
    F.bg_done = 0;
#if MK_PER_PHASE
#define GRID_BAR() do {} while (0)
#else
    XcdBarrier bar = xcd_barrier_post(F.ctl + CW_BAR + args.li * XCD_BAR_WORDS, (volatile LAS unsigned*)(F.lds + MISC_OFF));
#define GRID_BAR() xcd_barrier(bar)
#endif
    volatile LAS unsigned* relw = (volatile LAS unsigned*)(F.lds + MISC_OFF + 64);
    const int lo = args.ph_lo, hi = args.ph_hi;
#define IN(k) (lo <= (k) && (k) < hi)
#if MK_PER_PHASE
#define SEAM(k) do { if ((k) == 5) { while (bg_step(F)) {} } } while (0)
#else
#define SEAM(k) do { if ((k) == 5) { while (bg_step(F)) {} }         \
        if (IN(k) && IN((k) + 1)) { if ((k) < 5) xcd_barrier_bg(bar, F, relw, (unsigned)(k) + 1u); else GRID_BAR(); } } while (0)
#endif

#define PHASE_BEGIN(k) if (IN(k)) {
#define PHASE_END(k) SEAM(k); }
    PHASE_BEGIN(0) p0_prologue(F); norm_rows(F, F.x, F.g_mix, 0, DM, F.H); PHASE_END(0)
    PHASE_BEGIN(1)
        SchedTiles S{(const char*)F.H, (const char*)F.WinT, 2048, 2048, 16, 64, 20, F.G, F.bx, 1};
        EpiIn E{F.QA, F.KA, F.VAT, F.QB, F.KB, F.VBT, F.SGA, F.SGB, F.rcos, F.rsin};
        pg8::gemm_run<EpiIn, SchedTiles, false, true>(F.lds, nullptr, S, E);
    PHASE_END(1)
    PHASE_BEGIN(2) attn_phase(F); PHASE_END(2)
    PHASE_BEGIN(3)
        SchedBranch S{(const char*)F.OA, (const char*)F.OB, (const char*)F.WaT, (const char*)F.WbT, F.G, F.bx};
        EpiMerge E{F.SGA, F.SGB, F.MERGED};
        pg8::gemm_run<EpiMerge, SchedBranch, false, false>(F.lds, nullptr, S, E);
    PHASE_END(3)
    PHASE_BEGIN(4)
        SchedTiles S{(const char*)F.MERGED, (const char*)F.WoT, 2048, 2048, 16, 64, 4, F.G, F.bx};
        EpiX1 E{F.x, F.mod, F.X1};
        pg8::gemm_run<EpiX1, SchedTiles, false, false>(F.lds, nullptr, S, E);
    PHASE_END(4)
    PHASE_BEGIN(5) norm_route_phase(F, (MK_REPEAT_MASK != 0 && args.li == 1) ? 1 : 0); PHASE_END(5)
    PHASE_BEGIN(6)
        int n4, n7; moe_setup(F, n4, n7);
        SchedMoe S{(const char*)F.H, (const char*)F.ACT, (const char*)F.GUT, (const char*)F.DT, (const LAS int*)(F.lds + TAB_RB), F.ctl + CW_ACT, n4, n7, F.G, F.bx};
        EpiMoe E{F.ACT, F.Y, (const LAS int*)(F.lds + TAB_D), (const LAS float*)(F.lds + TAB_W), F.ctl + CW_ACT};
        pg8::gemm_run<EpiMoe, SchedMoe, true, true>(F.lds, (const LAS int*)(F.lds + TAB_GIDX), S, E);
    PHASE_END(6)
    PHASE_BEGIN(7) final_rows(F); PHASE_END(7)
#undef IN
#undef SEAM
}

extern "C" void kernel_launch(void* const* d_in, const int* in_sizes, int n_in, void* d_out, int out_size, void* d_ws, size_t ws_size, hipStream_t stream) {
    static int grid = 0;
    if (grid == 0) {
        if (n_in != 20 || out_size != MT * DM || ws_size < WS_END) { fprintf(stderr, "kernel_launch: unexpected shapes (n_in %d out %d ws %zu)\n", n_in, out_size, ws_size); grid = -1; return; }
        int dev = 0, cus = 0, per_cu = 0;
        if (hipGetDevice(&dev) != hipSuccess || hipDeviceGetAttribute(&cus, hipDeviceAttributeMultiprocessorCount, dev) != hipSuccess) { grid = -1; return; }
        if (hipFuncSetAttribute((const void*)fwd_kernel, hipFuncAttributeMaxDynamicSharedMemorySize, LDS_BYTES) != hipSuccess) { fprintf(stderr, "kernel_launch: hipFuncSetAttribute failed\n"); grid = -1; return; }
        if (hipOccupancyMaxActiveBlocksPerMultiprocessor(&per_cu, (const void*)fwd_kernel, 512, LDS_BYTES) != hipSuccess || per_cu < 1) { fprintf(stderr, "kernel_launch: occupancy query says %d\n", per_cu); }
        (void)hipGetLastError();
        grid = cus;
    }
    if (grid < 0) return;
    (void)hipMemsetAsync((char*)d_ws + WS_CTL, 0, CTL_ZERO_BYTES, stream);
    Args a{};
    for (int i = 0; i < 20; ++i) a.in[i] = d_in[i];
    a.out = (float*)d_out; a.ws = (unsigned char*)d_ws;
#if MK_PER_PHASE
    for (int p = 0; p < NPHASE; ++p) { a.ph_lo = p; a.ph_hi = p + 1; hipLaunchKernelGGL(fwd_kernel, dim3(grid), dim3(512), LDS_BYTES, stream, a); }
#else
    if (MK_REPEAT_MASK == 0) { a.ph_lo = 0; a.ph_hi = NPHASE; a.li = 0; hipLaunchKernelGGL(fwd_kernel, dim3(grid), dim3(512), LDS_BYTES, stream, a); }
    else {
        int k0 = 0, k1 = 0; for (int k = 0; k < NPHASE; ++k) if ((MK_REPEAT_MASK >> k) & 1) { k0 = k; break; }
        for (int k = 0; k < NPHASE; ++k) if ((MK_REPEAT_MASK >> k) & 1) k1 = k;
        a.ph_lo = 0; a.ph_hi = k1 + 1; a.li = 0; hipLaunchKernelGGL(fwd_kernel, dim3(grid), dim3(512), LDS_BYTES, stream, a);
        a.ph_lo = k0; a.ph_hi = k1 + 1; a.li = 1; hipLaunchKernelGGL(fwd_kernel, dim3(grid), dim3(512), LDS_BYTES, stream, a);
        if (k1 + 1 < NPHASE) { a.ph_lo = k1 + 1; a.ph_hi = NPHASE; a.li = 2; hipLaunchKernelGGL(fwd_kernel, dim3(grid), dim3(512), LDS_BYTES, stream, a); }
    }
#endif
}
```

```cpp
#include <hip/hip_runtime.h>
#include <cstdio>
#include <cstdint>

#ifndef MK_PER_PHASE
#define MK_PER_PHASE 0
#endif

#ifndef MK_REPEAT_MASK
#define MK_REPEAT_MASK 0
#endif
#define LAS __attribute__((address_space(3)))
#define GAS __attribute__((address_space(1)))
typedef unsigned short bf16;
typedef short bf16x8 __attribute__((ext_vector_type(8)));
typedef short s16x4 __attribute__((ext_vector_type(4)));
typedef float f32x4 __attribute__((ext_vector_type(4)));
typedef float f32x2 __attribute__((ext_vector_type(2)));
typedef float f32x16 __attribute__((ext_vector_type(16)));
typedef unsigned u32x4 __attribute__((ext_vector_type(4)));
typedef unsigned u32x2 __attribute__((ext_vector_type(2)));
typedef __bf16 bf16x2_t __attribute__((ext_vector_type(2)));

constexpr int NBATCH = 4, SEQ = 4096, DM = 1024, MT = NBATCH * SEQ;
constexpr int NIN = 5120, NMOD = 6 * DM;
constexpr int NEXP = 32, DEXP = 512;
constexpr float RMS_EPS = 1e-6f;
constexpr float LOG2E = 1.4426950408889634f;
constexpr float QSCALE = 0.125f * LOG2E;
constexpr int NPHASE = 8;

constexpr size_t MiB = 1u << 20;
constexpr size_t WS_CTL = 0, CTL_ZERO_BYTES = 1 * MiB;
constexpr size_t WS_MOD = 1 * MiB;
constexpr size_t WS_RCOS = 2 * MiB, WS_RSIN = 4 * MiB;
constexpr size_t WS_LIST = 288 * MiB;
constexpr size_t WS_WTS = 8 * MiB;
constexpr size_t WS_WRT = 8 * MiB + 512 * 1024;
constexpr size_t WS_WAT = 9 * MiB;
constexpr size_t WS_WBT = 9 * MiB + 512 * 1024;
constexpr size_t WS_WOT = 10 * MiB + 512 * 1024;
constexpr size_t WS_WINT = 13 * MiB;
constexpr size_t WS_GUT = 24 * MiB;
constexpr size_t WS_DT = 88 * MiB;
constexpr size_t WS_H = 120 * MiB;
constexpr size_t WS_OA = 120 * MiB;
constexpr size_t WS_OB = 128 * MiB;
constexpr size_t WS_QA = 152 * MiB, WS_KA = 176 * MiB, WS_VAT = 200 * MiB, WS_QB = 224 * MiB, WS_KB = 240 * MiB, WS_VBT = 244 * MiB;
constexpr size_t WS_MERGED = 152 * MiB;
constexpr size_t WS_ACT = 152 * MiB;
constexpr size_t WS_Y = 192 * MiB;
constexpr size_t WS_X1 = 256 * MiB;
constexpr size_t WS_END = 296 * MiB;
constexpr int CW_BAR = 4096;
constexpr int CW_CNT = 16384;
constexpr int CW_MODCNT = 49152;
constexpr int CW_ACT = 32768;

constexpr int RING_BYTES = 131072;
constexpr int TAB_OFF = RING_BYTES;
constexpr int TAB_GIDX = TAB_OFF, TAB_D = TAB_OFF + 3072, TAB_W = TAB_OFF + 6144, TAB_RB = TAB_OFF + 9216, TAB_CNT = TAB_RB + 768, TAB_NB = TAB_CNT + 128, TAB_PREF = TAB_NB + 16;
constexpr int MISC_OFF = TAB_OFF + 12288;
constexpr int LDS_BYTES = 147456;

#define LDS_WAIT() asm volatile("s_waitcnt lgkmcnt(0)" ::: "memory")
#define VM_WAIT() asm volatile("s_waitcnt vmcnt(0)" ::: "memory")
#define RLX_AGENT __ATOMIC_RELAXED, __HIP_MEMORY_SCOPE_AGENT
__device__ __forceinline__ unsigned cvtpk(float lo, float hi) { f32x2 v = {lo, hi}; bf16x2_t b = __builtin_convertvector(v, bf16x2_t); return __builtin_bit_cast(unsigned, b); }
__device__ __forceinline__ float bflo(unsigned u) { return __builtin_bit_cast(float, u << 16); }
__device__ __forceinline__ float bfhi(unsigned u) { return __builtin_bit_cast(float, u & 0xffff0000u); }
__device__ __forceinline__ float fexp2(float x) { return __builtin_amdgcn_exp2f(x); }
__device__ __forceinline__ float frcp(float x) { return __builtin_amdgcn_rcpf(x); }
__device__ __forceinline__ float fsigmoid(float x) { return frcp(1.0f + fexp2(-x * LOG2E)); }
__device__ __forceinline__ void st16_sc1(void* p, u32x4 v) { asm volatile("global_store_dwordx4 %0, %1, off sc1\n\ts_nop 1" :: "v"(p), "v"(v) : "memory"); }
__device__ __forceinline__ float wave_sum(float v) {
#pragma unroll
    for (int o = 1; o < 64; o <<= 1) v += __shfl_xor(v, o);
    return v;
}

namespace pg8 {
constexpr int BM = 256, BK = 64, HALF = 128, HTB = HALF * BK * 2, STAGE_BYTES = 8 * HTB;
__host__ __device__ __forceinline__ int lds_byte(int r, int c) { const int st = (r >> 4) * 2 + (c >> 5), rr = r & 15, cc = c & 31, ob = rr * 64 + cc * 2; return st * 1024 + (ob ^ (((ob >> 9) & 1) << 5)); }
__host__ __device__ __forceinline__ void stage_rc(int b, int& R, int& C) { const int st = b / 1024, sb = b % 1024, swz = sb ^ (((sb >> 9) & 1) << 5); R = (st >> 1) * 16 + swz / 64; C = (st & 1) * 32 + (swz % 64) / 2; }
__host__ __device__ __forceinline__ int perm32(int rho) { const int n = rho >> 4, i = rho & 15; return 8 * (i >> 2) + 4 * n + (i & 3); }

struct GU {
    const char* A;
    const char* B;
    int lda, ldb;
    int nt;
    int zero;
    int gslot;
    int pm, pn, aux;
    int eslot;
};

__device__ __forceinline__ bool static_tile(int i, int G, int c, int nM, int nN, int& pm, int& pn, int WG = 8) {
    const int nwg = nM * nN; const long L = (long)i * G + c; if (L >= nwg) return false;
    int wgid = (int)L; { const int q = nwg / 8, r = nwg % 8, xcd = wgid % 8, off = wgid / 8; wgid = (xcd < r ? xcd * (q + 1) : r * (q + 1) + (xcd - r) * q) + off; }
    const int nig = WG * nN, gid = wgid / nig, fm = gid * WG, gsz = (nM - fm) < WG ? (nM - fm) : WG;
    pm = fm + ((wgid % nig) % gsz); pn = (wgid % nig) / gsz; return true;
}

template <class Epi, class Sched, bool GATHER, bool ALIGN_EPI>
__device__ __forceinline__ void gemm_run(LAS unsigned char* lds, const LAS int* gidx, const Sched& S, const Epi& E) {
    const int tid = threadIdx.x, wid = __builtin_amdgcn_readfirstlane(tid >> 6), lane = tid & 63, wr = wid >> 2, wc = wid & 3, fr = lane & 15, fq = lane >> 4;
    int R[2], C2[2], Rb[2];
#pragma unroll
    for (int i = 0; i < 2; ++i) { int C; stage_rc(tid * 16 + i * 8192, R[i], C); C2[i] = C * 2; Rb[i] = Epi::PERM ? ((R[i] & ~31) + perm32(R[i] & 31)) : R[i]; }
    const unsigned ldsw = (unsigned)wid * 1024u;
    const int aoff = lds_byte(wr * 64 + fr, fq * 8), boff = lds_byte(wc * 32 + fr, fq * 8);
#define PG8_SA(b, h) (((b) * 2 + (h)) * HTB)
#define PG8_SB(b, h) ((4 + (b) * 2 + (h)) * HTB)
#define PG8_STAGE(bufoff, gbase, voff) do { _Pragma("unroll") for (int _i = 0; _i < 2; ++_i) \
        __builtin_amdgcn_global_load_lds((const unsigned*)((const char*)(gbase) + (voff)[_i]), (LAS unsigned*)(lds + (bufoff) + ldsw + _i * 8192), 16, 0, 0); } while (0)
#define PG8_LDA(dst, b, h) do { _Pragma("unroll") for (int m = 0; m < 4; ++m) _Pragma("unroll") for (int k = 0; k < 2; ++k) dst[m][k] = *(const LAS bf16x8*)(lds + PG8_SA(b, h) + aoff + m * 2048 + k * 1024); } while (0)
#define PG8_LDB(dst, b, h) do { _Pragma("unroll") for (int n = 0; n < 2; ++n) _Pragma("unroll") for (int k = 0; k < 2; ++k) dst[n][k] = *(const LAS bf16x8*)(lds + PG8_SB(b, h) + boff + n * 2048 + k * 1024); } while (0)
#define PG8_MMA(ai, bj, At, Bt) do { __builtin_amdgcn_s_setprio(1); _Pragma("unroll") for (int m = 0; m < 4; ++m) _Pragma("unroll") for (int n = 0; n < 2; ++n) _Pragma("unroll") for (int k = 0; k < 2; ++k) \
        acc[ai][bj][m][n] = __builtin_amdgcn_mfma_f32_16x16x32_bf16(Bt[n][k], At[m][k], acc[ai][bj][m][n], 0, 0, 0); __builtin_amdgcn_s_setprio(0); } while (0)
#define PG8_WAIT_V(n) asm volatile("s_waitcnt vmcnt(" #n ")" ::: "memory")
#define PG8_WAIT_L(n) asm volatile("s_waitcnt lgkmcnt(" #n ")" ::: "memory")
#define PG8_BAR __builtin_amdgcn_s_barrier()
#define PG8_SCHED __builtin_amdgcn_sched_barrier(0)
#define PG8_SETV(u) do { _Pragma("unroll") for (int _i = 0; _i < 2; ++_i) { int r0, r1; \
        if (GATHER && (u).gslot >= 0) { r0 = gidx[(u).gslot * 256 + R[_i]]; r1 = gidx[(u).gslot * 256 + 128 + R[_i]]; } else { r0 = R[_i]; r1 = R[_i] + 128; } \
        vA[0][_i] = (unsigned)(r0 * (u).lda + C2[_i]); vA[1][_i] = (unsigned)(r1 * (u).lda + C2[_i]); vB[_i] = (unsigned)(Rb[_i] * (u).ldb + C2[_i]); } hB = (unsigned)(128 * (u).ldb); } while (0)
    GU cur, nxt; int ui = 0; int pend = -1;
    if (!S.next(0, cur)) return;
    f32x4 acc[2][2][4][2];
#pragma unroll
    for (int a = 0; a < 2; ++a)
#pragma unroll
        for (int b = 0; b < 2; ++b)
#pragma unroll
            for (int m = 0; m < 4; ++m)
#pragma unroll
                for (int n = 0; n < 2; ++n) acc[a][b][m][n] = (f32x4){0.f, 0.f, 0.f, 0.f};
    bf16x8 At[4][2], B0[2][2], B1[2][2];
    unsigned vA[2][2], vB[2], hB;
    S.a_ready(cur);
    PG8_SETV(cur);
    const char* sA = cur.A; const char* sB = cur.B;
    PG8_STAGE(PG8_SB(0, 0), sB, vB); PG8_STAGE(PG8_SB(0, 1), sB + hB, vB); PG8_STAGE(PG8_SA(0, 0), sA, vA[0]); PG8_STAGE(PG8_SA(0, 1), sA, vA[1]);
    if (wr == 1) PG8_BAR;
    PG8_WAIT_V(2); PG8_BAR;
    PG8_STAGE(PG8_SB(1, 0), sB + 128, vB); PG8_STAGE(PG8_SA(1, 0), sA + 128, vA[0]); PG8_STAGE(PG8_SB(1, 1), sB + hB + 128, vB);
    PG8_WAIT_V(6); PG8_BAR;
    sA += 256; sB += 256;
    for (;;) {
        bool has_next = false;
        const int nt = cur.nt;
        for (int t = 0; t < nt; t += 2) {
            const bool last = (t == nt - 2);
            PG8_LDB(B0, 0, 0); PG8_LDB(B1, 0, 1); PG8_SCHED; PG8_LDA(At, 0, 0); PG8_STAGE(PG8_SA(1, 1), sA - 128, vA[1]);
            PG8_WAIT_V(8); PG8_WAIT_L(0); PG8_BAR; PG8_MMA(0, 0, At, B0); PG8_MMA(0, 1, At, B1); PG8_BAR; PG8_SCHED;
            if (last) {
                has_next = S.next(ui + 1, nxt);
                if (has_next) { S.a_ready(nxt); PG8_SETV(nxt); sA = nxt.A; sB = nxt.B; } else { sA = cur.A; sB = cur.B; }
            }
            PG8_LDA(At, 0, 1); PG8_STAGE(PG8_SB(0, 0), sB, vB); PG8_STAGE(PG8_SB(0, 1), sB + hB, vB); PG8_STAGE(PG8_SA(0, 0), sA, vA[0]);
            PG8_WAIT_V(8);
            if constexpr (Epi::DEFER_PUBLISH) { if (pend >= 0) { E.publish(pend, lane); pend = -1; } }
            PG8_WAIT_L(0); PG8_BAR; PG8_MMA(1, 0, At, B0); PG8_MMA(1, 1, At, B1); PG8_BAR; PG8_SCHED;
            PG8_LDB(B0, 1, 0); PG8_LDB(B1, 1, 1); PG8_SCHED; PG8_LDA(At, 1, 0); PG8_STAGE(PG8_SA(0, 1), sA, vA[1]);
            PG8_WAIT_V(8); PG8_WAIT_L(0); PG8_BAR; PG8_MMA(0, 0, At, B0); PG8_MMA(0, 1, At, B1); PG8_BAR; PG8_SCHED;
            PG8_LDA(At, 1, 1); PG8_STAGE(PG8_SB(1, 0), sB + 128, vB); PG8_STAGE(PG8_SB(1, 1), sB + hB + 128, vB); PG8_STAGE(PG8_SA(1, 0), sA + 128, vA[0]);
            PG8_WAIT_V(8); PG8_WAIT_L(0); PG8_BAR; PG8_MMA(1, 0, At, B0); PG8_MMA(1, 1, At, B1); PG8_BAR; PG8_SCHED;
            sA += 256; sB += 256;
        }
        if constexpr (ALIGN_EPI) { if (wr == 0) PG8_BAR; }
        if constexpr (!Epi::AFTER_DRAIN) { E(acc, cur, wr, wc, fr, fq); }
        if constexpr (Epi::DEFER_PUBLISH) { if (E.wants_publish(cur)) pend = cur.pm; }
        if (!has_next) break;
        if (nxt.zero) {
#pragma unroll
            for (int a = 0; a < 2; ++a)
#pragma unroll
                for (int b = 0; b < 2; ++b)
#pragma unroll
                    for (int m = 0; m < 4; ++m)
#pragma unroll
                        for (int n = 0; n < 2; ++n) acc[a][b][m][n] = (f32x4){0.f, 0.f, 0.f, 0.f};
        }
        cur = nxt; ++ui;
        if constexpr (ALIGN_EPI) { if (wr == 1) PG8_BAR; }
    }
    PG8_WAIT_V(0);
    if constexpr (Epi::DEFER_PUBLISH) { if (pend >= 0) { E.publish(pend, lane); pend = -1; } }
    if constexpr (!ALIGN_EPI) { if (wr == 0) PG8_BAR; }
    PG8_BAR;
    if constexpr (Epi::AFTER_DRAIN) { E.fused(acc, cur, wr, wc, fr, fq, lds, wid, lane); }
#undef PG8_SA
#undef PG8_SB
#undef PG8_STAGE
#undef PG8_LDA
#undef PG8_LDB
#undef PG8_MMA
#undef PG8_WAIT_V
#undef PG8_WAIT_L
#undef PG8_BAR
#undef PG8_SCHED
#undef PG8_SETV
}
}

#define XB_TMO      128
#define XB_XCNT(j)  (256  + 64 * (j))
#define XB_XSUB(j)  (1280 + 64 * (j))
#define XB_XGEN(j)  (2304 + 64 * (j))
#define XB_TOP      3328
#define XB_TOPGEN   3392
#define XCD_BAR_WORDS 3456
#define XB_SPIN_CAP (1u << 18)
__device__ __forceinline__ unsigned xb_ld(unsigned* p)              { return __hip_atomic_load(p, __ATOMIC_RELAXED, __HIP_MEMORY_SCOPE_AGENT); }
__device__ __forceinline__ unsigned xb_add(unsigned* p, unsigned v) { return __hip_atomic_fetch_add(p, v, __ATOMIC_RELAXED, __HIP_MEMORY_SCOPE_AGENT); }
__device__ __forceinline__ unsigned xb_xcc_id() { return (unsigned)__builtin_amdgcn_s_getreg((3 << 11) | 20) & 0xFu; }
#define XB_SPIN(cond, bar) do { unsigned _sp = 0; while (cond) { __builtin_amdgcn_s_sleep(1); \
    if ((++_sp & 255u) == 0u) { if (xb_ld(&(bar)[XB_TMO])) break; if (_sp > XB_SPIN_CAP) { atomicAdd(&(bar)[XB_TMO], 1u); break; } } } } while (0)
struct XcdBarrier { unsigned* bar; unsigned x; volatile LAS unsigned* st; };
__device__ __forceinline__ XcdBarrier xcd_barrier_post(unsigned* bar, volatile LAS unsigned* st) {
    XcdBarrier b; b.bar = bar; b.x = xb_xcc_id(); b.st = st;
    if (threadIdx.x == 0) (void)xb_add(&bar[XB_XCNT(b.x)], 1u);
    return b;
}
__device__ __forceinline__ void xcd_barrier_complete(unsigned* bar, unsigned x, unsigned& nloc, unsigned& nx) {
    const unsigned G = gridDim.x * gridDim.y * gridDim.z;
    unsigned sum, cnt, mine, sp = 0u;
    for (;;) {
        sum = 0u; cnt = 0u; mine = 0u;
#pragma unroll
        for (unsigned j = 0; j < 16; ++j) { const unsigned c = xb_ld(&bar[XB_XCNT(j)]); sum += c; cnt += (c > 0u) ? 1u : 0u; mine = (j == x) ? c : mine; }
        if (sum == G) break;
        __builtin_amdgcn_s_sleep(1);
        if ((++sp & 255u) == 0u) { if (xb_ld(&bar[XB_TMO])) break; if (sp > XB_SPIN_CAP) { atomicAdd(&bar[XB_TMO], 1u); break; } }
    }
    nloc = mine > 0u ? mine : 1u; nx = cnt > 0u ? cnt : 1u;
}
__device__ __forceinline__ void xcd_barrier(const XcdBarrier& b) {
    asm volatile("s_waitcnt vmcnt(0)" ::: "memory");
    __syncthreads();
    if (threadIdx.x == 0) {
        unsigned* bar = b.bar;
        __builtin_amdgcn_s_waitcnt(0);
        unsigned nloc = b.st[0], nx = b.st[1];
        if (nloc == 0u) { xcd_barrier_complete(bar, b.x, nloc, nx); b.st[0] = nloc; b.st[1] = nx; }
        const unsigned old = xb_add(&bar[XB_XSUB(b.x)], 1u);
        const unsigned gen = old / nloc;
        if (old + 1u == (gen + 1u) * nloc) {
            __builtin_amdgcn_fence(__ATOMIC_RELEASE, "agent");
            asm volatile("s_waitcnt vmcnt(0)" ::: "memory");
            const unsigned og = xb_add(&bar[XB_TOP], 1u);
            const unsigned tg = og / nx;
            if (og + 1u == (tg + 1u) * nx) xb_add(&bar[XB_TOPGEN], 1u);
            else XB_SPIN(xb_ld(&bar[XB_TOPGEN]) == tg, bar);
            __builtin_amdgcn_fence(__ATOMIC_ACQUIRE, "agent");
            xb_add(&bar[XB_XGEN(b.x)], 1u);
            asm volatile("s_waitcnt vmcnt(0)" ::: "memory");
        } else {
            XB_SPIN(xb_ld(&bar[XB_XGEN(b.x)]) == gen, bar);
            __builtin_amdgcn_fence(__ATOMIC_ACQUIRE, "agent");
            asm volatile("s_waitcnt vmcnt(0)" ::: "memory");
        }
    }
    __syncthreads();
}

struct Frame {
    LAS unsigned char* lds;
    unsigned* ctl;
    int tid, lane, wave, vcu, G, bx;
    int bg_done;
    const float *x, *c, *w_ada, *b_ada, *g_mix, *w_in, *sink, *w_a, *w_b, *w_out, *g_ffn, *w_group, *b_group, *w_route, *b_route, *w_gate, *w_up, *w_down, *g_final;
    const int* positions;
    float* out;
    float *mod, *rcos, *rsin, *wts;
    int* list;
    bf16 *WrT, *WaT, *WbT, *WoT, *WinT, *GUT, *DT, *H, *OA, *OB, *QA, *KA, *VAT, *QB, *KB, *VBT, *MERGED, *ACT, *Y, *X1;
    unsigned char *SGA, *SGB;
};

__device__ const double INVF[32] = {1, 0.74989420933245587, 0.56234132519034907, 0.42169650342858223, 0.31622776601683794, 0.23713737056616552, 0.17782794100389229, 0.1333521432163324,
    0.10000000000000001, 0.074989420933245579, 0.056234132519034911, 0.042169650342858224, 0.031622776601683791, 0.023713737056616554, 0.017782794100389229, 0.013335214321633241,
    0.01, 0.0074989420933245579, 0.005623413251903491, 0.0042169650342858229, 0.0031622776601683794, 0.0023713737056616554, 0.0017782794100389228, 0.0013335214321633241,
    0.001, 0.00074989420933245586, 0.0005623413251903491, 0.00042169650342858224, 0.00031622776601683794, 0.00023713737056616554, 0.00017782794100389227, 0.0001333521432163324};

template <int KIND> __device__ __forceinline__ int rowmap(int n) {
    if (KIND == 0) return n;
    if (KIND == 1) { const bool rp = (n < 1536) || (n >= 2304 && n < 2944); if (!rp) return n; const int j = n & 63; return (n & ~63) + (((j & 31) >> 2) << 3) + ((j >> 5) << 2) + (j & 3); }
    if (KIND == 2) return ((n >> 7) << 8) + (n & 127);
    return ((n >> 7) << 8) + 128 + (n & 127);
}
template <int KIND> __device__ __forceinline__ void transpose_item(const float* W, int K, int N, bf16* WT, int item, int lane) {
    const int nblk = N >> 5, kb = item / nblk, nb = item - kb * nblk, k0 = 64 * kb + 8 * (lane >> 3), n0 = 32 * nb + 4 * (lane & 7);
    f32x4 v[8];
#pragma unroll
    for (int j = 0; j < 8; ++j) v[j] = __builtin_nontemporal_load((const f32x4*)(W + (size_t)(k0 + j) * N + n0));
#pragma unroll
    for (int i = 0; i < 4; ++i) { u32x4 o; o.x = cvtpk(v[0][i], v[1][i]); o.y = cvtpk(v[2][i], v[3][i]); o.z = cvtpk(v[4][i], v[5][i]); o.w = cvtpk(v[6][i], v[7][i]);
        __builtin_nontemporal_store(o, (u32x4*)(WT + (size_t)rowmap<KIND>(n0 + i) * K + k0)); }
}


constexpr int EXP_ITEMS = NEXP * 3 * 256;
#ifndef BGW
#define BGW 3
#endif
#ifndef EXP_DEFER
#define EXP_DEFER 3072
#endif
struct FillRegs { f32x4 a, b, c, d, e, f, g, h; };
__device__ __forceinline__ void expert_item(const float* wg, const float* wu, const float* wd, bf16* gut, bf16* dt, int r, int lane) {
    const int e = r / 768, q = r - e * 768, kind = q >> 8, item = q & 255;
    const float* W = (kind == 0 ? wg : (kind == 1 ? wu : wd)) + (size_t)e * DM * DEXP;
    const int N = kind == 2 ? DM : DEXP, K = kind == 2 ? DEXP : DM, nblk = N >> 5, kb = item / nblk, nb = item - kb * nblk, k0 = 64 * kb + 8 * (lane >> 3), n0 = 32 * nb + 4 * (lane & 7);
    const f32x4* p = (const f32x4*)(W + (size_t)k0 * N + n0); const size_t st = (size_t)(N >> 2);
    FillRegs v;
    v.a = __builtin_nontemporal_load(p); v.b = __builtin_nontemporal_load(p + st); v.c = __builtin_nontemporal_load(p + 2 * st); v.d = __builtin_nontemporal_load(p + 3 * st);
    v.e = __builtin_nontemporal_load(p + 4 * st); v.f = __builtin_nontemporal_load(p + 5 * st); v.g = __builtin_nontemporal_load(p + 6 * st); v.h = __builtin_nontemporal_load(p + 7 * st);
    bf16* WT = kind == 2 ? dt + (size_t)e * 1024 * 512 : gut + (size_t)e * 1024 * 1024;
#pragma unroll
    for (int i = 0; i < 4; ++i) { u32x4 o; o.x = cvtpk(v.a[i], v.b[i]); o.y = cvtpk(v.c[i], v.d[i]); o.z = cvtpk(v.e[i], v.f[i]); o.w = cvtpk(v.g[i], v.h[i]);
        const int n = n0 + i, row = kind == 2 ? n : (((n >> 7) << 8) + 128 * kind + (n & 127));
        __builtin_nontemporal_store(o, (u32x4*)(WT + (size_t)row * K + k0)); }
}

__device__ __forceinline__ bool bg_step(Frame& F) {
    if (F.bg_done) return false;
    volatile LAS unsigned* bgk = (volatile LAS unsigned*)(F.lds + MISC_OFF + 128);
    int k = 0; if (F.lane == 0) k = (int)__hip_atomic_fetch_add((LAS unsigned*)bgk, 1u, __ATOMIC_RELAXED, __HIP_MEMORY_SCOPE_WORKGROUP);
    k = __builtin_amdgcn_readfirstlane(k);
    const int r = EXP_DEFER + F.vcu + k * F.G;
    if (r >= EXP_ITEMS) { F.bg_done = 1; return false; }
    expert_item(F.w_gate, F.w_up, F.w_down, F.GUT, F.DT, r, F.lane); return true;
}
__device__ __forceinline__ void xcd_barrier_bg(const XcdBarrier& b, Frame& F, volatile LAS unsigned* relw, unsigned epoch) {
    asm volatile("s_waitcnt vmcnt(0)" ::: "memory");
    __syncthreads();
    if (threadIdx.x < 64) {
        if (threadIdx.x == 0) {
            unsigned* bar = b.bar;
            __builtin_amdgcn_s_waitcnt(0);
            unsigned nloc = b.st[0], nx = b.st[1];
            if (nloc == 0u) { xcd_barrier_complete(bar, b.x, nloc, nx); b.st[0] = nloc; b.st[1] = nx; }
            const unsigned old = xb_add(&bar[XB_XSUB(b.x)], 1u);
            const unsigned gen = old / nloc;
            if (old + 1u == (gen + 1u) * nloc) {
                __builtin_amdgcn_fence(__ATOMIC_RELEASE, "agent");
                asm volatile("s_waitcnt vmcnt(0)" ::: "memory");
                const unsigned og = xb_add(&bar[XB_TOP], 1u);
                const unsigned tg = og / nx;
                if (og + 1u == (tg + 1u) * nx) xb_add(&bar[XB_TOPGEN], 1u);
                else XB_SPIN(xb_ld(&bar[XB_TOPGEN]) == tg, bar);
                relw[1] = epoch;
                __builtin_amdgcn_fence(__ATOMIC_ACQUIRE, "agent");
                xb_add(&bar[XB_XGEN(b.x)], 1u);
                asm volatile("s_waitcnt vmcnt(0)" ::: "memory");
            } else {
                XB_SPIN(xb_ld(&bar[XB_XGEN(b.x)]) == gen, bar);
                relw[1] = epoch;
                __builtin_amdgcn_fence(__ATOMIC_ACQUIRE, "agent");
                asm volatile("s_waitcnt vmcnt(0)" ::: "memory");
            }
            relw[0] = epoch;
        }
    } else {
        while (relw[0] != epoch) { if (F.wave > BGW || relw[1] == epoch || !bg_step(F)) __builtin_amdgcn_s_sleep(2); }
    }
    asm volatile("s_waitcnt lgkmcnt(0)" ::: "memory"); __builtin_amdgcn_s_barrier(); asm volatile("" ::: "memory");
}

__device__ __forceinline__ void p0_prologue(Frame& F) {
    {
        LAS float* cs = (LAS float*)(F.lds);
        LAS float* red = (LAS float*)(F.lds + 16384);
        for (int item = F.vcu; item < NMOD / 32; item += F.G) {
            for (int i = F.tid; i < 4096; i += 512) { const float v = F.c[i]; cs[i] = v / (1.0f + __expf(-v)); }
            __syncthreads();
            const int kq = F.tid >> 3, cq = F.tid & 7, n0 = 32 * item + 4 * cq;
            f32x4 a[4];
#pragma unroll
            for (int b = 0; b < 4; ++b) a[b] = (f32x4){0.f, 0.f, 0.f, 0.f};
#pragma unroll 4
            for (int it = 0; it < 16; ++it) { const int k = kq + 64 * it; const f32x4 w = __builtin_nontemporal_load((const f32x4*)(F.w_ada + (size_t)k * NMOD + n0));
#pragma unroll
                for (int b = 0; b < 4; ++b) a[b] += cs[b * 1024 + k] * w; }
#pragma unroll
            for (int b = 0; b < 4; ++b) *(LAS f32x4*)(red + kq * 132 + b * 32 + cq * 4) = a[b];
            __syncthreads();
            if (F.tid < 128) { float s = 0.f; for (int q = 0; q < 64; ++q) s += red[q * 132 + F.tid];
                const int b = F.tid >> 5, col = 32 * item + (F.tid & 31); __hip_atomic_store(F.mod + b * NMOD + col, s + F.b_ada[col], RLX_AGENT); }
            VM_WAIT(); __syncthreads();
            if (F.tid == 0) __hip_atomic_fetch_add(F.ctl + CW_MODCNT, 1u, RLX_AGENT);
        }
    }
    {
        const int gw = F.vcu * 8 + F.wave, NGW = F.G * 8;
        constexpr int I_IN = 16 * 160, I_A = 4 * 32, I_B = 8 * 32, I_O = 16 * 32, I_E = 256;
        constexpr int NITEMS = I_IN + I_A + I_B + I_O + EXP_DEFER;
        for (int it = gw; it < NITEMS; it += NGW) {
            int r = it;
            if (r < I_IN) { transpose_item<1>(F.w_in, DM, NIN, F.WinT, r, F.lane); continue; } r -= I_IN;
            if (r < I_A) { transpose_item<0>(F.w_a, 256, DM, F.WaT, r, F.lane); continue; } r -= I_A;
            if (r < I_B) { transpose_item<0>(F.w_b, 512, DM, F.WbT, r, F.lane); continue; } r -= I_B;
            if (r < I_O) { transpose_item<0>(F.w_out, DM, DM, F.WoT, r, F.lane); continue; } r -= I_O;
            const int e = r / (3 * I_E), q = r - e * 3 * I_E;
            if (q < I_E) transpose_item<2>(F.w_gate + (size_t)e * DM * DEXP, DM, DEXP, F.GUT + (size_t)e * 1024 * 1024, q, F.lane);
            else if (q < 2 * I_E) transpose_item<3>(F.w_up + (size_t)e * DM * DEXP, DM, DEXP, F.GUT + (size_t)e * 1024 * 1024, q - I_E, F.lane);
            else transpose_item<0>(F.w_down + (size_t)e * DEXP * DM, DEXP, DM, F.DT + (size_t)e * 1024 * 512, q - 2 * I_E, F.lane);
        }
    }
    {
        const int gt = F.vcu * 512 + F.tid, NT = F.G * 512;
        for (int idx = gt; idx < MT * 32; idx += NT) { const int tok = idx >> 5, i = idx & 31;
            double rev = (double)F.positions[tok] * INVF[i] * 0.15915494309189535; rev -= __builtin_rint(rev);
            const float fr = (float)rev; F.rcos[idx] = __builtin_amdgcn_cosf(fr); F.rsin[idx] = __builtin_amdgcn_sinf(fr); }
        for (int idx = gt; idx < 256 * 1024; idx += NT) { const int n = idx >> 10, k = idx & 1023;
            const float v = n < 4 ? F.w_group[k * 4 + n] : (n < 36 ? F.w_route[k * 32 + (n - 4)] : 0.f);
            F.WrT[idx] = (bf16)(cvtpk(v, 0.f) & 0xffffu); }
    }
    if (F.tid == 0) {
        unsigned sp = 0; while (__hip_atomic_load(F.ctl + CW_MODCNT, RLX_AGENT) < (unsigned)(NMOD / 32)) { __builtin_amdgcn_s_sleep(2); if (++sp > (1u << 22)) break; }
        __builtin_amdgcn_fence(__ATOMIC_ACQUIRE, "agent"); VM_WAIT();
    }
    __syncthreads();
}

__device__ __forceinline__ void norm_rows(Frame& F, const float* src, const float* g, int sh_off, int sc_off, bf16* dst) {
    if (F.G == 256) {
        const int x = F.vcu >> 5, j = F.vcu & 31;
#pragma unroll 1
        for (int k0 = 0; k0 < 8; k0 += 4) {
            f32x4 v[4][4]; float s[4];
#pragma unroll
            for (int q = 0; q < 4; ++q) { const int m = 256 * (8 * x + k0 + q) + 8 * j + F.wave; s[q] = 0.f; const f32x4* xr = (const f32x4*)(src + (size_t)m * DM) + F.lane;
#pragma unroll
                for (int jj = 0; jj < 4; ++jj) v[q][jj] = xr[64 * jj]; }
#pragma unroll
            for (int q = 0; q < 4; ++q) { const int m = 256 * (8 * x + k0 + q) + 8 * j + F.wave;
#pragma unroll
                for (int jj = 0; jj < 4; ++jj) s[q] += (v[q][jj].x * v[q][jj].x + v[q][jj].y * v[q][jj].y) + (v[q][jj].z * v[q][jj].z + v[q][jj].w * v[q][jj].w);
                const float rinv = 1.0f / sqrtf(wave_sum(s[q]) * (1.0f / DM) + RMS_EPS);
                const float* md = F.mod + (m >> 12) * NMOD;
#pragma unroll
                for (int jj = 0; jj < 4; ++jj) { const int col = 4 * (F.lane + 64 * jj);
                    const f32x4 g4 = *(const f32x4*)(g + col), sc = *(const f32x4*)(md + sc_off + col), sh = *(const f32x4*)(md + sh_off + col);
                    const f32x4 h = v[q][jj] * rinv * g4 * (1.0f + sc) + sh;
                    u32x2 o; o.x = cvtpk(h.x, h.y); o.y = cvtpk(h.z, h.w);
                    *(u32x2*)(dst + (size_t)m * DM + col) = o; } }
        }
        return;
    }
    const int gw = F.vcu * 8 + F.wave, NGW = F.G * 8;
    for (int m0 = gw; m0 < MT; m0 += 4 * NGW) {
        f32x4 v[4][4]; float s[4];
#pragma unroll
        for (int q = 0; q < 4; ++q) { const int m = m0 + q * NGW; s[q] = 0.f;
            if (m < MT) { const f32x4* xr = (const f32x4*)(src + (size_t)m * DM) + F.lane;
#pragma unroll
                for (int j = 0; j < 4; ++j) v[q][j] = xr[64 * j]; } }
#pragma unroll
        for (int q = 0; q < 4; ++q) { const int m = m0 + q * NGW; if (m >= MT) continue;
#pragma unroll
            for (int j = 0; j < 4; ++j) s[q] += (v[q][j].x * v[q][j].x + v[q][j].y * v[q][j].y) + (v[q][j].z * v[q][j].z + v[q][j].w * v[q][j].w);
            const float rinv = 1.0f / sqrtf(wave_sum(s[q]) * (1.0f / DM) + RMS_EPS);
            const float* md = F.mod + (m >> 12) * NMOD;
#pragma unroll
            for (int j = 0; j < 4; ++j) { const int col = 4 * (F.lane + 64 * j);
                const f32x4 g4 = *(const f32x4*)(g + col), sc = *(const f32x4*)(md + sc_off + col), sh = *(const f32x4*)(md + sh_off + col);
                const f32x4 h = v[q][j] * rinv * g4 * (1.0f + sc) + sh;
                u32x2 o; o.x = cvtpk(h.x, h.y); o.y = cvtpk(h.z, h.w);
                *(u32x2*)(dst + (size_t)m * DM + col) = o; } }
    }
}

using pg8::GU;
struct SchedTiles {
    const char* A; const char* B; int lda, ldb, nt, nM, nN, G, c; int wg = 8;
    __device__ __forceinline__ bool next(int i, GU& u) const {
        int pm, pn; if (!pg8::static_tile(i, G, c, nM, nN, pm, pn, wg)) return false;
        u.A = A + (size_t)pm * 256 * lda; u.B = B + (size_t)pn * 256 * ldb; u.lda = lda; u.ldb = ldb; u.nt = nt; u.zero = 1; u.gslot = 0; u.pm = pm; u.pn = pn; u.aux = 0; u.eslot = 0; return true;
    }
    __device__ __forceinline__ void a_ready(const GU&) const {}
};
struct SchedBranch {
    const char* OA; const char* OB; const char* WaT; const char* WbT; int G, c;
    __device__ __forceinline__ bool next(int i, GU& u) const {
        int pm, pn; if (!pg8::static_tile(i >> 1, G, c, 64, 4, pm, pn)) return false;
        if ((i & 1) == 0) { u.A = OB + (size_t)pm * 256 * 1024; u.B = WbT + (size_t)pn * 256 * 1024; u.lda = 1024; u.ldb = 1024; u.nt = 8; u.zero = 1; u.aux = 0; }
        else { u.A = OA + (size_t)pm * 256 * 512; u.B = WaT + (size_t)pn * 256 * 512; u.lda = 512; u.ldb = 512; u.nt = 4; u.zero = 0; u.aux = 1; }
        u.gslot = 0; u.pm = pm; u.pn = pn; u.eslot = 0; return true;
    }
    __device__ __forceinline__ void a_ready(const GU&) const {}
};
__device__ __forceinline__ int moe_deal(int i, int c, int G, int n4) {
    const int q = n4 / G, r = n4 - q * G, n7 = q + (c < r ? 1 : 0);
    if (i < n7) return i * G + c;
    const int k = i - n7, Lc = G - r; int j;
    if (c >= r) j = k == 0 ? (c - r) : (k == 1 ? Lc + (c - r) : 2 * Lc + (k - 2) * G + c);
    else j = 2 * Lc + k * G + c;
    return j < n4 ? n4 + j : -1;
}
__device__ __forceinline__ void moe_map(int idx, int n4, int& rb, int& pn) {
    const int x = idx & 7, q = idx >> 3, nbh = ((n4 >> 2) + 1) >> 1;
    pn = x & 3; rb = (x >> 2) ? nbh + q : q;
}
struct SchedMoe {
    const char* H; const char* ACT; const char* GUT; const char* DT; const LAS int* rbtab; unsigned* cnt; int n4, n7, G, c;
    __device__ __forceinline__ bool next(int i, GU& u) const {
        const int t = moe_deal(i, c, G, n4); if (t < 0) return false;
        if (t < n4) { int rb, pn; moe_map(t, n4, rb, pn); const int e = rbtab[rb] >> 8;
            u.A = H; u.B = GUT + (size_t)e * (1024 * 2048) + (size_t)pn * 256 * 2048; u.lda = 2048; u.ldb = 2048; u.nt = 16; u.gslot = i; u.eslot = 0; u.pm = rb; u.pn = pn; u.aux = 0; }
        else { int rb, pn; moe_map(t - n4, n4, rb, pn); const int e = rbtab[rb] >> 8;
            u.A = ACT + (size_t)rb * 256 * 1024; u.B = DT + (size_t)e * (1024 * 1024) + (size_t)pn * 256 * 1024; u.lda = 1024; u.ldb = 1024; u.nt = 8; u.gslot = -1; u.eslot = i - n7; u.pm = rb; u.pn = pn; u.aux = 1; }
        u.zero = 1; return true;
    }
    __device__ __forceinline__ void a_ready(const GU& u) const {
        if (u.aux != 1) return;
        if (threadIdx.x < 64) {
            unsigned sp = 0;
            while ((unsigned)__builtin_amdgcn_readfirstlane(__hip_atomic_load(cnt + 64 * u.pm, RLX_AGENT)) < 32u) { __builtin_amdgcn_s_sleep(2); if (++sp > (1u << 20)) break; }
            __builtin_amdgcn_fence(__ATOMIC_ACQUIRE, "agent");
            asm volatile("s_waitcnt vmcnt(0)" ::: "memory");
        }
        asm volatile("" ::: "memory"); __builtin_amdgcn_s_barrier(); asm volatile("" ::: "memory");
    }
};

__device__ __forceinline__ int strided_row(int s, int sh) { return ((s & ((1 << sh) - 1)) << (12 - sh)) | (s >> sh); }

struct EpiIn {
    static constexpr bool PERM = true, AFTER_DRAIN = false, DEFER_PUBLISH = false;
    bf16 *QA, *KA, *VAT, *QB, *KB, *VBT; unsigned char *SGA, *SGB; const float *rcos, *rsin;
    __device__ __forceinline__ void operator()(f32x4 (&acc)[2][2][4][2], const GU& u, int wr, int wc, int fr, int fq) const {
        const int row0 = u.pm * 256 + wr * 64 + fr;
        if (u.pn >= 12) {
            unsigned char* base = (u.pn < 16 ? SGA : SGB) + (size_t)(u.pm * 4 + ((u.pn - 12) & 3)) * 65536 + (size_t)(((wr * 4 + wc) * 64 + fq * 16 + fr) * 16);
#pragma unroll
            for (int ai = 0; ai < 2; ++ai)
#pragma unroll
                for (int m = 0; m < 4; ++m) { u32x4 w;
#pragma unroll
                    for (int bj = 0; bj < 2; ++bj)
#pragma unroll
                        for (int n = 0; n < 2; ++n) { unsigned p = 0;
#pragma unroll
                            for (int j = 0; j < 4; ++j) p = __builtin_amdgcn_cvt_pk_u8_f32(fmaxf(fsigmoid(acc[ai][bj][m][n][j]) * 255.0f, 1.0f), j, p);
                            w[bj * 2 + n] = p; }
                    *(u32x4*)(base + (size_t)(ai * 4 + m) * 8192) = w; }
            return;
        }
#pragma unroll
        for (int bj = 0; bj < 2; ++bj) {
            const int blk = 2 * u.pn + bj;
            const int pc = 32 * (wc & 1) + 8 * fq;
            if (blk < 12 || (blk >= 18 && blk < 23)) {
                const bool isq = (blk < 6) || (blk >= 18 && blk < 22);
                const float sc = isq ? QSCALE : 1.0f;
                const int g4 = 4 * (pc >> 3);
                bf16* base; int hd, nh, sh;
                if (blk < 6) { base = QA; hd = 2 * blk + (wc >> 1); nh = 12; sh = 2 * (hd >> 2); }
                else if (blk < 12) { base = KA; hd = 2 * (blk - 6) + (wc >> 1); nh = 12; sh = 2 * (hd >> 2); }
                else if (blk < 22) { base = QB; hd = 2 * (blk - 18) + (wc >> 1); nh = 8; sh = 0; }
                else { base = KB; hd = (wc >> 1); nh = 2; sh = 0; }
                f32x4 cs[2][4], sn[2][4];
#pragma unroll
                for (int ai = 0; ai < 2; ++ai)
#pragma unroll
                    for (int m = 0; m < 4; ++m) { const size_t ro = (size_t)(row0 + ai * 128 + m * 16) * 32 + g4; cs[ai][m] = *(const f32x4*)(rcos + ro); sn[ai][m] = *(const f32x4*)(rsin + ro); }
#pragma unroll
                for (int ai = 0; ai < 2; ++ai)
#pragma unroll
                    for (int m = 0; m < 4; ++m) {
                        const int row = row0 + ai * 128 + m * 16, b = row >> 12, s = row & 4095;
                        const f32x4 x1 = acc[ai][bj][m][0], x2 = acc[ai][bj][m][1];
                        const f32x4 o1 = (x1 * cs[ai][m] - x2 * sn[ai][m]) * sc, o2 = (x2 * cs[ai][m] + x1 * sn[ai][m]) * sc;
                        u32x4 w; w.x = cvtpk(o1[0], o1[1]); w.y = cvtpk(o1[2], o1[3]); w.z = cvtpk(o2[0], o2[1]); w.w = cvtpk(o2[2], o2[3]);
                        const int srow = strided_row(s, sh), q8 = pc >> 3;
                        *(u32x4*)(base + ((size_t)(b * nh + hd) * 4096 + (srow & ~31)) * 64 + (q8 >> 1) * 512 + (32 * (q8 & 1) + (srow & 31)) * 8) = w;
                    }
            } else if (blk < 24) {
                bf16* base; int hd, nh, sh;
                if (blk < 18) { base = VAT; hd = 2 * (blk - 12) + (wc >> 1); nh = 12; sh = 2 * (hd >> 2); }
                else { base = VBT; hd = (wc >> 1); nh = 2; sh = 0; }
                if (sh == 4) {
#pragma unroll
                    for (int ai = 0; ai < 2; ++ai) {
                        const int row = row0 + ai * 128, b = row >> 12, s = row & 4095;
                        const int srow = strided_row(s, 4), kap = srow & 31;
                        bf16* p = base + ((size_t)(b * nh + hd) * 4096 + (srow & ~31)) * 64 + ((pc >> 5) * 2 + (kap >> 4)) * 512 + (32 * ((kap >> 2) & 1) + (pc & 31)) * 8 + 4 * ((kap >> 3) & 1);
#pragma unroll
                        for (int n = 0; n < 2; ++n)
#pragma unroll
                            for (int j = 0; j < 4; ++j) { u32x2 w; w.x = cvtpk(acc[ai][bj][0][n][j], acc[ai][bj][1][n][j]); w.y = cvtpk(acc[ai][bj][2][n][j], acc[ai][bj][3][n][j]);
                                *(u32x2*)(p + (4 * n + j) * 8) = w; }
                    }
                } else {
#pragma unroll
                for (int ai = 0; ai < 2; ++ai)
#pragma unroll
                    for (int m = 0; m < 4; ++m) {
                        const int row = row0 + ai * 128 + m * 16, b = row >> 12, s = row & 4095;
                        const int srow = strided_row(s, sh), kap = srow & 31;
                        bf16* p = base + ((size_t)(b * nh + hd) * 4096 + (srow & ~31)) * 64 + ((pc >> 5) * 2 + (kap >> 4)) * 512 + (32 * ((kap >> 2) & 1) + (pc & 31)) * 8 + 4 * ((kap >> 3) & 1) + (kap & 3);
                        const f32x4 v0 = acc[ai][bj][m][0], v1 = acc[ai][bj][m][1];
                        const unsigned a = cvtpk(v0[0], v0[1]), bb = cvtpk(v0[2], v0[3]), c = cvtpk(v1[0], v1[1]), d = cvtpk(v1[2], v1[3]);
                        p[0 * 8] = (bf16)(a & 0xffffu); p[1 * 8] = (bf16)(a >> 16); p[2 * 8] = (bf16)(bb & 0xffffu); p[3 * 8] = (bf16)(bb >> 16);
                        p[4 * 8] = (bf16)(c & 0xffffu); p[5 * 8] = (bf16)(c >> 16); p[6 * 8] = (bf16)(d & 0xffffu); p[7 * 8] = (bf16)(d >> 16);
                    }
                }
            }
        }
    }
};

struct EpiMerge {
    static constexpr bool PERM = true, AFTER_DRAIN = false, DEFER_PUBLISH = false;
    const unsigned char *SGA, *SGB; bf16* MERGED;
    __device__ __forceinline__ void operator()(f32x4 (&acc)[2][2][4][2], const GU& u, int wr, int wc, int fr, int fq) const {
        const int row0 = u.pm * 256 + wr * 64 + fr, col0 = u.pn * 256 + wc * 32 + 8 * fq;
        const size_t gbase = (size_t)(u.pm * 4 + u.pn) * 65536 + (size_t)(((wr * 4 + wc) * 64 + fq * 16 + fr) * 16);
#pragma unroll
        for (int ai = 0; ai < 2; ++ai)
#pragma unroll
            for (int m = 0; m < 4; ++m) {
                const u32x4 ga = *(const u32x4*)(SGA + gbase + (size_t)(ai * 4 + m) * 8192);
                if (u.aux == 0) {
                    const u32x4 gb = *(const u32x4*)(SGB + gbase + (size_t)(ai * 4 + m) * 8192);
#pragma unroll
                    for (int bj = 0; bj < 2; ++bj)
#pragma unroll
                        for (int n = 0; n < 2; ++n)
#pragma unroll
                            for (int j = 0; j < 4; ++j) acc[ai][bj][m][n][j] *= (float)((gb[bj * 2 + n] >> (8 * j)) & 255u) * frcp((float)((ga[bj * 2 + n] >> (8 * j)) & 255u));
                } else {
#pragma unroll
                    for (int bj = 0; bj < 2; ++bj) { f32x4 v0, v1;
#pragma unroll
                        for (int j = 0; j < 4; ++j) { v0[j] = acc[ai][bj][m][0][j] * ((float)((ga[bj * 2] >> (8 * j)) & 255u) * (1.0f / 255.0f)); v1[j] = acc[ai][bj][m][1][j] * ((float)((ga[bj * 2 + 1] >> (8 * j)) & 255u) * (1.0f / 255.0f)); }
                        u32x4 w; w.x = cvtpk(v0[0], v0[1]); w.y = cvtpk(v0[2], v0[3]); w.z = cvtpk(v1[0], v1[1]); w.w = cvtpk(v1[2], v1[3]);
                        *(u32x4*)(MERGED + (size_t)(row0 + ai * 128 + m * 16) * DM + col0 + bj * 128) = w; }
                }
            }
    }
};

struct EpiX1 {
    static constexpr bool PERM = true, AFTER_DRAIN = false, DEFER_PUBLISH = false;
    const float* x; const float* mod; bf16* X1;
    __device__ __forceinline__ void operator()(f32x4 (&acc)[2][2][4][2], const GU& u, int wr, int wc, int fr, int fq) const {
        const int row0 = u.pm * 256 + wr * 64 + fr, col0 = u.pn * 256 + wc * 32 + 8 * fq, b = (u.pm * 256) >> 12;
        const float* gt = mod + b * NMOD + 2 * DM;
#pragma unroll
        for (int bj = 0; bj < 2; ++bj) { const int col = col0 + bj * 128; const f32x4 g0 = *(const f32x4*)(gt + col), g1 = *(const f32x4*)(gt + col + 4);
#pragma unroll
            for (int ai = 0; ai < 2; ++ai)
#pragma unroll
                for (int m = 0; m < 4; ++m) { const size_t off = (size_t)(row0 + ai * 128 + m * 16) * DM + col;
                    const f32x4 v0 = __builtin_nontemporal_load((const f32x4*)(x + off)) + g0 * acc[ai][bj][m][0], v1 = __builtin_nontemporal_load((const f32x4*)(x + off + 4)) + g1 * acc[ai][bj][m][1];
                    u32x4 w; w.x = cvtpk(v0[0], v0[1]); w.y = cvtpk(v0[2], v0[3]); w.z = cvtpk(v1[0], v1[1]); w.w = cvtpk(v1[2], v1[3]);
                    *(u32x4*)(X1 + off) = w; } }
    }
};

struct EpiMoe {
    static constexpr bool PERM = true, AFTER_DRAIN = false, DEFER_PUBLISH = true;
    bf16* ACT; bf16* Y; const LAS int* dtab; const LAS float* wtab; unsigned* cnt;
    __device__ __forceinline__ bool wants_publish(const GU& u) const { return u.aux == 0; }
    __device__ __forceinline__ void publish(int rb, int lane) const { if (lane == 0) __hip_atomic_fetch_add(cnt + 64 * rb, 1u, RLX_AGENT); }
    __device__ __forceinline__ void operator()(f32x4 (&acc)[2][2][4][2], const GU& u, int wr, int wc, int fr, int fq) const {
        if (u.aux == 0) {
            const int row0 = u.pm * 256 + wr * 64 + fr, col0 = u.pn * 128 + wc * 32 + 8 * fq;
#pragma unroll
            for (int ai = 0; ai < 2; ++ai)
#pragma unroll
                for (int m = 0; m < 4; ++m) { f32x4 a0, a1;
#pragma unroll
                    for (int j = 0; j < 4; ++j) { const float g0 = acc[ai][0][m][0][j], g1 = acc[ai][0][m][1][j]; a0[j] = g0 * fsigmoid(g0) * acc[ai][1][m][0][j]; a1[j] = g1 * fsigmoid(g1) * acc[ai][1][m][1][j]; }
                    u32x4 w; w.x = cvtpk(a0[0], a0[1]); w.y = cvtpk(a0[2], a0[3]); w.z = cvtpk(a1[0], a1[1]); w.w = cvtpk(a1[2], a1[3]);
                    st16_sc1(ACT + (size_t)(row0 + ai * 128 + m * 16) * DEXP + col0, w); }
        } else {
            const int r0 = wr * 64 + fr, col0 = u.pn * 256 + wc * 32 + 8 * fq;
#pragma unroll
            for (int ai = 0; ai < 2; ++ai)
#pragma unroll
                for (int m = 0; m < 4; ++m) { const int r = r0 + ai * 128 + m * 16; const int dest = dtab[u.eslot * 256 + r]; const float w = wtab[u.eslot * 256 + r];
                    if (dest >= 0) {
#pragma unroll
                        for (int bj = 0; bj < 2; ++bj) { const f32x4 v0 = acc[ai][bj][m][0] * w, v1 = acc[ai][bj][m][1] * w;
                            u32x4 o; o.x = cvtpk(v0[0], v0[1]); o.y = cvtpk(v0[2], v0[3]); o.z = cvtpk(v1[0], v1[1]); o.w = cvtpk(v1[2], v1[3]);
                            *(u32x4*)(Y + (size_t)dest * DM + col0 + bj * 128) = o; } } }
        }
    }
};

#define MFMA32(a, b, c) __builtin_amdgcn_mfma_f32_32x32x16_bf16((a), (b), (c), 0, 0, 0)
__device__ __forceinline__ int crow(int reg, int h) { return (reg & 3) + 8 * (reg >> 2) + 4 * h; }
struct KVFrag { bf16x8 k[4], v[4]; };
#define GLD16(dst, ptr, OFF) asm volatile("global_load_dwordx4 %0, %1, off offset:" #OFF : "=v"(dst) : "v"(ptr) : "memory")
__device__ __forceinline__ void kv_load(KVFrag& f, const bf16* kp, const bf16* vp) {
    GLD16(f.k[0], kp, 0); GLD16(f.k[1], kp, 1024); GLD16(f.k[2], kp, 2048); GLD16(f.k[3], kp, 3072);
    GLD16(f.v[0], vp, 0); GLD16(f.v[1], vp, 1024); GLD16(f.v[2], vp, 2048); GLD16(f.v[3], vp, 3072);
}
#define KV_WAIT(f, N) asm volatile("s_waitcnt vmcnt(" #N ")" : "+v"(f.k[0]), "+v"(f.k[1]), "+v"(f.k[2]), "+v"(f.k[3]), "+v"(f.v[0]), "+v"(f.v[1]), "+v"(f.v[2]), "+v"(f.v[3]) :: "memory")
__device__ __forceinline__ void attn_tile(const KVFrag& f, const bf16x8 (&qf)[4], bool first, bool lastt, int r, int h, float& m, float& l, f32x16& o0, f32x16& o1) {
    f32x16 st;
#pragma unroll
    for (int e = 0; e < 16; ++e) st[e] = 0.f;
#pragma unroll
    for (int c = 0; c < 4; ++c) st = MFMA32(f.k[c], qf[c], st);
    if (first || lastt) {
        int rq = r - 4 * h; asm volatile("" : "+v"(rq));
        if (first) {
#pragma unroll
            for (int e = 0; e < 16; ++e) st[e] = ((e & 3) + 8 * (e >> 2) < rq) ? -1.0e30f : st[e];
        } else {
#pragma unroll
            for (int e = 0; e < 16; ++e) st[e] = ((e & 3) + 8 * (e >> 2) > rq) ? -1.0e30f : st[e];
        }
    }
    float tm = st[0];
#pragma unroll
    for (int e = 1; e < 16; ++e) tm = fmaxf(tm, st[e]);
    { auto rr = __builtin_amdgcn_permlane32_swap(__float_as_uint(tm), __float_as_uint(tm), false, false); tm = fmaxf(__uint_as_float(rr[0]), __uint_as_float(rr[1])); }
    const float mn = fmaxf(m, tm), alpha = fexp2(m - mn); m = mn;
    float ps = 0.f;
#pragma unroll
    for (int e = 0; e < 16; ++e) { st[e] = fexp2(st[e] - mn); ps += st[e]; }
    l = l * alpha + ps;
#pragma unroll
    for (int e = 0; e < 16; ++e) { o0[e] *= alpha; o1[e] *= alpha; }
    u32x4 pa, pb;
    pa.x = cvtpk(st[0], st[1]); pa.y = cvtpk(st[2], st[3]); pa.z = cvtpk(st[4], st[5]); pa.w = cvtpk(st[6], st[7]);
    pb.x = cvtpk(st[8], st[9]); pb.y = cvtpk(st[10], st[11]); pb.z = cvtpk(st[12], st[13]); pb.w = cvtpk(st[14], st[15]);
    const bf16x8 p0 = __builtin_bit_cast(bf16x8, pa), p1 = __builtin_bit_cast(bf16x8, pb);
    o0 = MFMA32(f.v[0], p0, o0); o0 = MFMA32(f.v[1], p1, o0);
    o1 = MFMA32(f.v[2], p0, o1); o1 = MFMA32(f.v[3], p1, o1);
}
template <int W>
__device__ __forceinline__ void attn_job(const bf16* __restrict__ Qp, const bf16* __restrict__ Kp, const bf16* __restrict__ Vp, int L, int t0, float m0, float l0,
                                         f32x16& o0, f32x16& o1, float& m_out, float& l_out, int lane) {
    constexpr int NT = 2 * W / 32 + 1;
    const int r = lane & 31, h = lane >> 5;
    bf16x8 qf[4];
    { const bf16* qp = Qp + (size_t)(t0 >> 5) * 2048 + lane * 8; GLD16(qf[0], qp, 0); GLD16(qf[1], qp, 1024); GLD16(qf[2], qp, 2048); GLD16(qf[3], qp, 3072); }
    float m = m0, l = (h == 0) ? l0 : 0.f;
#pragma unroll
    for (int i = 0; i < 16; ++i) { o0[i] = 0.f; o1[i] = 0.f; }
    const int i_lo = (W - t0) > 0 ? ((W - t0) >> 5) : 0, i_hi = ((L - t0 + W) >> 5) < NT ? ((L - t0 + W) >> 5) : NT;
    const bf16* kq = Kp + lane * 8; const bf16* vq = Vp + lane * 8;
#define TILE_OFF(ii) ((size_t)((t0 - W + 32 * ((ii) < i_hi ? (ii) : i_hi - 1)) >> 5) * 2048)
    KVFrag fa, fb;
    int i = i_lo;
    kv_load(fa, kq + TILE_OFF(i), vq + TILE_OFF(i));
#pragma unroll 1
    for (;;) {
        kv_load(fb, kq + TILE_OFF(i + 1), vq + TILE_OFF(i + 1));
        KV_WAIT(fa, 8); asm volatile("" : "+v"(qf[0]), "+v"(qf[1]), "+v"(qf[2]), "+v"(qf[3]));
        attn_tile(fa, qf, i == 0, i == NT - 1, r, h, m, l, o0, o1);
        if (++i >= i_hi) break;
        kv_load(fa, kq + TILE_OFF(i + 1), vq + TILE_OFF(i + 1));
        KV_WAIT(fb, 8);
        attn_tile(fb, qf, i == 0, i == NT - 1, r, h, m, l, o0, o1);
        if (++i >= i_hi) break;
    }
    KV_WAIT(fa, 0); KV_WAIT(fb, 0);
#undef TILE_OFF
    l += __shfl_xor(l, 32);
    m_out = m; l_out = l;
}

constexpr int PSTRIDE = 136;
__device__ __forceinline__ void attn_phase(Frame& F) {
    LAS unsigned char* P = F.lds;
    LAS f32x2* ML = (LAS f32x2*)(F.lds + 3 * 256 * PSTRIDE);
    const int lane = F.lane, r = lane & 31, h = lane >> 5;
    for (int uidx = F.vcu; uidx < 512; uidx += F.G) {
        if (uidx < 256) {
            const int b = uidx >> 6, hs = (uidx >> 4) & 3, c = uidx & 15;
#pragma unroll 1
            for (int jj = 0; jj < 4; ++jj) {
                const int j = F.wave + 8 * jj;
                int g, head, res, t0, L, slot; bool valid = true;
                if (j < 8) { g = 0; head = hs; res = 0; t0 = 256 * c + 32 * j; L = 4096; slot = 32 * j + r; }
                else if (j < 16) { const int q = j - 8; g = 1; head = 4 + hs; res = q >> 1; t0 = 64 * c + 32 * (q & 1); L = 1024; slot = res * 64 + 32 * (q & 1) + r; }
                else { const int q = j - 16; g = 2; head = 8 + hs; res = q; t0 = 32 * (c >> 1); L = 256; valid = (r >> 4) == (c & 1); slot = res * 16 + (r & 15); }
                const size_t hb = (size_t)(b * 12 + head);
                const bf16* Qp = F.QA + (hb * 4096 + (size_t)res * L) * 64;
                const bf16* Kp = F.KA + (hb * 4096 + (size_t)res * L) * 64;
                const bf16* Vt = F.VAT + (hb * 4096 + (size_t)res * L) * 64;
                f32x16 o0, o1; float m, l;
                attn_job<64>(Qp, Kp, Vt, L, t0, -1.0e30f, 0.f, o0, o1, m, l, lane);
                if (valid) {
                    LAS unsigned char* row = P + (g * 256 + slot) * PSTRIDE;
#pragma unroll
                    for (int q4 = 0; q4 < 4; ++q4) {
                        u32x2 w0, w1; w0.x = cvtpk(o0[4 * q4], o0[4 * q4 + 1]); w0.y = cvtpk(o0[4 * q4 + 2], o0[4 * q4 + 3]); w1.x = cvtpk(o1[4 * q4], o1[4 * q4 + 1]); w1.y = cvtpk(o1[4 * q4 + 2], o1[4 * q4 + 3]);
                        *(LAS u32x2*)(row + (8 * q4 + 4 * h) * 2) = w0; *(LAS u32x2*)(row + (32 + 8 * q4 + 4 * h) * 2) = w1; }
                    if (h == 0) ML[g * 256 + slot] = (f32x2){m, l};
                }
            }
            __syncthreads();
            {
                const int tau = F.tid >> 1, half = F.tid & 1;
                const int s0 = tau, s1 = 256 + (tau & 3) * 64 + (tau >> 2), s2 = 512 + (tau & 15) * 16 + (tau >> 4);
                const f32x2 a0 = ML[s0], a1 = ML[s1], a2 = ML[s2];
                const float M = fmaxf(a0.x, fmaxf(a1.x, a2.x));
                float w0 = fexp2(a0.x - M), w1 = fexp2(a1.x - M), w2 = fexp2(a2.x - M);
                const float inv = 1.0f / (w0 * a0.y + w1 * a1.y + w2 * a2.y); w0 *= inv; w1 *= inv; w2 *= inv;
                bf16* dst = F.OA + (size_t)(b * 4096 + 256 * c + tau) * 256 + hs * 64 + 32 * half;
#pragma unroll
                for (int q = 0; q < 4; ++q) {
                    const u32x4 x0 = *(const LAS u32x4*)(P + s0 * PSTRIDE + (32 * half + 8 * q) * 2), x1 = *(const LAS u32x4*)(P + s1 * PSTRIDE + (32 * half + 8 * q) * 2), x2 = *(const LAS u32x4*)(P + s2 * PSTRIDE + (32 * half + 8 * q) * 2);
                    u32x4 o;
#pragma unroll
                    for (int k = 0; k < 4; ++k) { const float lo = w0 * bflo(x0[k]) + w1 * bflo(x1[k]) + w2 * bflo(x2[k]), hi = w0 * bfhi(x0[k]) + w1 * bfhi(x1[k]) + w2 * bfhi(x2[k]); o[k] = cvtpk(lo, hi); }
                    *(u32x4*)(dst + 8 * q) = o; }
            }
            __syncthreads();
        } else {
            const int uu = uidx - 256, b = uu >> 6, kvh = (uu >> 5) & 1, qb = uu & 31, T0 = 4 * qb - 4;
            const bf16* Kb_ = F.KB + (size_t)(b * 2 + kvh) * 4096 * 64; const bf16* Vb_ = F.VBT + (size_t)(b * 2 + kvh) * 4096 * 64;
            for (int x = F.wave; x < 24; x += 8) { const int j = x >> 1, kv = x & 1, T = T0 + j; if (T < 0 || T > 127) continue;
                const bf16* src = (kv ? Vb_ : Kb_) + (size_t)T * 2048 + lane * 8;
#pragma unroll
                for (int c = 0; c < 4; ++c) __builtin_amdgcn_global_load_lds((const unsigned*)(src + c * 512), (LAS unsigned*)(F.lds + j * 8192 + kv * 4096 + c * 1024), 16, 0, 0); }
            VM_WAIT(); __syncthreads();
#pragma unroll 1
            for (int jj = 0; jj < 2; ++jj) {
                const int j = F.wave + 8 * jj, head = kvh * 4 + (j >> 2), qt = j & 3, t0 = 128 * qb + 32 * qt;
                const bf16* Qp = F.QB + (size_t)(b * 8 + head) * 4096 * 64 + (size_t)(t0 >> 5) * 2048 + lane * 8;
                bf16x8 qf[4];
#pragma unroll
                for (int c = 0; c < 4; ++c) qf[c] = *(const bf16x8*)(Qp + c * 512);
                float m = F.sink[head] * LOG2E, l = (h == 0) ? 1.0f : 0.f;
                f32x16 o0, o1;
#pragma unroll
                for (int e = 0; e < 16; ++e) { o0[e] = 0.f; o1[e] = 0.f; }
#pragma unroll 1
                for (int i = 0; i < 9; ++i) { const int T = T0 + qt + i; if (T < 0 || T > 127) continue;
                    const LAS unsigned char* tp = F.lds + (qt + i) * 8192 + lane * 16;
                    KVFrag f;
#pragma unroll
                    for (int c = 0; c < 4; ++c) { f.k[c] = *(const LAS bf16x8*)(tp + c * 1024); f.v[c] = *(const LAS bf16x8*)(tp + 4096 + c * 1024); }
                    attn_tile(f, qf, i == 0, i == 8, r, h, m, l, o0, o1); }
                l += __shfl_xor(l, 32);
                const float inv = 1.0f / l;
                bf16* dst = F.OB + (size_t)(b * 4096 + t0 + r) * 512 + head * 64;
#pragma unroll
                for (int q4 = 0; q4 < 4; ++q4) {
                    u32x2 w0, w1; w0.x = cvtpk(o0[4 * q4] * inv, o0[4 * q4 + 1] * inv); w0.y = cvtpk(o0[4 * q4 + 2] * inv, o0[4 * q4 + 3] * inv);
                    w1.x = cvtpk(o1[4 * q4] * inv, o1[4 * q4 + 1] * inv); w1.y = cvtpk(o1[4 * q4 + 2] * inv, o1[4 * q4 + 3] * inv);
                    *(u32x2*)(dst + 8 * q4 + 4 * h) = w0; *(u32x2*)(dst + 32 + 8 * q4 + 4 * h) = w1; }
            }
            __syncthreads();
        }
    }
}

__device__ __forceinline__ void norm_route_phase(Frame& F, int bank) {
    LAS unsigned char* A = F.lds;
    const int lane = F.lane, w = F.wave;
    for (int u = F.vcu; u < MT / 64; u += F.G) {
        {
            u32x4 xv[8][2];
#pragma unroll
            for (int q = 0; q < 8; ++q) { const u32x4* xr = (const u32x4*)(F.X1 + (size_t)(64 * u + 8 * w + q) * DM) + lane; xv[q][0] = xr[0]; xv[q][1] = xr[64]; }
            f32x4 gg[2][2], sc[2][2], sh[2][2];
            const float* md = F.mod + ((64 * u) >> 12) * NMOD;
#pragma unroll
            for (int j = 0; j < 2; ++j)
#pragma unroll
                for (int hh = 0; hh < 2; ++hh) { const int col = 8 * (lane + 64 * j) + 4 * hh; gg[j][hh] = *(const f32x4*)(F.g_ffn + col); sc[j][hh] = *(const f32x4*)(md + 4 * DM + col) + 1.0f; sh[j][hh] = *(const f32x4*)(md + 3 * DM + col); }
#pragma unroll
            for (int q = 0; q < 8; ++q) {
                const int rl = 8 * w + q, m = 64 * u + rl; float ss = 0.f; f32x4 f[2][2];
#pragma unroll
                for (int j = 0; j < 2; ++j) { f[j][0] = (f32x4){bflo(xv[q][j].x), bfhi(xv[q][j].x), bflo(xv[q][j].y), bfhi(xv[q][j].y)}; f[j][1] = (f32x4){bflo(xv[q][j].z), bfhi(xv[q][j].z), bflo(xv[q][j].w), bfhi(xv[q][j].w)};
#pragma unroll
                    for (int hh = 0; hh < 2; ++hh) ss += (f[j][hh].x * f[j][hh].x + f[j][hh].y * f[j][hh].y) + (f[j][hh].z * f[j][hh].z + f[j][hh].w * f[j][hh].w); }
                const float rinv = 1.0f / sqrtf(wave_sum(ss) * (1.0f / DM) + RMS_EPS);
#pragma unroll
                for (int j = 0; j < 2; ++j) { const int col = 8 * (lane + 64 * j);
                    const f32x4 h0 = f[j][0] * rinv * gg[j][0] * sc[j][0] + sh[j][0], h1 = f[j][1] * rinv * gg[j][1] * sc[j][1] + sh[j][1];
                    u32x4 o; o.x = cvtpk(h0.x, h0.y); o.y = cvtpk(h0.z, h0.w); o.z = cvtpk(h1.x, h1.y); o.w = cvtpk(h1.z, h1.w);
                    *(u32x4*)(F.H + (size_t)m * DM + col) = o;
                    *(LAS u32x4*)(A + rl * 2048 + ((((col >> 3) ^ (rl & 15))) << 4)) = o; }
            }
        }
        __syncthreads();
        const int rt = w & 1, ct = (w >> 1) & 1, kq = w >> 2, r = lane & 31, h = lane >> 5;
        f32x16 acc;
#pragma unroll
        for (int e = 0; e < 16; ++e) acc[e] = 0.f;
        {
            const bf16* bp = F.WrT + (size_t)(32 * ct + r) * DM + 512 * kq + 8 * h;
            const int arow = 32 * rt + r;
            const LAS unsigned char* ap = A + arow * 2048;
#pragma unroll 8
            for (int ks = 0; ks < 32; ++ks) {
                const bf16x8 bf = *(const bf16x8*)(bp + 16 * ks);
                const int chunk = 64 * kq + 2 * ks + h;
                const bf16x8 af = *(const LAS bf16x8*)(ap + ((chunk ^ (arow & 15)) << 4));
                acc = MFMA32(af, bf, acc);
            }
        }
        __syncthreads();
        LAS float* P = (LAS float*)F.lds;
        LAS int* lcnt = (LAS int*)(F.lds + 2 * 64 * 68 * 4);
#pragma unroll
        for (int e = 0; e < 16; ++e) P[(kq * 64 + 32 * rt + crow(e, h)) * 68 + 32 * ct + r] = acc[e];
        if (F.tid < 64) lcnt[F.tid] = 0;
        __syncthreads();
        int e1 = 0, e2 = 0, p1 = 0, p2 = 0; float w1 = 0.f, w2 = 0.f;
        if (F.tid < 64) {
            const LAS float* q0 = P + F.tid * 68; const LAS float* q1 = P + (64 + F.tid) * 68;
            float gl[4]; float gmax = -3.0e38f; int gs = 0;
#pragma unroll
            for (int j = 0; j < 4; ++j) { gl[j] = q0[j] + q1[j] + F.b_group[j]; if (gl[j] > gmax) { gmax = gl[j]; gs = j; } }
            float gz = 0.f;
#pragma unroll
            for (int j = 0; j < 4; ++j) gz += __expf(gl[j] - gmax);
            const float gw = 1.0f / gz;
            float el[8]; float m1 = -3.0e38f; int i1 = 0;
#pragma unroll
            for (int j = 0; j < 8; ++j) { el[j] = q0[4 + 8 * gs + j] + q1[4 + 8 * gs + j] + F.b_route[8 * gs + j]; if (el[j] > m1) { m1 = el[j]; i1 = j; } }
            float m2 = -3.0e38f; int i2 = 0;
#pragma unroll
            for (int j = 0; j < 8; ++j) { if (j != i1 && el[j] > m2) { m2 = el[j]; i2 = j; } }
            const float q2 = __expf(m2 - m1), inv = 1.0f / (1.0f + q2);
            w1 = inv * gw; w2 = q2 * inv * gw; e1 = 8 * gs + i1; e2 = 8 * gs + i2;
            p1 = atomicAdd((int*)(lcnt + e1), 1); p2 = atomicAdd((int*)(lcnt + e2), 1);
        } else if (F.wave >= 1) bg_step(F);
        __syncthreads();
        const int shard = F.bx & 7;
        if (F.tid < 32) { const int c = lcnt[F.tid]; lcnt[32 + F.tid] = c ? (int)__hip_atomic_fetch_add(F.ctl + CW_CNT + bank * 49152 + 64 * (32 * shard + F.tid), (unsigned)c, RLX_AGENT) : 0; }
        __syncthreads();
        if (F.tid < 64) {
            const int tok = 64 * u + F.tid;
            F.list[(bank << 20) + ((32 * shard + e1) << 12) + lcnt[32 + e1] + p1] = 2 * tok; F.wts[2 * tok] = w1;
            F.list[(bank << 20) + ((32 * shard + e2) << 12) + lcnt[32 + e2] + p2] = 2 * tok + 1; F.wts[2 * tok + 1] = w2;
        }
        __syncthreads();
    }
}

__device__ __forceinline__ void moe_setup(Frame& F, int& n4_out, int& n7_out) {
    LAS int* rbtab = (LAS int*)(F.lds + TAB_RB); LAS int* cnttab = (LAS int*)(F.lds + TAB_CNT); LAS int* nbw = (LAS int*)(F.lds + TAB_NB);
    LAS int* gidx = (LAS int*)(F.lds + TAB_GIDX); LAS int* dtab = (LAS int*)(F.lds + TAB_D); LAS float* wtab = (LAS float*)(F.lds + TAB_W);
    LAS int* pref = (LAS int*)(F.lds + TAB_PREF);
    if (F.tid < 256) pref[(F.tid & 31) * 8 + (F.tid >> 5)] = (int)__hip_atomic_load(F.ctl + CW_CNT + 64 * F.tid, RLX_AGENT);
    __syncthreads();
    if (F.tid < 64) {
        int cnt = 0;
        if (F.tid < 32) { for (int sh = 0; sh < 8; ++sh) { const int c = pref[F.tid * 8 + sh]; pref[F.tid * 8 + sh] = cnt; cnt += c; } }
        const int nb = (cnt + 255) >> 8; int incl = nb;
#pragma unroll
        for (int o = 1; o < 32; o <<= 1) { const int t = __shfl_up(incl, o); if (F.lane >= o) incl += t; }
        if (F.tid < 32) { cnttab[F.tid] = cnt; const int st = incl - nb; for (int j = 0; j < nb; ++j) rbtab[st + j] = (F.tid << 8) | j; }
        if (F.tid == 31) nbw[0] = incl;
    }
    __syncthreads();
    const int n4 = 4 * nbw[0];
    const int n7 = n4 / F.G + (F.bx < n4 % F.G ? 1 : 0);
    for (int i = 0; i < 7; ++i) { const int t = moe_deal(i, F.bx, F.G, n4); if (t < 0) break;
        const bool down = t >= n4; int rb, pnx; moe_map(down ? t - n4 : t, n4, rb, pnx); const int slot = down ? i - n7 : i;
        if (slot < 3 && F.tid < 256) { const int v = rbtab[rb], e = v >> 8, j = v & 255; const int nvalid = cnttab[e] - 256 * j;
            int val = -1;
            if (F.tid < nvalid) { const int q = 256 * j + F.tid; int sh = 0;
#pragma unroll
                for (int k = 1; k < 8; ++k) sh += (pref[e * 8 + k] <= q) ? 1 : 0;
                val = F.list[((32 * sh + e) << 12) + q - pref[e * 8 + sh]]; }
            if (!down) gidx[slot * 256 + F.tid] = val >= 0 ? (val >> 1) : 0;
            else { dtab[slot * 256 + F.tid] = val; wtab[slot * 256 + F.tid] = val >= 0 ? F.wts[val] : 0.f; } } }
    __syncthreads();
    n4_out = n4; n7_out = n7;
}

__device__ __forceinline__ void final_rows(Frame& F) {
    const int gw = F.vcu * 8 + F.wave, NGW = F.G * 8;
    for (int m0 = gw; m0 < MT; m0 += 2 * NGW) {
        u32x4 xa[2][2], ya[2][2], yb[2][2];
#pragma unroll
        for (int q = 0; q < 2; ++q) { const int m = m0 + q * NGW; if (m < MT) {
            const u32x4* xr = (const u32x4*)(F.X1 + (size_t)m * DM) + F.lane; const u32x4* y0 = (const u32x4*)(F.Y + (size_t)(2 * m) * DM) + F.lane; const u32x4* y1 = (const u32x4*)(F.Y + (size_t)(2 * m + 1) * DM) + F.lane;
#pragma unroll
            for (int j = 0; j < 2; ++j) { xa[q][j] = xr[64 * j]; ya[q][j] = y0[64 * j]; yb[q][j] = y1[64 * j]; } } }
#pragma unroll
        for (int q = 0; q < 2; ++q) { const int m = m0 + q * NGW; if (m >= MT) continue;
            const float* gt = F.mod + (m >> 12) * NMOD + 5 * DM; float s = 0.f; f32x4 v[2][2];
#pragma unroll
            for (int j = 0; j < 2; ++j)
#pragma unroll
                for (int hh = 0; hh < 2; ++hh) { const int col = 8 * (F.lane + 64 * j) + 4 * hh; const f32x4 g = *(const f32x4*)(gt + col);
                    const unsigned x0 = hh ? xa[q][j].z : xa[q][j].x, x1 = hh ? xa[q][j].w : xa[q][j].y, a0 = hh ? ya[q][j].z : ya[q][j].x, a1 = hh ? ya[q][j].w : ya[q][j].y, b0 = hh ? yb[q][j].z : yb[q][j].x, b1 = hh ? yb[q][j].w : yb[q][j].y;
                    const f32x4 xs = {bflo(x0), bfhi(x0), bflo(x1), bfhi(x1)}, ys = {bflo(a0) + bflo(b0), bfhi(a0) + bfhi(b0), bflo(a1) + bflo(b1), bfhi(a1) + bfhi(b1)};
                    v[j][hh] = xs + g * ys; s += (v[j][hh].x * v[j][hh].x + v[j][hh].y * v[j][hh].y) + (v[j][hh].z * v[j][hh].z + v[j][hh].w * v[j][hh].w); }
            const float rinv = 1.0f / sqrtf(wave_sum(s) * (1.0f / DM) + RMS_EPS);
#pragma unroll
            for (int j = 0; j < 2; ++j)
#pragma unroll
                for (int hh = 0; hh < 2; ++hh) { const int col = 8 * (F.lane + 64 * j) + 4 * hh; *(f32x4*)(F.out + (size_t)m * DM + col) = v[j][hh] * rinv * *(const f32x4*)(F.g_final + col); }
        }
    }
}

struct Args { const void* in[20]; float* out; unsigned char* ws; int ph_lo, ph_hi, li, pad; };
__global__ void __launch_bounds__(512, 2) fwd_kernel(Args args) {
    extern __shared__ __attribute__((aligned(16))) unsigned char lds[];
    Frame F;
    F.lds = (LAS unsigned char*)lds;
    F.tid = threadIdx.x; F.lane = F.tid & 63; F.wave = __builtin_amdgcn_readfirstlane(F.tid >> 6);
    F.G = gridDim.x; F.bx = blockIdx.x; F.vcu = (F.G % 8 == 0) ? (F.bx % 8) * (F.G / 8) + F.bx / 8 : F.bx;
    unsigned char* ws = args.ws;
    F.ctl = (unsigned*)(ws + WS_CTL);
    F.x = (const float*)args.in[0]; F.c = (const float*)args.in[1]; F.positions = (const int*)args.in[2]; F.w_ada = (const float*)args.in[3]; F.b_ada = (const float*)args.in[4];
    F.g_mix = (const float*)args.in[5]; F.w_in = (const float*)args.in[6]; F.sink = (const float*)args.in[7]; F.w_a = (const float*)args.in[8]; F.w_b = (const float*)args.in[9];
    F.w_out = (const float*)args.in[10]; F.g_ffn = (const float*)args.in[11]; F.w_group = (const float*)args.in[12]; F.b_group = (const float*)args.in[13]; F.w_route = (const float*)args.in[14];
    F.b_route = (const float*)args.in[15]; F.w_gate = (const float*)args.in[16]; F.w_up = (const float*)args.in[17]; F.w_down = (const float*)args.in[18]; F.g_final = (const float*)args.in[19];
    F.out = args.out;
    F.mod = (float*)(ws + WS_MOD); F.rcos = (float*)(ws + WS_RCOS); F.rsin = (float*)(ws + WS_RSIN); F.wts = (float*)(ws + WS_WTS); F.list = (int*)(ws + WS_LIST);
    F.WrT = (bf16*)(ws + WS_WRT); F.WaT = (bf16*)(ws + WS_WAT); F.WbT = (bf16*)(ws + WS_WBT); F.WoT = (bf16*)(ws + WS_WOT); F.WinT = (bf16*)(ws + WS_WINT); F.GUT = (bf16*)(ws + WS_GUT); F.DT = (bf16*)(ws + WS_DT);
    F.H = (bf16*)(ws + WS_H); F.OA = (bf16*)(ws + WS_OA); F.OB = (bf16*)(ws + WS_OB); F.QA = (bf16*)(ws + WS_QA); F.KA = (bf16*)(ws + WS_KA); F.VAT = (bf16*)(ws + WS_VAT);
    F.QB = (bf16*)(ws + WS_QB); F.KB = (bf16*)(ws + WS_KB); F.VBT = (bf16*)(ws + WS_VBT); F.MERGED = (bf16*)(ws + WS_MERGED); F.ACT = (bf16*)(ws + WS_ACT); F.Y = (bf16*)(ws + WS_Y);
    F.X1 = (bf16*)(ws + WS_X1);
    F.SGA = (unsigned char*)args.out; F.SGB = (unsigned char*)args.out + (size_t)MT * DM;
    for (int u = F.tid; u < (LDS_BYTES - MISC_OFF) / 4; u += 512) ((LAS unsigned*)(F.lds + MISC_OFF))[u] = 0u;
    __syncthreads();
    F.bg_done = 0;
#if MK_PER_PHASE
#define GRID_BAR() do {} while (0)
#else
    XcdBarrier bar = xcd_barrier_post(F.ctl + CW_BAR + args.li * XCD_BAR_WORDS, (volatile LAS unsigned*)(F.lds + MISC_OFF));
#define GRID_BAR() xcd_barrier(bar)
#endif
    volatile LAS unsigned* relw = (volatile LAS unsigned*)(F.lds + MISC_OFF + 64);
    const int lo = args.ph_lo, hi = args.ph_hi;
#define IN(k) (lo <= (k) && (k) < hi)
#if MK_PER_PHASE
#define SEAM(k) do { if ((k) == 5) { while (bg_step(F)) {} } } while (0)
#else
#define SEAM(k) do { if ((k) == 5) { while (bg_step(F)) {} }         \
        if (IN(k) && IN((k) + 1)) { if ((k) < 5) xcd_barrier_bg(bar, F, relw, (unsigned)(k) + 1u); else GRID_BAR(); } } while (0)
#endif

#define PHASE_BEGIN(k) if (IN(k)) {
#define PHASE_END(k) SEAM(k); }
    PHASE_BEGIN(0) p0_prologue(F); norm_rows(F, F.x, F.g_mix, 0, DM, F.H); PHASE_END(0)
    PHASE_BEGIN(1)
        SchedTiles S{(const char*)F.H, (const char*)F.WinT, 2048, 2048, 16, 64, 20, F.G, F.bx, 1};
        EpiIn E{F.QA, F.KA, F.VAT, F.QB, F.KB, F.VBT, F.SGA, F.SGB, F.rcos, F.rsin};
        pg8::gemm_run<EpiIn, SchedTiles, false, true>(F.lds, nullptr, S, E);
    PHASE_END(1)
    PHASE_BEGIN(2) attn_phase(F); PHASE_END(2)
    PHASE_BEGIN(3)
        SchedBranch S{(const char*)F.OA, (const char*)F.OB, (const char*)F.WaT, (const char*)F.WbT, F.G, F.bx};
        EpiMerge E{F.SGA, F.SGB, F.MERGED};
        pg8::gemm_run<EpiMerge, SchedBranch, false, false>(F.lds, nullptr, S, E);
    PHASE_END(3)
    PHASE_BEGIN(4)
        SchedTiles S{(const char*)F.MERGED, (const char*)F.WoT, 2048, 2048, 16, 64, 4, F.G, F.bx};
        EpiX1 E{F.x, F.mod, F.X1};
        pg8::gemm_run<EpiX1, SchedTiles, false, false>(F.lds, nullptr, S, E);
    PHASE_END(4)
    PHASE_BEGIN(5) norm_route_phase(F, (MK_REPEAT_MASK != 0 && args.li == 1) ? 1 : 0); PHASE_END(5)
    PHASE_BEGIN(6)
        int n4, n7; moe_setup(F, n4, n7);
        SchedMoe S{(const char*)F.H, (const char*)F.ACT, (const char*)F.GUT, (const char*)F.DT, (const LAS int*)(F.lds + TAB_RB), F.ctl + CW_ACT, n4, n7, F.G, F.bx};
        EpiMoe E{F.ACT, F.Y, (const LAS int*)(F.lds + TAB_D), (const LAS float*)(F.lds + TAB_W), F.ctl + CW_ACT};
        pg8::gemm_run<EpiMoe, SchedMoe, true, true>(F.lds, (const LAS int*)(F.lds + TAB_GIDX), S, E);
    PHASE_END(6)
    PHASE_BEGIN(7) final_rows(F); PHASE_END(7)
#undef IN
#undef SEAM
}

extern "C" void kernel_launch(void* const* d_in, const int* in_sizes, int n_in, void* d_out, int out_size, void* d_ws, size_t ws_size, hipStream_t stream) {
    static int grid = 0;
    if (grid == 0) {
        if (n_in != 20 || out_size != MT * DM || ws_size < WS_END) { fprintf(stderr, "kernel_launch: unexpected shapes (n_in %d out %d ws %zu)\n", n_in, out_size, ws_size); grid = -1; return; }
        int dev = 0, cus = 0, per_cu = 0;
        if (hipGetDevice(&dev) != hipSuccess || hipDeviceGetAttribute(&cus, hipDeviceAttributeMultiprocessorCount, dev) != hipSuccess) { grid = -1; return; }
        if (hipFuncSetAttribute((const void*)fwd_kernel, hipFuncAttributeMaxDynamicSharedMemorySize, LDS_BYTES) != hipSuccess) { fprintf(stderr, "kernel_launch: hipFuncSetAttribute failed\n"); grid = -1; return; }
        if (hipOccupancyMaxActiveBlocksPerMultiprocessor(&per_cu, (const void*)fwd_kernel, 512, LDS_BYTES) != hipSuccess || per_cu < 1) { fprintf(stderr, "kernel_launch: occupancy query says %d\n", per_cu); }
        (void)hipGetLastError();
        grid = cus;
    }
    if (grid < 0) return;
    (void)hipMemsetAsync((char*)d_ws + WS_CTL, 0, CTL_ZERO_BYTES, stream);
    Args a{};
    for (int i = 0; i < 20; ++i) a.in[i] = d_in[i];
    a.out = (float*)d_out; a.ws = (unsigned char*)d_ws;
#if MK_PER_PHASE
    for (int p = 0; p < NPHASE; ++p) { a.ph_lo = p; a.ph_hi = p + 1; hipLaunchKernelGGL(fwd_kernel, dim3(grid), dim3(512), LDS_BYTES, stream, a); }
#else
    if (MK_REPEAT_MASK == 0) { a.ph_lo = 0; a.ph_hi = NPHASE; a.li = 0; hipLaunchKernelGGL(fwd_kernel, dim3(grid), dim3(512), LDS_BYTES, stream, a); }
    else {
        int k0 = 0, k1 = 0; for (int k = 0; k < NPHASE; ++k) if ((MK_REPEAT_MASK >> k) & 1) { k0 = k; break; }
        for (int k = 0; k < NPHASE; ++k) if ((MK_REPEAT_MASK >> k) & 1) k1 = k;
        a.ph_lo = 0; a.ph_hi = k1 + 1; a.li = 0; hipLaunchKernelGGL(fwd_kernel, dim3(grid), dim3(512), LDS_BYTES, stream, a);
        a.ph_lo = k0; a.ph_hi = k1 + 1; a.li = 1; hipLaunchKernelGGL(fwd_kernel, dim3(grid), dim3(512), LDS_BYTES, stream, a);
        if (k1 + 1 < NPHASE) { a.ph_lo = k1 + 1; a.ph_hi = NPHASE; a.li = 2; hipLaunchKernelGGL(fwd_kernel, dim3(grid), dim3(512), LDS_BYTES, stream, a); }
    }
#endif
}
```
